# Optimizing an MI355X kernel written in HIP

```python
import math
import jax, jax.numpy as jnp
from jax import lax
import numpy as np

D_MODEL = 2048
BATCH = 2
SEQ = 8192
DEPTH = 4

D_MIX = D_MODEL
D_SSM = D_MIX // 2
SSM_GROUP = 16
N_SSM_GROUPS = D_SSM // SSM_GROUP
SSM_STATE = 64
DT_MIN = 1e-3
DT_MAX = 1e-1

N_HEADS = 16
N_KV = 4
GQA_R = N_HEADS // N_KV
HEAD_DIM = (D_MIX - D_SSM) // N_HEADS
CMP_BLOCK = 32
CMP_STRIDE = 16
CMP_HIDDEN = 128
SEL_BLOCK = 64
SEL_TOP = 16
WINDOW = 512
Q_BLOCK = 128
SEL_RATIO = SEL_BLOCK // CMP_STRIDE
CMP_RATIO = CMP_BLOCK // CMP_STRIDE
FORCED_SCORE = 1e4

N_BUCKETS = 32
RPB_MAX_EXACT = 16
RPB_MAX_DIST = 1024

D_FF = ((8 * D_MODEL // 3 + 255) // 256) * 256
NORM_EPS = 1e-6

IN_SIZES = [D_SSM, N_HEADS * HEAD_DIM] + [N_KV * HEAD_DIM] * 6 + [3 * N_HEADS]
IN_COLS = int(sum(IN_SIZES))
IN_SPLITS = [int(v) for v in np.cumsum(IN_SIZES)[:-1]]

kernel_name = "hymba_s5_nsa_hybrid_trunk"


def rms_norm(x, g):
    xf = x.astype(jnp.float32)
    y = xf * lax.rsqrt(jnp.mean(xf * xf, axis=-1, keepdims=True) + NORM_EPS)
    return (y * g.astype(jnp.float32)).astype(x.dtype)


def masked_softmax(logits, mask):
    logits = jnp.where(mask, logits.astype(jnp.float32), -jnp.inf)
    m = jnp.max(logits, axis=-1, keepdims=True)
    m = jnp.where(jnp.isfinite(m), m, 0.0)
    e = jnp.exp(logits - m)
    return e / jnp.maximum(jnp.sum(e, axis=-1, keepdims=True), 1e-30)


def rel_bucket(dist):
    n = jnp.maximum(dist, 0)
    nf = jnp.maximum(n, 1).astype(jnp.float32)
    large = RPB_MAX_EXACT + (jnp.log(nf / RPB_MAX_EXACT) / math.log(RPB_MAX_DIST / RPB_MAX_EXACT)
                             * (N_BUCKETS - RPB_MAX_EXACT)).astype(jnp.int32)
    large = jnp.minimum(large, N_BUCKETS - 1)
    return jnp.where(n < RPB_MAX_EXACT, n, large)


def _complex_linear_combine(e1, e2):
    a1r, a1i, b1r, b1i = e1
    a2r, a2i, b2r, b2i = e2
    return (a2r * a1r - a2i * a1i,
            a2r * a1i + a2i * a1r,
            a2r * b1r - a2i * b1i + b2r,
            a2r * b1i + a2i * b1r + b2i)


def s5_glu(u, a_re, a_im, log_dt, b_re, b_im, c_re, c_im, d, w_glu, b_glu):
    B_, L_ = u.shape[:2]
    ug = u.astype(jnp.float32).reshape(B_, L_, N_SSM_GROUPS, SSM_GROUP)
    lam_re = jnp.minimum(a_re.astype(jnp.float32), -1e-4)
    lam_im = a_im.astype(jnp.float32)
    dt = jnp.exp(log_dt.astype(jnp.float32))[:, None]
    mag = jnp.exp(lam_re * dt)
    ab_re = mag * jnp.cos(lam_im * dt)
    ab_im = mag * jnp.sin(lam_im * dt)
    nr, ni = ab_re - 1.0, ab_im
    den = lam_re * lam_re + lam_im * lam_im
    f_re = (nr * lam_re + ni * lam_im) / den
    f_im = (ni * lam_re - nr * lam_im) / den
    br, bi = b_re.astype(jnp.float32), b_im.astype(jnp.float32)
    bb_re = f_re[..., None] * br - f_im[..., None] * bi
    bb_im = f_re[..., None] * bi + f_im[..., None] * br
    bu_re = jnp.einsum('blgh,gph->blgp', ug, bb_re)
    bu_im = jnp.einsum('blgh,gph->blgp', ug, bb_im)
    a_b_re = jnp.broadcast_to(ab_re, bu_re.shape)
    a_b_im = jnp.broadcast_to(ab_im, bu_im.shape)
    _, _, x_re, x_im = lax.associative_scan(_complex_linear_combine,
                                            (a_b_re, a_b_im, bu_re, bu_im), axis=1)
    y = (jnp.einsum('blgp,ghp->blgh', x_re, c_re.astype(jnp.float32))
         - jnp.einsum('blgp,ghp->blgh', x_im, c_im.astype(jnp.float32))
         + d.astype(jnp.float32).reshape(N_SSM_GROUPS, SSM_GROUP) * ug)
    y = jax.nn.gelu(y.reshape(B_, L_, D_SSM))
    ab = y @ w_glu.astype(jnp.float32) + b_glu.astype(jnp.float32)
    a, b = jnp.split(ab, 2, axis=-1)
    return (a * jax.nn.sigmoid(b)).astype(u.dtype)


def compress(k, pos, w1, w2):
    B_, L_ = k.shape[:2]
    c = k.reshape(B_, L_ // CMP_STRIDE, CMP_STRIDE, N_KV, HEAD_DIM)
    blocks = jnp.concatenate([c[:, :-1], c[:, 1:]], axis=2)
    blocks = blocks + pos[None, None, :, None, :]
    n_cmp = blocks.shape[1]
    flat = blocks.transpose(0, 1, 3, 2, 4).reshape(B_, n_cmp, N_KV, CMP_BLOCK * HEAD_DIM)
    return jax.nn.gelu(flat @ w1) @ w2


def nsa_mixer(q, kc, vc, ks, vs, kw, vw, gates,
              pos_k, w1_k, w2_k, pos_v, w1_v, w2_v, rpb_table):
    B_, L_ = q.shape[:2]
    n_qb = L_ // Q_BLOCK
    n_sel = L_ // SEL_BLOCK
    top = min(SEL_TOP, n_sel)
    kv_shape = (B_, L_, N_KV, HEAD_DIM)
    q = q.reshape(B_, L_, N_KV, GQA_R, HEAD_DIM) * (HEAD_DIM ** -0.5)
    gates = jax.nn.sigmoid(gates.astype(jnp.float32)).reshape(B_, L_, N_KV, GQA_R, 3)

    k_cmp = compress(kc.reshape(kv_shape), pos_k, w1_k, w2_k)
    v_cmp = compress(vc.reshape(kv_shape), pos_v, w1_v, w2_v)
    n_cmp = k_cmp.shape[1]
    cmp_end = jnp.arange(n_cmp) * CMP_STRIDE + (CMP_BLOCK - 1)

    k_sel_blk = ks.reshape(B_, n_sel, SEL_BLOCK, N_KV, HEAD_DIM).transpose(0, 3, 1, 2, 4)
    v_sel_blk = vs.reshape(B_, n_sel, SEL_BLOCK, N_KV, HEAD_DIM).transpose(0, 3, 1, 2, 4)
    pad_w = ((0, 0), (WINDOW, 0), (0, 0), (0, 0))
    k_win = jnp.pad(kw.reshape(kv_shape), pad_w)
    v_win = jnp.pad(vw.reshape(kv_shape), pad_w)

    table_gr = rpb_table.astype(jnp.float32).reshape(N_BUCKETS, N_KV, GQA_R)
    table_g = table_gr.transpose(1, 0, 2)

    qi = jnp.arange(Q_BLOCK)
    kj = jnp.arange(Q_BLOCK + WINDOW)
    win_dist = qi[:, None] + WINDOW - kj[None, :]
    win_rel_mask = (win_dist >= 0) & (win_dist < WINDOW)
    win_bias = table_gr[rel_bucket(win_dist)].transpose(2, 3, 0, 1)

    bidx = jnp.arange(B_)[:, None, None, None]
    gidx = jnp.arange(N_KV)[None, :, None, None]
    blk_ids = jnp.arange(n_sel)
    s_max = SEL_RATIO + CMP_RATIO - 2
    coefs = {}
    for m in range(SEL_RATIO):
        for n in range(CMP_RATIO):
            coefs[m + n] = coefs.get(m + n, 0) + 1
    span = SEL_RATIO * (n_sel - 1) + 1

    def block(j):
        t = j * Q_BLOCK + qi
        qb = lax.dynamic_slice_in_dim(q, j * Q_BLOCK, Q_BLOCK, axis=1)
        gb = lax.dynamic_slice_in_dim(gates, j * Q_BLOCK, Q_BLOCK, axis=1)

        cdist = t[:, None] - cmp_end[None, :]
        c_bias = table_gr[rel_bucket(cdist)].transpose(2, 3, 0, 1)
        c_logits = jnp.einsum('bqgrd,bngd->bgrqn', qb, k_cmp).astype(jnp.float32) + c_bias
        p_cmp = masked_softmax(c_logits, cdist >= 0)
        o_cmp = jnp.einsum('bgrqn,bngd->bqgrd', p_cmp.astype(v_cmp.dtype), v_cmp)

        imp = jnp.pad(p_cmp.sum(axis=2), ((0, 0), (0, 0), (0, 0), (s_max, SEL_RATIO)))
        p_slc = jnp.zeros(imp.shape[:-1] + (n_sel,), jnp.float32)
        for s, cnt in coefs.items():
            p_slc = p_slc + cnt * imp[..., s_max - s: s_max - s + span: SEL_RATIO]
        cur = t // SEL_BLOCK
        valid = blk_ids[None, :] * SEL_BLOCK <= t[:, None]
        forced = ((blk_ids[None, :] == 0) | (blk_ids[None, :] == cur[:, None])
                  | (blk_ids[None, :] == cur[:, None] - 1))
        score = jnp.where(valid, jnp.where(forced, FORCED_SCORE, p_slc), -1.0)
        top_score, idx = lax.top_k(score, top)
        ksel = k_sel_blk[bidx, gidx, idx].reshape(B_, N_KV, Q_BLOCK, top * SEL_BLOCK, HEAD_DIM)
        vsel = v_sel_blk[bidx, gidx, idx].reshape(B_, N_KV, Q_BLOCK, top * SEL_BLOCK, HEAD_DIM)
        spos = (idx[..., None] * SEL_BLOCK + jnp.arange(SEL_BLOCK)).reshape(B_, N_KV, Q_BLOCK, -1)
        sdist = t[None, None, :, None] - spos
        s_valid = jnp.repeat(top_score >= 0.0, SEL_BLOCK, axis=-1) & (sdist >= 0)
        s_bias = table_g[gidx, rel_bucket(sdist)].transpose(0, 1, 4, 2, 3)
        s_logits = jnp.einsum('bqgrd,bgqkd->bgrqk', qb, ksel).astype(jnp.float32) + s_bias
        p_sel = masked_softmax(s_logits, s_valid[:, :, None])
        o_sel = jnp.einsum('bgrqk,bgqkd->bqgrd', p_sel.astype(vsel.dtype), vsel)

        kwb = lax.dynamic_slice_in_dim(k_win, j * Q_BLOCK, Q_BLOCK + WINDOW, axis=1)
        vwb = lax.dynamic_slice_in_dim(v_win, j * Q_BLOCK, Q_BLOCK + WINDOW, axis=1)
        w_mask = win_rel_mask & (kj[None, :] >= WINDOW - j * Q_BLOCK)
        w_logits = jnp.einsum('bqgrd,bkgd->bgrqk', qb, kwb).astype(jnp.float32) + win_bias
        p_win = masked_softmax(w_logits, w_mask)
        o_win = jnp.einsum('bgrqk,bkgd->bqgrd', p_win.astype(vwb.dtype), vwb)

        out = gb[..., 0:1] * o_cmp + gb[..., 1:2] * o_sel + gb[..., 2:3] * o_win
        return out.reshape(B_, Q_BLOCK, N_HEADS * HEAD_DIM).astype(q.dtype)

    out = lax.map(block, jnp.arange(n_qb))
    return out.transpose(1, 0, 2, 3).reshape(B_, L_, N_HEADS * HEAD_DIM)


def swiglu(h, w_gate, w_up, w_down):
    return (jax.nn.silu(h @ w_gate) * (h @ w_up)) @ w_down


def setup_inputs(seed: int = 0) -> dict:
    key = jax.random.key(seed)
    ks = jax.random.split(key, 32)
    f32 = jnp.float32

    def nrm(k, shape, scale):
        return jax.random.normal(k, shape, f32) * scale

    G, P, H16 = N_SSM_GROUPS, SSM_STATE, SSM_GROUP
    n_idx = jnp.arange(P, dtype=f32)
    return {
        "x": nrm(ks[0], (BATCH, SEQ, D_MODEL), 1.0),
        "rpb_table": nrm(ks[1], (N_BUCKETS, N_HEADS), 0.5),
        "attn_norm": 1.0 + nrm(ks[2], (DEPTH, D_MODEL), 0.01),
        "ffn_norm": 1.0 + nrm(ks[3], (DEPTH, D_MODEL), 0.01),
        "final_norm": 1.0 + nrm(ks[4], (D_MODEL,), 0.01),
        "w_in": nrm(ks[5], (DEPTH, D_MODEL, IN_COLS), D_MODEL ** -0.5),
        "ssm_a_re": -0.5 + nrm(ks[6], (DEPTH, G, P), 0.01),
        "ssm_a_im": math.pi * n_idx[None, None, :] + nrm(ks[7], (DEPTH, G, P), 0.01),
        "ssm_log_dt": jax.random.uniform(ks[8], (DEPTH, G), f32, math.log(DT_MIN), math.log(DT_MAX)),
        "ssm_b_re": nrm(ks[9], (DEPTH, G, P, H16), (2 * H16) ** -0.5),
        "ssm_b_im": nrm(ks[10], (DEPTH, G, P, H16), (2 * H16) ** -0.5),
        "ssm_c_re": nrm(ks[11], (DEPTH, G, H16, P), 0.5),
        "ssm_c_im": nrm(ks[12], (DEPTH, G, H16, P), 0.5),
        "ssm_d": nrm(ks[13], (DEPTH, D_SSM), 1.0),
        "w_glu": nrm(ks[14], (DEPTH, D_SSM, 2 * D_SSM), D_SSM ** -0.5),
        "b_glu": nrm(ks[15], (DEPTH, 2 * D_SSM), 0.01),
        "cmp_pos_k": nrm(ks[16], (DEPTH, CMP_BLOCK, HEAD_DIM), 0.02),
        "cmp_w1_k": nrm(ks[17], (DEPTH, CMP_BLOCK * HEAD_DIM, CMP_HIDDEN), (CMP_BLOCK * HEAD_DIM) ** -0.5),
        "cmp_w2_k": nrm(ks[18], (DEPTH, CMP_HIDDEN, HEAD_DIM), CMP_HIDDEN ** -0.5),
        "cmp_pos_v": nrm(ks[19], (DEPTH, CMP_BLOCK, HEAD_DIM), 0.02),
        "cmp_w1_v": nrm(ks[20], (DEPTH, CMP_BLOCK * HEAD_DIM, CMP_HIDDEN), (CMP_BLOCK * HEAD_DIM) ** -0.5),
        "cmp_w2_v": nrm(ks[21], (DEPTH, CMP_HIDDEN, HEAD_DIM), CMP_HIDDEN ** -0.5),
        "w_out": nrm(ks[22], (DEPTH, D_MIX, D_MODEL), D_MIX ** -0.5),
        "w_ffn_gate": nrm(ks[23], (DEPTH, D_MODEL, D_FF), D_MODEL ** -0.5),
        "w_ffn_up": nrm(ks[24], (DEPTH, D_MODEL, D_FF), D_MODEL ** -0.5),
        "w_ffn_down": nrm(ks[25], (DEPTH, D_FF, D_MODEL), D_FF ** -0.5),
    }


def reference(x, rpb_table, attn_norm, ffn_norm, final_norm, w_in,
              ssm_a_re, ssm_a_im, ssm_log_dt, ssm_b_re, ssm_b_im, ssm_c_re, ssm_c_im, ssm_d,
              w_glu, b_glu, cmp_pos_k, cmp_w1_k, cmp_w2_k, cmp_pos_v, cmp_w1_v, cmp_w2_v,
              w_out, w_ffn_gate, w_ffn_up, w_ffn_down):
    for l in range(DEPTH):
        h = rms_norm(x, attn_norm[l])
        proj = h @ w_in[l]
        u, q, kc, vc, ks_, vs_, kw, vw, gates = jnp.split(proj, IN_SPLITS, axis=-1)
        y_ssm = s5_glu(u, ssm_a_re[l], ssm_a_im[l], ssm_log_dt[l], ssm_b_re[l], ssm_b_im[l],
                       ssm_c_re[l], ssm_c_im[l], ssm_d[l], w_glu[l], b_glu[l])
        y_nsa = nsa_mixer(q, kc, vc, ks_, vs_, kw, vw, gates,
                          cmp_pos_k[l], cmp_w1_k[l], cmp_w2_k[l],
                          cmp_pos_v[l], cmp_w1_v[l], cmp_w2_v[l], rpb_table)
        x = x + jnp.concatenate([y_ssm, y_nsa], axis=-1) @ w_out[l]
        h = rms_norm(x, ffn_norm[l])
        x = x + swiglu(h, w_ffn_gate[l], w_ffn_up[l], w_ffn_down[l])
    return rms_norm(x, final_norm)
```

```cpp
#include <hip/hip_runtime.h>
#include <hip/hip_cooperative_groups.h>
#include <cstdio>
#include <cstdint>
namespace cg = cooperative_groups;

#define LAS __attribute__((address_space(3)))
typedef unsigned short bf16_t;
typedef short bf16x8 __attribute__((ext_vector_type(8)));
typedef short s16x4 __attribute__((ext_vector_type(4)));
typedef float f32x4 __attribute__((ext_vector_type(4)));
typedef float f32x2 __attribute__((ext_vector_type(2)));
typedef unsigned u32x4 __attribute__((ext_vector_type(4)));
typedef unsigned u32x2 __attribute__((ext_vector_type(2)));

constexpr int NB = 2, SEQ = 8192, MTOK = NB * SEQ, DM = 2048, DEPTH = 4;
constexpr int NIN = 3632, NINP = 3840;
constexpr int DSSM = 1024, NGRP = 64, NST = 64;
constexpr int NKV = 4, HD = 64;
constexpr int DFF = 5632;
constexpr int NCHUNK = 16, CHUNK = SEQ / NCHUNK;
constexpr float EPS = 1e-6f;
constexpr int C_Q = 1024, C_KC = 2048, C_VC = 2304, C_KS = 2560, C_KW = 3072, C_GATE = 3584;

constexpr size_t MiB = 1u << 20;
constexpr size_t WS_CTL = 0;
constexpr size_t WS_WIN = 1 * MiB;
constexpr size_t WS_WGLU = WS_WIN + 60 * MiB;
constexpr size_t WS_WOUT = WS_WGLU + 16 * MiB;
constexpr size_t WS_WGU = WS_WOUT + 32 * MiB;
constexpr size_t WS_WDN = WS_WGU + 176 * MiB;
constexpr size_t WS_CW1 = WS_WDN + 88 * MiB;
constexpr size_t WS_CW2 = WS_CW1 + 4 * MiB;
constexpr size_t WS_XB = WS_CW2 + 1 * MiB;
constexpr size_t WS_P = WS_XB + 64 * MiB;
constexpr size_t WS_Y1 = WS_P + 120 * MiB;
constexpr size_t WS_MIX = WS_Y1 + 32 * MiB;
constexpr size_t WS_HID = WS_P;
constexpr size_t WS_VST = WS_MIX + 64 * MiB;
constexpr size_t WS_VWT = WS_VST + 8 * MiB;
constexpr size_t WS_KC = WS_VWT + 8 * MiB;
constexpr size_t WS_VCT = WS_KC + 4 * MiB;
constexpr size_t WS_SST = WS_VCT + 4 * MiB;
constexpr size_t WS_RSQ = WS_SST + 4 * MiB;
constexpr size_t WS_P1 = WS_RSQ + 18 * MiB;
constexpr size_t WS_VT1 = WS_P1 + 120 * MiB;
constexpr size_t WS_END = WS_P1 + 16 * MiB;
__host__ __device__ __forceinline__ size_t p_off(int) { return WS_P; }
__host__ __device__ __forceinline__ size_t vt_off(int) { return WS_VST; }
constexpr size_t WS_KST = WS_P1;
constexpr size_t WS_KWT = WS_P1 + 8 * MiB;
constexpr size_t RSQ_BUF = (size_t)32 * MTOK;

constexpr int LDS_BYTES = 135168;

namespace pg8 {
constexpr int BM = 256, BK = 64, HALF = 128, HTB = HALF * BK * 2, STAGE_BYTES = 8 * HTB, NXCD = 8, WGM = 8;
__host__ __device__ __forceinline__ int lds_byte(int r, int c) { const int st = (r >> 4) * 2 + (c >> 5), rr = r & 15, cc = c & 31, ob = rr * 64 + cc * 2; return st * 1024 + (ob ^ (((ob >> 9) & 1) << 5)); }
__host__ __device__ __forceinline__ void stage_rc(int b, int& R, int& C) { const int st = b / 1024, sb = b % 1024, swz = sb ^ (((sb >> 9) & 1) << 5); R = (st >> 1) * 16 + swz / 64; C = (st & 1) * 32 + (swz % 64) / 2; }
struct Unit { int pm, pn; };
struct Gemm { const bf16_t* A; const bf16_t* Bt; int M, N, K; };
struct StaticOrder {
    int nM, nN, nwg, G, c;
    __host__ __device__ void init(int M, int N, int G_, int c_) { nM = M / BM; nN = N / BM; nwg = nM * nN; G = G_; c = c_; }
    __host__ __device__ bool next(int i, Unit& u) const {
        const long L = (long)i * G + c; if (L >= nwg) return false;
        int wgid = (int)L; { const int q = nwg / NXCD, r = nwg % NXCD, xcd = wgid % NXCD, off = wgid / NXCD; wgid = (xcd < r ? xcd * (q + 1) : r * (q + 1) + (xcd - r) * q) + off; }
        const int nig = WGM * nN, gid = wgid / nig, fm = gid * WGM, gsz = (nM - fm) < WGM ? (nM - fm) : WGM;
        u.pm = fm + ((wgid % nig) % gsz); u.pn = (wgid % nig) / gsz; return true;
    }
};
typedef float f32x2_cv __attribute__((ext_vector_type(2))); typedef __bf16 bf16x2_cv __attribute__((ext_vector_type(2)));
__device__ __forceinline__ unsigned cvt_pk_bf16(float lo, float hi) { const f32x2_cv v = {lo, hi}; const bf16x2_cv b = __builtin_convertvector(v, bf16x2_cv); return __builtin_bit_cast(unsigned, b); }

template <class Epi, class Sched, bool ALIGN_EPI = false, bool SP2 = false>
__device__ __forceinline__ void gemm_phase(LAS unsigned char* lds, const Gemm g, const Sched& S, const Epi& E, const int tid) {
    const int wid = __builtin_amdgcn_readfirstlane(tid >> 6), lane = tid & 63, wr = wid >> 2, wc = wid & 3, fr = lane & 15, fq = lane >> 4;
    const int K = g.K, nt = K / BK;
    unsigned voffA[2], voffB[2];
#pragma unroll
    for (int i = 0; i < 2; ++i) { int R, C; stage_rc(tid * 16 + i * 8192, R, C); voffA[i] = (unsigned)(R * K + C) * 2u; voffB[i] = voffA[i]; }
    const size_t kstep = (size_t)(BK * 2);
    const size_t hstep = (size_t)HALF * K * 2;
    const size_t tstep = 2 * hstep;
    const unsigned ldsw = (unsigned)wid * 1024u;
    const int aoff = lds_byte(wr * 64 + fr, fq * 8), boff = lds_byte(wc * 32 + fr, fq * 8);
#define PG8_SA(b, h) (((b) * 2 + (h)) * HTB)
#define PG8_SB(b, h) ((4 + (b) * 2 + (h)) * HTB)
#define PG8_STAGE(bufoff, gbase, voff) do { _Pragma("unroll") for (int _i = 0; _i < 2; ++_i) \
        __builtin_amdgcn_global_load_lds((const unsigned*)((const char*)(gbase) + (voff)[_i]), (LAS unsigned*)(lds + (bufoff) + ldsw + _i * 8192), 16, 0, 0); } while (0)
#define PG8_LDA(dst, b, h) do { _Pragma("unroll") for (int m = 0; m < 4; ++m) _Pragma("unroll") for (int k = 0; k < 2; ++k) dst[m][k] = *(const LAS bf16x8*)(lds + PG8_SA(b, h) + aoff + m * 2048 + k * 1024); } while (0)
#define PG8_LDB(dst, b, h) do { _Pragma("unroll") for (int n = 0; n < 2; ++n) _Pragma("unroll") for (int k = 0; k < 2; ++k) dst[n][k] = *(const LAS bf16x8*)(lds + PG8_SB(b, h) + boff + n * 2048 + k * 1024); } while (0)
#define PG8_MMA(ai, bj, At, Bt) do { __builtin_amdgcn_s_setprio(1); _Pragma("unroll") for (int m = 0; m < 4; ++m) _Pragma("unroll") for (int n = 0; n < 2; ++n) _Pragma("unroll") for (int k = 0; k < 2; ++k) \
        acc[ai][bj][m][n] = __builtin_amdgcn_mfma_f32_16x16x32_bf16(Bt[n][k], At[m][k], acc[ai][bj][m][n], 0, 0, 0); __builtin_amdgcn_s_setprio(0); } while (0)
#define PG8_WAIT_V(n) asm volatile("s_waitcnt vmcnt(" #n ")" ::: "memory")
#define PG8_WAIT_L(n) asm volatile("s_waitcnt lgkmcnt(" #n ")" ::: "memory")
#define PG8_BAR __builtin_amdgcn_s_barrier()
#define PG8_SCHED __builtin_amdgcn_sched_barrier(0)
    Unit cur, nxt; int ui = 0;
    if (!S.next(0, cur)) return;
    f32x4 acc[2][2][4][2];
#pragma unroll
    for (int a = 0; a < 2; ++a)
#pragma unroll
        for (int b = 0; b < 2; ++b)
#pragma unroll
            for (int m = 0; m < 4; ++m)
#pragma unroll
                for (int n = 0; n < 2; ++n) acc[a][b][m][n] = (f32x4){0.f, 0.f, 0.f, 0.f};
    bf16x8 At[4][2], B0[2][2], B1[2][2];
    const char* cA = (const char*)g.A + (size_t)cur.pm * tstep; const char* cB = (const char*)g.Bt + (size_t)cur.pn * tstep;
    if constexpr (SP2) {
        PG8_STAGE(PG8_SB(0, 0), cB, voffB); PG8_STAGE(PG8_SB(0, 1), cB + hstep, voffB); PG8_STAGE(PG8_SA(0, 0), cA, voffA); PG8_STAGE(PG8_SA(0, 1), cA + hstep, voffA);
        if (wr == 1) PG8_BAR;
        PG8_WAIT_V(2); PG8_BAR;
        PG8_STAGE(PG8_SB(1, 0), cB + kstep, voffB); PG8_STAGE(PG8_SA(1, 0), cA + kstep, voffA); PG8_STAGE(PG8_SB(1, 1), cB + hstep + kstep, voffB);
        PG8_WAIT_V(6); PG8_BAR;
    } else {
        PG8_STAGE(PG8_SB(0, 0), cB, voffB); PG8_STAGE(PG8_SA(0, 0), cA, voffA); PG8_STAGE(PG8_SB(0, 1), cB + hstep, voffB); PG8_STAGE(PG8_SA(0, 1), cA + hstep, voffA);
        if (wr == 1) PG8_BAR;
        PG8_WAIT_V(4); PG8_BAR;
        PG8_STAGE(PG8_SB(1, 0), cB + kstep, voffB); PG8_STAGE(PG8_SA(1, 0), cA + kstep, voffA); PG8_STAGE(PG8_SB(1, 1), cB + hstep + kstep, voffB);
        PG8_WAIT_V(6); PG8_BAR;
    }
    for (;;) {
        const bool has_next = S.next(ui + 1, nxt);
        const char* nA = has_next ? (const char*)g.A + (size_t)nxt.pm * tstep : cA; const char* nB = has_next ? (const char*)g.Bt + (size_t)nxt.pn * tstep : cB;
        for (int t = 0; t < nt; t += 2) {
            const bool last = (t == nt - 2);
            const char* a1 = cA + (size_t)(t + 1) * kstep;
            const char* a2 = last ? nA : cA + (size_t)(t + 2) * kstep; const char* b2 = last ? nB : cB + (size_t)(t + 2) * kstep;
            const char* a3 = a2 + kstep; const char* b3 = b2 + kstep;
            if constexpr (SP2) {
            PG8_LDB(B0, 0, 0); PG8_LDB(B1, 0, 1); PG8_SCHED; PG8_LDA(At, 0, 0); PG8_STAGE(PG8_SA(1, 1), a1 + hstep, voffA);
            PG8_WAIT_V(8); PG8_WAIT_L(0); PG8_BAR; PG8_MMA(0, 0, At, B0); PG8_MMA(0, 1, At, B1); PG8_BAR; PG8_SCHED;
            PG8_LDA(At, 0, 1); PG8_STAGE(PG8_SB(0, 0), b2, voffB); PG8_STAGE(PG8_SB(0, 1), b2 + hstep, voffB); PG8_STAGE(PG8_SA(0, 0), a2, voffA);
            PG8_WAIT_V(8); PG8_WAIT_L(0); PG8_BAR; PG8_MMA(1, 0, At, B0); PG8_MMA(1, 1, At, B1); PG8_BAR; PG8_SCHED;
            PG8_LDB(B0, 1, 0); PG8_LDB(B1, 1, 1); PG8_SCHED; PG8_LDA(At, 1, 0); PG8_STAGE(PG8_SA(0, 1), a2 + hstep, voffA);
            PG8_WAIT_V(8); PG8_WAIT_L(0); PG8_BAR; PG8_MMA(0, 0, At, B0); PG8_MMA(0, 1, At, B1); PG8_BAR; PG8_SCHED;
            PG8_LDA(At, 1, 1); PG8_STAGE(PG8_SB(1, 0), b3, voffB); PG8_STAGE(PG8_SB(1, 1), b3 + hstep, voffB); PG8_STAGE(PG8_SA(1, 0), a3, voffA);
            PG8_WAIT_V(8); PG8_WAIT_L(0); PG8_BAR; PG8_MMA(1, 0, At, B0); PG8_MMA(1, 1, At, B1); PG8_BAR; PG8_SCHED;
            } else {
            PG8_LDB(B0, 0, 0); PG8_SCHED; PG8_LDA(At, 0, 0); PG8_STAGE(PG8_SA(1, 1), a1 + hstep, voffA);
            PG8_WAIT_L(8); PG8_BAR; PG8_WAIT_L(0); PG8_MMA(0, 0, At, B0); PG8_BAR; PG8_SCHED;
            PG8_LDB(B1, 0, 1); PG8_STAGE(PG8_SB(0, 0), b2, voffB);
            PG8_BAR; PG8_WAIT_L(0); PG8_MMA(0, 1, At, B1); PG8_BAR;
            PG8_LDA(At, 0, 1); PG8_STAGE(PG8_SA(0, 0), a2, voffA);
            PG8_BAR; PG8_WAIT_L(0); PG8_MMA(1, 0, At, B0); PG8_BAR; PG8_SCHED;
            PG8_STAGE(PG8_SB(0, 1), b2 + hstep, voffB);
            PG8_WAIT_V(6); PG8_BAR; PG8_MMA(1, 1, At, B1); PG8_BAR;
            PG8_LDB(B0, 1, 0); PG8_SCHED; PG8_LDA(At, 1, 0); PG8_STAGE(PG8_SA(0, 1), a2 + hstep, voffA);
            PG8_WAIT_L(8); PG8_BAR; PG8_WAIT_L(0); PG8_MMA(0, 0, At, B0); PG8_BAR; PG8_SCHED;
            PG8_LDB(B1, 1, 1); PG8_STAGE(PG8_SB(1, 0), b3, voffB);
            PG8_BAR; PG8_WAIT_L(0); PG8_MMA(0, 1, At, B1); PG8_BAR;
            PG8_LDA(At, 1, 1); PG8_STAGE(PG8_SA(1, 0), a3, voffA);
            PG8_BAR; PG8_WAIT_L(0); PG8_MMA(1, 0, At, B0); PG8_BAR; PG8_SCHED;
            PG8_STAGE(PG8_SB(1, 1), b3 + hstep, voffB);
            PG8_WAIT_V(6); PG8_BAR; PG8_MMA(1, 1, At, B1); PG8_BAR;
            }
        }
        if constexpr (ALIGN_EPI) { if (wr == 0) PG8_BAR; }
        E(acc, cur, wr, wc, fr, fq);
        if (!has_next) break;
#pragma unroll
        for (int a = 0; a < 2; ++a)
#pragma unroll
            for (int b = 0; b < 2; ++b)
#pragma unroll
                for (int m = 0; m < 4; ++m)
#pragma unroll
                    for (int n = 0; n < 2; ++n) acc[a][b][m][n] = (f32x4){0.f, 0.f, 0.f, 0.f};
        cur = nxt; cA = nA; cB = nB; ++ui;
        if constexpr (ALIGN_EPI) { if (wr == 1) PG8_BAR; }
    }
    PG8_WAIT_V(0);
    if constexpr (!ALIGN_EPI) { if (wr == 0) PG8_BAR; }
    PG8_BAR;
#undef PG8_SA
#undef PG8_SB
#undef PG8_STAGE
#undef PG8_LDA
#undef PG8_LDB
#undef PG8_MMA
#undef PG8_WAIT_V
#undef PG8_WAIT_L
#undef PG8_BAR
#undef PG8_SCHED
}
}

__device__ __forceinline__ unsigned pk2(float lo, float hi) { return pg8::cvt_pk_bf16(lo, hi); }
__device__ __forceinline__ bf16_t f2bf(float f) { return (bf16_t)(pk2(f, f) & 0xffffu); }
__device__ __forceinline__ float bf2f(bf16_t h) { return __uint_as_float(((unsigned)h) << 16); }
__device__ __forceinline__ float bflo(unsigned w) { return __uint_as_float(w << 16); }
__device__ __forceinline__ float bfhi(unsigned w) { return __uint_as_float(w & 0xffff0000u); }
__device__ __forceinline__ float fexp(float x) { return __expf(x); }
__device__ __forceinline__ float sigmoidf_(float x) { return 1.f / (1.f + fexp(-x)); }
__device__ __forceinline__ float gelu_tanh(float x) { const float z = 0.7978845608f * (x + 0.044715f * x * x * x); const float e = fexp(2.f * z); const float th = 1.f - 2.f / (e + 1.f); return 0.5f * x * (1.f + th); }
__device__ __forceinline__ int vperm(int k) { return (k & 32) | (((k & 15) >> 2) << 3) | (k & 3) | (((k >> 4) & 1) << 2); }
__device__ __forceinline__ int kswz(int key, int d) { return ((((key >> 4) * 2 + (d >> 5)) * 64) + ((d >> 3) & 3) * 16 + (key & 15)) * 8 + (d & 7); }
__device__ __forceinline__ int vswz(int d, int key) { const int k = key & 31; return ((((d >> 4) * 2 + (key >> 5)) * 64) + ((k & 15) >> 2) * 16 + (d & 15)) * 8 + (k & 3) + 4 * (k >> 4); }
__device__ __forceinline__ void wave_lds_fence() { asm volatile("s_waitcnt lgkmcnt(0)" ::: "memory"); }
__device__ __forceinline__ float wave_sum(float v) {
#pragma unroll
    for (int o = 1; o < 64; o <<= 1) v += __shfl_xor(v, o);
    return v;
}
__device__ __forceinline__ bf16x8 zero8() { return (bf16x8){0, 0, 0, 0, 0, 0, 0, 0}; }

__device__ __forceinline__ long pack8_fp8(float a0, float a1, float a2, float a3, float a4, float a5, float a6, float a7) {
    int lo = 0, hi = 0;
    lo = __builtin_amdgcn_cvt_pk_fp8_f32(a0, a1, lo, false); lo = __builtin_amdgcn_cvt_pk_fp8_f32(a2, a3, lo, true);
    hi = __builtin_amdgcn_cvt_pk_fp8_f32(a4, a5, hi, false); hi = __builtin_amdgcn_cvt_pk_fp8_f32(a6, a7, hi, true);
    return (long)(((unsigned long long)(unsigned)hi << 32) | (unsigned long long)(unsigned)lo);
}
__device__ __forceinline__ unsigned pack4_fp8(float a0, float a1, float a2, float a3) {
    int lo = 0; lo = __builtin_amdgcn_cvt_pk_fp8_f32(a0, a1, lo, false); lo = __builtin_amdgcn_cvt_pk_fp8_f32(a2, a3, lo, true); return (unsigned)lo;
}
__device__ __forceinline__ void rstd_table(const float* part, int pm, LAS float* tab, int tid) {
    const int row = tid >> 1, hf = tid & 1; float s = 0.f;
#pragma unroll
    for (int k = 0; k < 16; ++k) s += part[(size_t)(hf * 16 + k) * MTOK + pm * 256 + row];
    s += __shfl_xor(s, 1);
    if (hf == 0) tab[row] = rsqrtf(s * (1.f / DM) + EPS);
    __syncthreads();
}
__device__ __forceinline__ float row_rstd(const float* part, int r, int fq) {
    float s = 0.f;
#pragma unroll
    for (int k = 0; k < 8; ++k) s += part[(size_t)(fq * 8 + k) * MTOK + r];
    s += __shfl_xor(s, 16); s += __shfl_xor(s, 32);
    return rsqrtf(s * (1.f / DM) + EPS);
}
struct EpiInProj {
    unsigned char* wsb; const float* rowsq; const LAS float* tab; int tab_pm;
    __device__ __forceinline__ float rs(int r, int fq) const { return (r >> 8) == tab_pm ? tab[r & 255] : row_rstd(rowsq, r, fq); }
    __device__ __forceinline__ void operator()(const f32x4 (&acc)[2][2][4][2], const pg8::Unit& u, int wr, int wc, int fr, int fq) const {
        const int row0 = u.pm * 256 + wr * 64 + fr;
        const bool tr = (u.pn >= 10 && u.pn <= 13);
        if (!tr) {
            bf16_t* P = (bf16_t*)(wsb + WS_P);
#pragma unroll
            for (int ai = 0; ai < 2; ++ai)
#pragma unroll
                for (int m = 0; m < 4; ++m) {
                    const int r = row0 + ai * 128 + m * 16;
                    const float rstd = rs(r, fq);
                    bf16_t* rowp = P + (size_t)r * NINP + u.pn * 256 + wc * 32 + 4 * fq;
#pragma unroll
                    for (int bj = 0; bj < 2; ++bj)
#pragma unroll
                        for (int n = 0; n < 2; ++n) { const f32x4 v = acc[ai][bj][m][n] * rstd; u32x2 w; w.x = pk2(v[0], v[1]); w.y = pk2(v[2], v[3]); *(u32x2*)(rowp + bj * 128 + n * 16) = w; }
                }
        } else {
            const bool isv = (u.pn & 1); const bool sel8 = (u.pn < 12);
            bf16_t* BT = (bf16_t*)(wsb + ((u.pn == 10) ? WS_KST : (u.pn == 11) ? WS_VST : (u.pn == 12) ? WS_KWT : WS_VWT));
            const int b = u.pm >> 5, blk0 = (u.pm & 31) * 4 + wr;
            const int lk = (((fq >> 1) * 16 + fr) * 8) + 4 * (fq & 1);
            const int lv = (((fr >> 2) * 16 + 4 * fq) * 8) + (fr & 3);
#pragma unroll
            for (int ai = 0; ai < 2; ++ai)
#pragma unroll
                for (int m = 0; m < 4; ++m) {
                    const int r = row0 + ai * 128 + m * 16;
                    const float rstd = rs(r, fq);
#pragma unroll
                    for (int bj = 0; bj < 2; ++bj) {
                        bf16_t* blkp = BT + (size_t)((b * 4 + 2 * bj + (wc >> 1)) * 128 + blk0 + 2 * ai) * 4096;
#pragma unroll
                        for (int n = 0; n < 2; ++n) { const f32x4 v = acc[ai][bj][m][n] * rstd;
                            if (sel8) {
                                unsigned char* blk8 = (unsigned char*)BT + (size_t)((b * 4 + 2 * bj + (wc >> 1)) * 128 + blk0 + 2 * ai) * 4096;
                                if (!isv) *(unsigned*)(blk8 + ((m * 2 + (wc & 1)) * 64 + 2 * n * 16) * 8 + lk) = pack4_fp8(v[0], v[1], v[2], v[3]);
                                else { unsigned char* vp = blk8 + ((((wc & 1) * 2 + n) * 2 + (m >> 1)) * 64) * 8 + 4 * (m & 1) + lv; const unsigned w4 = pack4_fp8(v[0], v[1], v[2], v[3]);
#pragma unroll
                                    for (int i = 0; i < 4; ++i) vp[8 * i] = (unsigned char)(w4 >> (8 * i)); }
                            } else
                            if (!isv) { u32x2 w; w.x = pk2(v[0], v[1]); w.y = pk2(v[2], v[3]); *(u32x2*)(blkp + ((m * 2 + (wc & 1)) * 64 + 2 * n * 16) * 8 + lk) = w; }
                            else { bf16_t* vp = blkp + ((((wc & 1) * 2 + n) * 2 + (m >> 1)) * 64) * 8 + 4 * (m & 1) + lv;
#pragma unroll
                                for (int i = 0; i < 4; ++i) vp[8 * i] = f2bf(v[i]); } }
                    }
                }
        }
    }
};
struct EpiGlu {
    bf16_t* MIX; const float* bias;
    __device__ __forceinline__ void operator()(const f32x4 (&acc)[2][2][4][2], const pg8::Unit& u, int wr, int wc, int fr, int fq) const {
        const int row0 = u.pm * 256 + wr * 64 + fr;
#pragma unroll
        for (int bj = 0; bj < 2; ++bj) {
            const int j0 = u.pn * 128 + bj * 64 + wc * 16 + 4 * fq;
            const f32x4 ba = *(const f32x4*)(bias + j0), bb = *(const f32x4*)(bias + DSSM + j0);
#pragma unroll
            for (int ai = 0; ai < 2; ++ai)
#pragma unroll
                for (int m = 0; m < 4; ++m) {
                    const int r = row0 + ai * 128 + m * 16;
                    const f32x4 a = acc[ai][bj][m][0] + ba, b = acc[ai][bj][m][1] + bb;
                    float o[4];
#pragma unroll
                    for (int i = 0; i < 4; ++i) o[i] = a[i] * sigmoidf_(b[i]);
                    u32x2 w; w.x = pk2(o[0], o[1]); w.y = pk2(o[2], o[3]);
                    *(u32x2*)(MIX + (size_t)r * DM + j0) = w;
                }
        }
    }
};
struct EpiResid {
    bf16_t* XB; float* rowsq;
    __device__ __forceinline__ void operator()(const f32x4 (&acc)[2][2][4][2], const pg8::Unit& u, int wr, int wc, int fr, int fq) const {
        const int row0 = u.pm * 256 + wr * 64 + fr; const int col0 = u.pn * 256 + wc * 32 + 4 * fq;
#pragma unroll
        for (int ai = 0; ai < 2; ++ai)
#pragma unroll
            for (int m = 0; m < 4; ++m) {
                const int r = row0 + ai * 128 + m * 16; float ss = 0.f;
#pragma unroll
                for (int bj = 0; bj < 2; ++bj)
#pragma unroll
                    for (int n = 0; n < 2; ++n) {
                        const size_t off = (size_t)r * DM + col0 + bj * 128 + n * 16;
                        const u32x2 old = *(const u32x2*)(XB + off);
                        f32x4 x = (f32x4){bflo(old.x), bfhi(old.x), bflo(old.y), bfhi(old.y)} + acc[ai][bj][m][n];
                        u32x2 w; w.x = pk2(x[0], x[1]); w.y = pk2(x[2], x[3]); *(u32x2*)(XB + off) = w;
                        ss += (x[0] * x[0] + x[1] * x[1]) + (x[2] * x[2] + x[3] * x[3]);
                    }
                ss += __shfl_xor(ss, 16); ss += __shfl_xor(ss, 32);
                if (fq == 0) rowsq[(size_t)(u.pn * 4 + wc) * MTOK + r] = ss;
            }
    }
};
struct EpiSwiglu {
    bf16_t* HID; const float* rowsq; const LAS float* tab; int tab_pm;
    __device__ __forceinline__ float rs(int r, int fq) const { return (r >> 8) == tab_pm ? tab[r & 255] : row_rstd(rowsq, r, fq); }
    __device__ __forceinline__ void operator()(const f32x4 (&acc)[2][2][4][2], const pg8::Unit& u, int wr, int wc, int fr, int fq) const {
        const int row0 = u.pm * 256 + wr * 64 + fr;
#pragma unroll
        for (int ai = 0; ai < 2; ++ai)
#pragma unroll
            for (int m = 0; m < 4; ++m) {
                const int r = row0 + ai * 128 + m * 16;
                const float rstd = rs(r, fq);
#pragma unroll
                for (int bj = 0; bj < 2; ++bj) {
                    const int j0 = u.pn * 128 + bj * 64 + wc * 16 + 4 * fq;
                    const f32x4 gv = acc[ai][bj][m][0] * rstd, uv = acc[ai][bj][m][1] * rstd;
                    float o[4];
#pragma unroll
                    for (int i = 0; i < 4; ++i) o[i] = gv[i] * sigmoidf_(gv[i]) * uv[i];
                    u32x2 w; w.x = pk2(o[0], o[1]); w.y = pk2(o[2], o[3]);
                    *(u32x2*)(HID + (size_t)r * DFF + j0) = w;
                }
            }
    }
};

__device__ __forceinline__ void transpose_item(const float* W, int K, int N, bf16_t* WT, int mode, const float* gain, LAS float* scr, int item, int lane) {
    const int nblk = (N + 31) / 32, kb = item / nblk, nb = item % nblk, k0 = 64 * kb, n0 = 32 * nb;
    const int nn = n0 + (lane & 31);
    float cs = 1.f; if (mode == 4 && nn >= C_Q && nn < C_KC) cs = 0.125f;
#pragma unroll
    for (int i = 0; i < 32; ++i) { const int kk = 2 * i + (lane >> 5);
        float v = (nn < N) ? W[(size_t)(k0 + kk) * N + nn] : 0.f;
        if (gain) v *= gain[k0 + kk];
        scr[kk * 33 + (lane & 31)] = v * cs; }
    wave_lds_fence();
    const int c = lane & 7;
#pragma unroll
    for (int j = 0; j < 4; ++j) { const int n = (lane >> 3) + 8 * j; const LAS float* s = scr + (8 * c) * 33 + n;
        u32x4 o; o.x = pk2(s[0 * 33], s[1 * 33]); o.y = pk2(s[2 * 33], s[3 * 33]); o.z = pk2(s[4 * 33], s[5 * 33]); o.w = pk2(s[6 * 33], s[7 * 33]);
        const int ng = n0 + n; int dest = ng;
        if (mode == 1) { const int hf = ng >= DSSM, jj = ng - DSSM * hf; dest = (jj >> 4) * 32 + 16 * hf + (jj & 15); }
        else if (mode == 2 || mode == 3) dest = (ng >> 4) * 32 + 16 * (mode - 2) + (ng & 15);
        *(u32x4*)(WT + (size_t)dest * K + k0 + 8 * c) = o; }
    wave_lds_fence();
}

struct Args {
    const float* in[26];
    float* out; unsigned char* ws;
};
typedef const Args __attribute__((address_space(4))) CArgs;
__device__ __forceinline__ CArgs* get_args() { CArgs* p = (CArgs*)__builtin_amdgcn_kernarg_segment_ptr(); asm volatile("" : "+s"(p)); return p; }

constexpr int IT_WIN = 32 * 114, IT_GLU = 16 * 64, IT_OUT = 32 * 64, IT_G = 32 * 176, IT_U = 32 * 176, IT_D = 88 * 64, IT_C1 = 32 * 4, IT_C2 = 2 * 2;
constexpr int IT_LAYER = IT_WIN + IT_GLU + IT_OUT + IT_G + IT_U + IT_D + 2 * IT_C1 + 2 * IT_C2;

__device__ __forceinline__ void prologue(LAS unsigned char* lds, int wave, int lane, int gw, int NGW) {
    CArgs* Ap = get_args();
    unsigned char* ws = Ap->ws;
    LAS float* scr = (LAS float*)(lds + wave * 16384);
    for (int it = gw; it < DEPTH * IT_LAYER; it += NGW) {
        const int l = it / IT_LAYER; int r = it % IT_LAYER;
        if (r < IT_WIN) { transpose_item(Ap->in[5] + (size_t)l * DM * NIN, DM, NIN, (bf16_t*)(ws + WS_WIN) + (size_t)l * NINP * DM, 4, Ap->in[2] + l * DM, scr, r, lane); continue; } r -= IT_WIN;
        if (r < IT_GLU) { transpose_item(Ap->in[14] + (size_t)l * DSSM * 2 * DSSM, DSSM, 2 * DSSM, (bf16_t*)(ws + WS_WGLU) + (size_t)l * 2 * DSSM * DSSM, 1, nullptr, scr, r, lane); continue; } r -= IT_GLU;
        if (r < IT_OUT) { transpose_item(Ap->in[22] + (size_t)l * DM * DM, DM, DM, (bf16_t*)(ws + WS_WOUT) + (size_t)l * DM * DM, 0, nullptr, scr, r, lane); continue; } r -= IT_OUT;
        if (r < IT_G) { transpose_item(Ap->in[23] + (size_t)l * DM * DFF, DM, DFF, (bf16_t*)(ws + WS_WGU) + (size_t)l * 2 * DFF * DM, 2, Ap->in[3] + l * DM, scr, r, lane); continue; } r -= IT_G;
        if (r < IT_U) { transpose_item(Ap->in[24] + (size_t)l * DM * DFF, DM, DFF, (bf16_t*)(ws + WS_WGU) + (size_t)l * 2 * DFF * DM, 3, Ap->in[3] + l * DM, scr, r, lane); continue; } r -= IT_U;
        if (r < IT_D) { transpose_item(Ap->in[25] + (size_t)l * DFF * DM, DFF, DM, (bf16_t*)(ws + WS_WDN) + (size_t)l * DM * DFF, 0, nullptr, scr, r, lane); continue; } r -= IT_D;
        if (r < IT_C1) { transpose_item(Ap->in[17] + (size_t)l * 2048 * 128, 2048, 128, (bf16_t*)(ws + WS_CW1) + (size_t)(l * 2 + 0) * 128 * 2048, 0, nullptr, scr, r, lane); continue; } r -= IT_C1;
        if (r < IT_C1) { transpose_item(Ap->in[20] + (size_t)l * 2048 * 128, 2048, 128, (bf16_t*)(ws + WS_CW1) + (size_t)(l * 2 + 1) * 128 * 2048, 0, nullptr, scr, r, lane); continue; } r -= IT_C1;
        if (r < IT_C2) { transpose_item(Ap->in[18] + (size_t)l * 128 * 64, 128, 64, (bf16_t*)(ws + WS_CW2) + (size_t)(l * 2 + 0) * 64 * 128, 0, nullptr, scr, r, lane); continue; } r -= IT_C2;
        transpose_item(Ap->in[21] + (size_t)l * 128 * 64, 128, 64, (bf16_t*)(ws + WS_CW2) + (size_t)(l * 2 + 1) * 64 * 128, 0, nullptr, scr, r, lane);
    }
    const float* x = Ap->in[0]; bf16_t* XB = (bf16_t*)(ws + WS_XB); float* rowsq = (float*)(ws + WS_RSQ);
    for (int m = gw; m < MTOK; m += NGW) {
        const f32x4* xr = (const f32x4*)(x + (size_t)m * DM) + lane; u32x2* xb = (u32x2*)(XB + (size_t)m * DM) + lane;
        float s = 0.f;
#pragma unroll
        for (int j = 0; j < 8; ++j) { const f32x4 v = xr[64 * j]; u32x2 w; w.x = pk2(v[0], v[1]); w.y = pk2(v[2], v[3]); xb[64 * j] = w; s += (v[0] * v[0] + v[1] * v[1]) + (v[2] * v[2] + v[3] * v[3]); }
        s = wave_sum(s);
        if (lane < 32) rowsq[(size_t)lane * MTOK + m] = (lane == 0) ? s : 0.f;
    }
}

__device__ __forceinline__ void sincos_small(float ang, float& sn, float& cs) {
    const float k = rintf(ang * 0.636619772f);
    float r = fmaf(-k, 1.5707963705f, ang); r = fmaf(-k, -4.37113883e-8f, r);
    const float r2 = r * r;
    const float s = r * (1.f + r2 * (-1.f / 6.f + r2 * (1.f / 120.f + r2 * (-1.f / 5040.f + r2 * (1.f / 362880.f)))));
    const float c = 1.f + r2 * (-0.5f + r2 * (1.f / 24.f + r2 * (-1.f / 720.f + r2 * (1.f / 40320.f))));
    const int q = ((int)k) & 3;
    sn = (q == 0) ? s : (q == 1) ? c : (q == 2) ? -s : -c;
    cs = (q == 0) ? c : (q == 1) ? -s : (q == 2) ? -c : s;
}

template <int PASS>
__device__ __forceinline__ void s5_task(CArgs* Ap, int l, int b, int g, int c, LAS unsigned char* wl, int lane) {
    if (PASS == 1 && c == NCHUNK - 1) return;
    unsigned char* ws = Ap->ws;
    const bf16_t* P = (const bf16_t*)(ws + p_off(l));
    f32x2* SST = (f32x2*)(ws + WS_SST + (size_t)l * MiB);
    LAS float* us = (LAS float*)wl;
    LAS bf16_t* Xs = (LAS bf16_t*)(wl + 1024);
    const int p = lane;
    const float a_re = fminf(Ap->in[6][(l * NGRP + g) * NST + p], -1e-4f), a_im = Ap->in[7][(l * NGRP + g) * NST + p];
    const float dt = expf(Ap->in[8][l * NGRP + g]);
    const float mag = expf(a_re * dt); float sn, cs; sincos_small(a_im * dt, sn, cs);
    const float ab_re = mag * cs, ab_im = mag * sn;
    const float nr = ab_re - 1.f, ni = ab_im, den = a_re * a_re + a_im * a_im;
    const float f_re = (nr * a_re + ni * a_im) / den, f_im = (ni * a_re - nr * a_im) / den;
    float bbr[16], bbi[16]; f32x2 bb2[16];
    {
        const f32x4* br = (const f32x4*)(Ap->in[9] + ((size_t)(l * NGRP + g) * NST + p) * 16); const f32x4* bi = (const f32x4*)(Ap->in[10] + ((size_t)(l * NGRP + g) * NST + p) * 16);
#pragma unroll
        for (int q = 0; q < 4; ++q) { const f32x4 vr = br[q], vi = bi[q];
#pragma unroll
            for (int i = 0; i < 4; ++i) { bbr[4 * q + i] = f_re * vr[i] - f_im * vi[i]; bbi[4 * q + i] = f_re * vi[i] + f_im * vr[i]; bb2[4 * q + i] = (f32x2){bbr[4 * q + i], bbi[4 * q + i]}; } }
    }
    float xr = 0.f, xi = 0.f;
    const int n16 = lane & 15, g4 = lane >> 4;
    bf16x8 cB[4]; float dval = 0.f;
    if (PASS == 2) {
        float pr = ab_re, pi = ab_im;
#pragma unroll
        for (int i = 0; i < 9; ++i) { const float t_ = pr * pr - pi * pi; pi = 2.f * pr * pi; pr = t_; }
        const f32x2* S = SST + (size_t)((b * NGRP + g) * NCHUNK) * NST + p;
        for (int cc = 0; cc < c; ++cc) { const f32x2 s = S[(size_t)cc * NST]; const float t_ = pr * xr - pi * xi + s.x; xi = pr * xi + pi * xr + s.y; xr = t_; }
        const float* cre = Ap->in[11] + ((size_t)(l * NGRP + g) * 16 + n16) * NST; const float* cim = Ap->in[12] + ((size_t)(l * NGRP + g) * 16 + n16) * NST;
#pragma unroll
        for (int kk = 0; kk < 4; ++kk) { const f32x4 r4 = *(const f32x4*)(cre + 16 * kk + 4 * g4), i4 = *(const f32x4*)(cim + 16 * kk + 4 * g4);
            u32x4 w; w.x = pk2(r4[0], -i4[0]); w.y = pk2(r4[1], -i4[1]); w.z = pk2(r4[2], -i4[2]); w.w = pk2(r4[3], -i4[3]);
            cB[kk] = __builtin_bit_cast(bf16x8, w); }
        dval = Ap->in[13][l * DSSM + g * 16 + n16];
    }
    const size_t row0 = (size_t)b * SEQ + (size_t)c * CHUNK;
    const bf16_t* up = P + (row0 + (lane >> 2)) * NINP + g * 16 + 4 * (lane & 3);
    u32x2 unext = *(const u32x2*)up;
    bf16_t* Y1 = (bf16_t*)(ws + WS_Y1);
    for (int tb = 0; tb < CHUNK; tb += 16) {
        const u32x2 ucur = unext;
        if (tb + 16 < CHUNK) unext = *(const u32x2*)(up + (size_t)(tb + 16) * NINP);
        *(LAS f32x4*)(us + (lane >> 2) * 16 + 4 * (lane & 3)) = (f32x4){bflo(ucur.x), bfhi(ucur.x), bflo(ucur.y), bfhi(ucur.y)};
        wave_lds_fence();
#pragma unroll 4
        for (int s = 0; s < 16; ++s) {
            const f32x4 u0 = *(const LAS f32x4*)(us + s * 16), u1 = *(const LAS f32x4*)(us + s * 16 + 4), u2 = *(const LAS f32x4*)(us + s * 16 + 8), u3 = *(const LAS f32x4*)(us + s * 16 + 12);
            f32x2 bu = (f32x2){0.f, 0.f};
#pragma unroll
            for (int i = 0; i < 4; ++i) bu = bb2[i] * (f32x2){u0[i], u0[i]} + bu;
#pragma unroll
            for (int i = 0; i < 4; ++i) bu = bb2[4 + i] * (f32x2){u1[i], u1[i]} + bu;
#pragma unroll
            for (int i = 0; i < 4; ++i) bu = bb2[8 + i] * (f32x2){u2[i], u2[i]} + bu;
#pragma unroll
            for (int i = 0; i < 4; ++i) bu = bb2[12 + i] * (f32x2){u3[i], u3[i]} + bu;
            const float br_ = bu.x, bi_ = bu.y;
            const float nxr = fmaf(ab_re, xr, fmaf(-ab_im, xi, br_)); const float nxi = fmaf(ab_re, xi, fmaf(ab_im, xr, bi_));
            xr = nxr; xi = nxi;
            if (PASS == 2) *(LAS unsigned*)(Xs + s * 136 + 2 * p) = pk2(xr, xi);
        }
        if (PASS == 2) {
            wave_lds_fence();
            f32x4 y = (f32x4){0.f, 0.f, 0.f, 0.f};
#pragma unroll
            for (int kk = 0; kk < 4; ++kk) { const bf16x8 xa = *(const LAS bf16x8*)(Xs + n16 * 136 + 32 * kk + 8 * g4); y = __builtin_amdgcn_mfma_f32_16x16x32_bf16(xa, cB[kk], y, 0, 0, 0); }
#pragma unroll
            for (int i = 0; i < 4; ++i) { const int tl = 4 * g4 + i; const float uv = us[tl * 16 + n16]; const float v = gelu_tanh(y[i] + dval * uv);
                Y1[(row0 + tb + tl) * DSSM + g * 16 + n16] = f2bf(v); }
        }
        wave_lds_fence();
    }
    if (PASS == 1) SST[(size_t)((b * NGRP + g) * NCHUNK + c) * NST + p] = (f32x2){xr, xi};
}

__device__ __forceinline__ void compress_task(CArgs* Ap, int l, int task, int lane) {
    unsigned char* ws = Ap->ws;
    const int kv = task & 1, nb = (task >> 1) & 31, g = (task >> 6) & 3, b = task >> 8;
    const int n16 = lane & 15, g4 = lane >> 4;
    const bf16_t* P = (const bf16_t*)(ws + p_off(l));
    const bf16_t* W1t = (const bf16_t*)(ws + WS_CW1) + (size_t)(l * 2 + kv) * 128 * 2048;
    const bf16_t* W2t = (const bf16_t*)(ws + WS_CW2) + (size_t)(l * 2 + kv) * 64 * 128;
    const float* pos = Ap->in[kv ? 19 : 16] + (size_t)l * 32 * 64;
    const int n = nb * 16 + n16;
    const int colb = (kv ? C_VC : C_KC) + g * 64;
    f32x4 acc[8];
#pragma unroll
    for (int h = 0; h < 8; ++h) acc[h] = (f32x4){0.f, 0.f, 0.f, 0.f};
#pragma unroll 2
    for (int ks = 0; ks < 64; ++ks) {
        const int itok = ks >> 1, d0 = 32 * (ks & 1) + 8 * g4;
        int tok = 16 * n + itok; tok = tok > SEQ - 1 ? SEQ - 1 : tok;
        const u32x4 raw = *(const u32x4*)(P + ((size_t)b * SEQ + tok) * NINP + colb + d0);
        const f32x4 p0 = *(const f32x4*)(pos + itok * 64 + d0), p1 = *(const f32x4*)(pos + itok * 64 + d0 + 4);
        u32x4 w;
        w.x = pk2(bflo(raw.x) + p0[0], bfhi(raw.x) + p0[1]); w.y = pk2(bflo(raw.y) + p0[2], bfhi(raw.y) + p0[3]);
        w.z = pk2(bflo(raw.z) + p1[0], bfhi(raw.z) + p1[1]); w.w = pk2(bflo(raw.w) + p1[2], bfhi(raw.w) + p1[3]);
        const bf16x8 fb = __builtin_bit_cast(bf16x8, w);
#pragma unroll
        for (int h = 0; h < 8; ++h) { const bf16x8 wa = *(const bf16x8*)(W1t + (size_t)(16 * h + n16) * 2048 + 32 * ks + 8 * g4); acc[h] = __builtin_amdgcn_mfma_f32_16x16x32_bf16(wa, fb, acc[h], 0, 0, 0); }
    }
    bf16x8 hB[4];
#pragma unroll
    for (int pp = 0; pp < 4; ++pp) { float v[8];
#pragma unroll
        for (int i = 0; i < 4; ++i) { v[i] = gelu_tanh(acc[2 * pp][i]); v[4 + i] = gelu_tanh(acc[2 * pp + 1][i]); }
        u32x4 w; w.x = pk2(v[0], v[1]); w.y = pk2(v[2], v[3]); w.z = pk2(v[4], v[5]); w.w = pk2(v[6], v[7]); hB[pp] = __builtin_bit_cast(bf16x8, w); }
    bf16_t* KC = (bf16_t*)(ws + WS_KC + (size_t)l * MiB); bf16_t* VCT = (bf16_t*)(ws + WS_VCT + (size_t)l * MiB);
#pragma unroll
    for (int dt = 0; dt < 4; ++dt) {
        f32x4 o = (f32x4){0.f, 0.f, 0.f, 0.f};
#pragma unroll
        for (int pp = 0; pp < 4; ++pp) { const bf16_t* wrow = W2t + (size_t)(16 * dt + n16) * 128 + 32 * pp + 4 * g4;
            const u32x2 lo = *(const u32x2*)wrow, hi = *(const u32x2*)(wrow + 16);
            u32x4 w; w.x = lo.x; w.y = lo.y; w.z = hi.x; w.w = hi.y;
            o = __builtin_amdgcn_mfma_f32_16x16x32_bf16(__builtin_bit_cast(bf16x8, w), hB[pp], o, 0, 0, 0); }
        if (kv == 0) { u32x2 w; w.x = pk2(o[0], o[1]); w.y = pk2(o[2], o[3]); *(u32x2*)(KC + (size_t)((b * 4 + g) * 8 + (n >> 6)) * 4096 + kswz(n & 63, 16 * dt + 4 * g4)) = w; }
        else {
#pragma unroll
            for (int i = 0; i < 4; ++i) VCT[(size_t)((b * 4 + g) * 8 + (n >> 6)) * 4096 + vswz(16 * dt + 4 * g4 + i, n & 63)] = f2bf(o[i]); }
    }
}

__device__ __forceinline__ void compress_simple(CArgs* Ap, int l, int task, LAS float* hs, int lane) {
    unsigned char* ws = Ap->ws;
    const int kv = task & 1, n0 = ((task >> 1) & 127) * 4, g = (task >> 8) & 3, b = task >> 10;
    const bf16_t* P = (const bf16_t*)(ws + p_off(l));
    const float* w1 = Ap->in[kv ? 20 : 17] + (size_t)l * 2048 * 128; const float* w2 = Ap->in[kv ? 21 : 18] + (size_t)l * 128 * 64;
    const float* pos = Ap->in[kv ? 19 : 16] + (size_t)l * 32 * 64;
    const int colb = (kv ? C_VC : C_KC) + g * 64;
    float h0[4] = {0.f, 0.f, 0.f, 0.f}, h1[4] = {0.f, 0.f, 0.f, 0.f};
    for (int i = 0; i < 32; ++i) {
        const bf16_t* pr[4];
#pragma unroll
        for (int r = 0; r < 4; ++r) { int tok = 16 * (n0 + r) + i; tok = tok > SEQ - 1 ? SEQ - 1 : tok; pr[r] = P + ((size_t)b * SEQ + tok) * NINP + colb; }
        for (int d8 = 0; d8 < 8; ++d8) {
            const f32x4 p0 = *(const f32x4*)(pos + i * 64 + d8 * 8), p1 = *(const f32x4*)(pos + i * 64 + d8 * 8 + 4);
            const float pv[8] = {p0[0], p0[1], p0[2], p0[3], p1[0], p1[1], p1[2], p1[3]};
            float f[4][8];
#pragma unroll
            for (int r = 0; r < 4; ++r) { const u32x4 raw = *(const u32x4*)(pr[r] + d8 * 8);
                f[r][0] = bflo(raw.x) + pv[0]; f[r][1] = bfhi(raw.x) + pv[1]; f[r][2] = bflo(raw.y) + pv[2]; f[r][3] = bfhi(raw.y) + pv[3];
                f[r][4] = bflo(raw.z) + pv[4]; f[r][5] = bfhi(raw.z) + pv[5]; f[r][6] = bflo(raw.w) + pv[6]; f[r][7] = bfhi(raw.w) + pv[7]; }
            const float* wr = w1 + (size_t)(i * 64 + d8 * 8) * 128 + lane;
#pragma unroll
            for (int e = 0; e < 8; ++e) { const float wa = wr[e * 128], wb = wr[e * 128 + 64];
#pragma unroll
                for (int r = 0; r < 4; ++r) { h0[r] = fmaf(f[r][e], wa, h0[r]); h1[r] = fmaf(f[r][e], wb, h1[r]); } }
        }
    }
#pragma unroll
    for (int r = 0; r < 4; ++r) { hs[r * 128 + lane] = gelu_tanh(h0[r]); hs[r * 128 + lane + 64] = gelu_tanh(h1[r]); }
    wave_lds_fence();
    float o[4] = {0.f, 0.f, 0.f, 0.f};
    for (int k = 0; k < 128; ++k) { const float w = w2[k * 64 + lane];
#pragma unroll
        for (int r = 0; r < 4; ++r) o[r] = fmaf(hs[r * 128 + k], w, o[r]); }
    wave_lds_fence();
    bf16_t* KC = (bf16_t*)(ws + WS_KC + (size_t)l * MiB); bf16_t* VCT = (bf16_t*)(ws + WS_VCT + (size_t)l * MiB);
#pragma unroll
    for (int r = 0; r < 4; ++r) { const int n = n0 + r;
        if (kv == 0) KC[(size_t)((b * 4 + g) * 8 + (n >> 6)) * 4096 + kswz(n & 63, lane)] = f2bf(o[r]);
        else VCT[(size_t)((b * 4 + g) * 8 + (n >> 6)) * 4096 + vswz(lane, n & 63)] = f2bf(o[r]); }
}

__device__ __forceinline__ int rel_bucket_i(int n) {
    if (n < 16) return n;
    int c = 0;
    c += n >= 16; c += n >= 21; c += n >= 27; c += n >= 35; c += n >= 46; c += n >= 59; c += n >= 77; c += n >= 99;
    c += n >= 128; c += n >= 166; c += n >= 216; c += n >= 280; c += n >= 363; c += n >= 470; c += n >= 609; c += n >= 790;
    return 15 + c;
}

struct SmState { float m, l; };

template <int MODE>
__device__ __forceinline__ void softmax_block(f32x4 (&acc)[4], int base, bool ok, int t, int g4, const LAS float* lutg, SmState& st, f32x4 (&O)[4], bf16x8 (&pB)[2]) {
    float mx = -1e30f; unsigned vm = 0u;
#pragma unroll
    for (int nt = 0; nt < 4; ++nt)
#pragma unroll
        for (int i = 0; i < 4; ++i) {
            const int key = base + 16 * nt + 4 * g4 + i;
            const int dist = (MODE == 0) ? t - (16 * key + 31) : t - key;
            bool valid = dist >= 0;
            if (MODE == 1) valid = valid && ok;
            if (MODE == 2) valid = valid && dist < 512;
            int dc = dist < 0 ? 0 : dist; dc = dc > 1023 ? 1023 : dc;
            const float lg = acc[nt][i] + lutg[dc * 4];
            acc[nt][i] = lg;
            if (valid) { mx = fmaxf(mx, lg); vm |= 1u << (nt * 4 + i); }
        }
    mx = fmaxf(mx, __shfl_xor(mx, 16)); mx = fmaxf(mx, __shfl_xor(mx, 32));
    const float mn = fmaxf(st.m, mx);
    const float sc = fexp(st.m - mn);
    float ls = 0.f;
#pragma unroll
    for (int nt = 0; nt < 4; ++nt)
#pragma unroll
        for (int i = 0; i < 4; ++i) { const float p = ((vm >> (nt * 4 + i)) & 1u) ? fexp(acc[nt][i] - mn) : 0.f; acc[nt][i] = p; ls += p; }
    st.l = st.l * sc + ls; st.m = mn;
#pragma unroll
    for (int dt = 0; dt < 4; ++dt) O[dt] = O[dt] * sc;
#pragma unroll
    for (int hh = 0; hh < 2; ++hh) { u32x4 w; w.x = pk2(acc[2 * hh][0], acc[2 * hh][1]); w.y = pk2(acc[2 * hh][2], acc[2 * hh][3]); w.z = pk2(acc[2 * hh + 1][0], acc[2 * hh + 1][1]); w.w = pk2(acc[2 * hh + 1][2], acc[2 * hh + 1][3]);
        pB[hh] = __builtin_bit_cast(bf16x8, w); }
}

__device__ __forceinline__ void load_k(bf16x8 (&kf)[4][2], const bf16_t* Kb, int lane) {
#pragma unroll
    for (int nt = 0; nt < 4; ++nt)
#pragma unroll
        for (int kk = 0; kk < 2; ++kk) kf[nt][kk] = *(const bf16x8*)(Kb + ((nt * 2 + kk) * 64 + lane) * 8);
}
__device__ __forceinline__ void load_v(bf16x8 (&vf)[4][2], const bf16_t* Vb, int lane) {
#pragma unroll
    for (int dt = 0; dt < 4; ++dt)
#pragma unroll
        for (int hh = 0; hh < 2; ++hh) vf[dt][hh] = *(const bf16x8*)(Vb + ((dt * 2 + hh) * 64 + lane) * 8);
}
__device__ __forceinline__ void qk_acc(f32x4 (&acc)[4], const bf16x8 (&kf)[4][2], const bf16x8 (&q)[2]) {
#pragma unroll
    for (int nt = 0; nt < 4; ++nt) { acc[nt] = __builtin_amdgcn_mfma_f32_16x16x32_bf16(kf[nt][0], q[0], acc[nt], 0, 0, 0); acc[nt] = __builtin_amdgcn_mfma_f32_16x16x32_bf16(kf[nt][1], q[1], acc[nt], 0, 0, 0); }
}
__device__ __forceinline__ void pv_acc(f32x4 (&O)[4], const bf16x8 (&vf)[4][2], const bf16x8 (&pB)[2]) {
#pragma unroll
    for (int dt = 0; dt < 4; ++dt) { O[dt] = __builtin_amdgcn_mfma_f32_16x16x32_bf16(vf[dt][0], pB[0], O[dt], 0, 0, 0); O[dt] = __builtin_amdgcn_mfma_f32_16x16x32_bf16(vf[dt][1], pB[1], O[dt], 0, 0, 0); }
}


__device__ __forceinline__ void load_kh(bf16x8 (&kf)[2][2], const bf16_t* Kb, int hh, int lane) {
#pragma unroll
    for (int nt = 0; nt < 2; ++nt)
#pragma unroll
        for (int kk = 0; kk < 2; ++kk) kf[nt][kk] = *(const bf16x8*)(Kb + (((2 * hh + nt) * 2 + kk) * 64 + lane) * 8);
}
__device__ __forceinline__ void load_vh(bf16x8 (&vf)[4], const bf16_t* Vb, int hh, int lane) {
#pragma unroll
    for (int dt = 0; dt < 4; ++dt) vf[dt] = *(const bf16x8*)(Vb + ((dt * 2 + hh) * 64 + lane) * 8);
}
__device__ __forceinline__ void qk_acch(f32x4 (&acc)[2], const bf16x8 (&kf)[2][2], const bf16x8 (&q)[2]) {
#pragma unroll
    for (int nt = 0; nt < 2; ++nt) { acc[nt] = __builtin_amdgcn_mfma_f32_16x16x32_bf16(kf[nt][0], q[0], acc[nt], 0, 0, 0); acc[nt] = __builtin_amdgcn_mfma_f32_16x16x32_bf16(kf[nt][1], q[1], acc[nt], 0, 0, 0); }
}
__device__ __forceinline__ void pv_acch(f32x4 (&O)[4], const bf16x8 (&vf)[4], const bf16x8 pB) {
#pragma unroll
    for (int dt = 0; dt < 4; ++dt) O[dt] = __builtin_amdgcn_mfma_f32_16x16x32_bf16(vf[dt], pB, O[dt], 0, 0, 0);
}
__device__ __forceinline__ void softmax_half_far(f32x4 (&acc)[2], const LAS float* lutg, SmState& st, f32x4 (&O)[4]) {
    const float bias = lutg[1023 * 4];
    float mx = -1e30f;
#pragma unroll
    for (int nt = 0; nt < 2; ++nt)
#pragma unroll
        for (int i = 0; i < 4; ++i) { const float lg = acc[nt][i] + bias; acc[nt][i] = lg; mx = fmaxf(mx, lg); }
    mx = fmaxf(mx, __shfl_xor(mx, 16)); mx = fmaxf(mx, __shfl_xor(mx, 32));
    const float mn = fmaxf(st.m, mx);
    const float sc = fexp(st.m - mn);
    float ls = 0.f;
#pragma unroll
    for (int nt = 0; nt < 2; ++nt)
#pragma unroll
        for (int i = 0; i < 4; ++i) { const float p = fexp(acc[nt][i] - mn); acc[nt][i] = p; ls += p; }
    st.l = st.l * sc + ls; st.m = mn;
#pragma unroll
    for (int dt = 0; dt < 4; ++dt) O[dt] = O[dt] * sc;
}
template <int MODE>
__device__ __forceinline__ void softmax_half(f32x4 (&acc)[2], int base, bool ok, int t, int g4, const LAS float* lutg, SmState& st, f32x4 (&O)[4], bf16x8& pB) {
    float mx = -1e30f; unsigned vm = 0u;
#pragma unroll
    for (int nt = 0; nt < 2; ++nt)
#pragma unroll
        for (int i = 0; i < 4; ++i) {
            const int key = base + 16 * nt + 4 * g4 + i;
            const int dist = t - key;
            bool valid = dist >= 0;
            if (MODE == 1) valid = valid && ok;
            if (MODE == 2) valid = valid && dist < 512;
            int dc = dist < 0 ? 0 : dist; dc = dc > 1023 ? 1023 : dc;
            const float lg = acc[nt][i] + lutg[dc * 4];
            acc[nt][i] = lg;
            if (valid) { mx = fmaxf(mx, lg); vm |= 1u << (nt * 4 + i); }
        }
    mx = fmaxf(mx, __shfl_xor(mx, 16)); mx = fmaxf(mx, __shfl_xor(mx, 32));
    const float mn = fmaxf(st.m, mx);
    const float sc = fexp(st.m - mn);
    float ls = 0.f;
#pragma unroll
    for (int nt = 0; nt < 2; ++nt)
#pragma unroll
        for (int i = 0; i < 4; ++i) { const float p = ((vm >> (nt * 4 + i)) & 1u) ? fexp(acc[nt][i] - mn) : 0.f; acc[nt][i] = p; ls += p; }
    st.l = st.l * sc + ls; st.m = mn;
#pragma unroll
    for (int dt = 0; dt < 4; ++dt) O[dt] = O[dt] * sc;
    u32x4 w; w.x = pk2(acc[0][0], acc[0][1]); w.y = pk2(acc[0][2], acc[0][3]); w.z = pk2(acc[1][0], acc[1][1]); w.w = pk2(acc[1][2], acc[1][3]);
    pB = __builtin_bit_cast(bf16x8, w);
}


__device__ __forceinline__ void load_kh8(long (&kf)[2][2], const unsigned char* Kb, int hh, int lane) {
#pragma unroll
    for (int nt = 0; nt < 2; ++nt)
#pragma unroll
        for (int kk = 0; kk < 2; ++kk) kf[nt][kk] = *(const long*)(Kb + (((2 * hh + nt) * 2 + kk) * 64 + lane) * 8);
}
__device__ __forceinline__ void load_vh8(long (&vf)[4], const unsigned char* Vb, int hh, int lane) {
#pragma unroll
    for (int dt = 0; dt < 4; ++dt) vf[dt] = *(const long*)(Vb + ((dt * 2 + hh) * 64 + lane) * 8);
}
__device__ __forceinline__ void qk_acch8(f32x4 (&acc)[2], const long (&kf)[2][2], const long (&q)[2]) {
#pragma unroll
    for (int nt = 0; nt < 2; ++nt) { acc[nt] = __builtin_amdgcn_mfma_f32_16x16x32_fp8_fp8(kf[nt][0], q[0], acc[nt], 0, 0, 0); acc[nt] = __builtin_amdgcn_mfma_f32_16x16x32_fp8_fp8(kf[nt][1], q[1], acc[nt], 0, 0, 0); }
}
__device__ __forceinline__ void pv_acch8(f32x4 (&O)[4], const long (&vf)[4], const long p8) {
#pragma unroll
    for (int dt = 0; dt < 4; ++dt) O[dt] = __builtin_amdgcn_mfma_f32_16x16x32_fp8_fp8(vf[dt], p8, O[dt], 0, 0, 0);
}
constexpr float P8_SCALE = 256.f;
__device__ __forceinline__ long p_to_fp8(const f32x4 (&acc)[2]) {
    return pack8_fp8(acc[0][0] * P8_SCALE, acc[0][1] * P8_SCALE, acc[0][2] * P8_SCALE, acc[0][3] * P8_SCALE, acc[1][0] * P8_SCALE, acc[1][1] * P8_SCALE, acc[1][2] * P8_SCALE, acc[1][3] * P8_SCALE);
}

__device__ __forceinline__ void nsa_wave(CArgs* Ap, int l, int b, int g, int tq0, const LAS float* lut, LAS float* imp, int lane) {
    unsigned char* ws = Ap->ws;
    const bf16_t* P = (const bf16_t*)(ws + p_off(l));
    const bf16_t* KC = (const bf16_t*)(ws + WS_KC + (size_t)l * MiB) + (size_t)(b * 4 + g) * 8 * 4096;
    const bf16_t* VCT = (const bf16_t*)(ws + WS_VCT + (size_t)l * MiB) + (size_t)(b * 4 + g) * 8 * 4096;
    const bf16_t* VST = (const bf16_t*)(ws + vt_off(l)) + (size_t)(b * 4 + g) * 128 * 4096;
    const bf16_t* VWT = (const bf16_t*)(ws + vt_off(l) + 8 * MiB) + (size_t)(b * 4 + g) * 128 * 4096;
    bf16_t* MIX = (bf16_t*)(ws + WS_MIX);
    const int n16 = lane & 15, g4 = lane >> 4, qi = n16 >> 2, r = n16 & 3;
    const int t = tq0 + qi;
    const bf16_t* prow = P + ((size_t)b * SEQ + t) * NINP;
    bf16x8 qB[2];
    qB[0] = *(const bf16x8*)(prow + C_Q + (4 * g + r) * 64 + 8 * g4); qB[1] = *(const bf16x8*)(prow + C_Q + (4 * g + r) * 64 + 8 * g4 + 32);
    float gt[3];
#pragma unroll
    for (int br = 0; br < 3; ++br) gt[br] = sigmoidf_(bf2f(prow[C_GATE + (4 * g + r) * 3 + br]));
    const LAS float* lutg = lut + g * 4096 + r;
    f32x4 outacc[4];
#pragma unroll
    for (int dt = 0; dt < 4; ++dt) outacc[dt] = (f32x4){0.f, 0.f, 0.f, 0.f};
#pragma unroll
    for (int i = 0; i < 8; ++i) *(LAS f32x4*)(imp + (i * 64 + lane) * 4) = (f32x4){0.f, 0.f, 0.f, 0.f};

    const int tmax = tq0 + 3;
    const int ncb = (tmax >= 31) ? ((((tmax - 31) >> 4) >> 6) + 1) : 0;
    {
        SmState st{-1e30f, 0.f};
        f32x4 Od[4];
#pragma unroll
        for (int dt = 0; dt < 4; ++dt) Od[dt] = (f32x4){0.f, 0.f, 0.f, 0.f};
        bf16x8 pB[2];
        for (int cb = 0; cb < ncb; ++cb) {
            bf16x8 kf[4][2]; load_k(kf, KC + (size_t)cb * 4096, lane);
            f32x4 acc[4];
#pragma unroll
            for (int nt = 0; nt < 4; ++nt) acc[nt] = (f32x4){0.f, 0.f, 0.f, 0.f};
            qk_acc(acc, kf, qB);
            softmax_block<0>(acc, cb * 64, true, t, g4, lutg, st, Od, pB);
        }
        float lt = st.l; lt += __shfl_xor(lt, 16); lt += __shfl_xor(lt, 32);
        const float inv = 1.f / fmaxf(lt, 1e-30f), mfin = st.m;
        for (int cb = 0; cb < ncb; ++cb) {
            bf16x8 kf[4][2]; load_k(kf, KC + (size_t)cb * 4096, lane);
            bf16x8 vf[4][2]; load_v(vf, VCT + (size_t)cb * 4096, lane);
            f32x4 acc[4];
#pragma unroll
            for (int nt = 0; nt < 4; ++nt) acc[nt] = (f32x4){0.f, 0.f, 0.f, 0.f};
            qk_acc(acc, kf, qB);
#pragma unroll
            for (int nt = 0; nt < 4; ++nt) {
                f32x4 pi4;
#pragma unroll
                for (int i = 0; i < 4; ++i) {
                    const int key = cb * 64 + 16 * nt + 4 * g4 + i; const int dist = t - (16 * key + 31);
                    int dc = dist < 0 ? 0 : dist; dc = dc > 1023 ? 1023 : dc;
                    const float lg = acc[nt][i] + lutg[dc * 4];
                    float p = (dist >= 0) ? fexp(lg - mfin) * inv : 0.f;
                    acc[nt][i] = p;
                    p += __shfl_xor(p, 1); p += __shfl_xor(p, 2);
                    pi4[i] = p;
                }
                if (r == 0) *(LAS f32x4*)(imp + qi * 512 + cb * 64 + 16 * nt + 4 * g4) = pi4;
            }
#pragma unroll
            for (int hh = 0; hh < 2; ++hh) { u32x4 w; w.x = pk2(acc[2 * hh][0], acc[2 * hh][1]); w.y = pk2(acc[2 * hh][2], acc[2 * hh][3]); w.z = pk2(acc[2 * hh + 1][0], acc[2 * hh + 1][1]); w.w = pk2(acc[2 * hh + 1][2], acc[2 * hh + 1][3]);
                pB[hh] = __builtin_bit_cast(bf16x8, w); }
            pv_acc(outacc, vf, pB);
        }
#pragma unroll
        for (int dt = 0; dt < 4; ++dt) outacc[dt] = outacc[dt] * gt[0];
    }
    wave_lds_fence();

    const int cur = tq0 >> 6;
    int selreg = -1;
    if (cur < 16) selreg = (n16 <= cur) ? n16 : -1;
    else {
        const int sq = lane >> 4, tsel = tq0 + sq; (void)tsel;
        float sc[8];
#pragma unroll
        for (int jj = 0; jj < 8; ++jj) { const int j = n16 + 16 * jj;
            float v;
            if (j > cur) v = -1.f;
            else if (j == 0 || j == cur || j == cur - 1) v = 1e4f;
            else { const LAS float* ip = imp + sq * 512 + 4 * j; v = ip[0] + 2.f * (ip[-1] + ip[-2] + ip[-3]) + ip[-4]; }
            sc[jj] = v; }
        for (int s = 0; s < 16; ++s) {
            float bv = sc[0]; int bj = n16;
#pragma unroll
            for (int jj = 1; jj < 8; ++jj) if (sc[jj] > bv) { bv = sc[jj]; bj = n16 + 16 * jj; }
#pragma unroll
            for (int off = 1; off < 16; off <<= 1) { const float ov = __shfl_xor(bv, off); const int oj = __shfl_xor(bj, off); if (ov > bv || (ov == bv && oj < bj)) { bv = ov; bj = oj; } }
            if (n16 == s) selreg = (bv >= 0.f) ? bj : -1;
#pragma unroll
            for (int jj = 0; jj < 8; ++jj) if (bj == n16 + 16 * jj) sc[jj] = -2.f;
        }
    }
    if (cur >= 16) {
        const int fj = selreg;
        const int key = (fj < 0) ? ((1 << 20) + n16) : ((fj == 0 || fj == cur || fj == cur - 1) ? fj : (1 << 10) + fj);
        int rank = 0;
#pragma unroll
        for (int o = 1; o < 16; ++o) { const int other = __shfl(key, (lane & 48) | ((n16 + o) & 15)); rank += (other < key) ? 1 : 0; }
        selreg = __builtin_amdgcn_ds_permute(((lane & 48) | rank) << 2, fj);
    }
    const int nvalid = (cur + 1) < 16 ? (cur + 1) : 16;
    wave_lds_fence();
#pragma unroll
    for (int dt = 0; dt < 4; ++dt) *(LAS f32x4*)(imp + (dt * 64 + lane) * 4) = outacc[dt];

    {
        SmState st{-1e30f, 0.f};
        f32x4 Od[4];
#pragma unroll
        for (int dt = 0; dt < 4; ++dt) Od[dt] = (f32x4){0.f, 0.f, 0.f, 0.f};
        const unsigned char* Ks8 = (const unsigned char*)(ws + WS_KST) + (size_t)(b * 4 + g) * 128 * 4096;
        const unsigned char* Vs8 = (const unsigned char*)(ws + WS_VST) + (size_t)(b * 4 + g) * 128 * 4096;
        long q8[2];
#pragma unroll
        for (int kk = 0; kk < 2; ++kk) { const u32x4 w = __builtin_bit_cast(u32x4, qB[kk]);
            q8[kk] = pack8_fp8(bflo(w.x), bfhi(w.x), bflo(w.y), bfhi(w.y), bflo(w.z), bfhi(w.z), bflo(w.w), bfhi(w.w)); }
        int ns = 0;
        for (; ns < nvalid; ++ns) { const int j0 = __builtin_amdgcn_readlane(selreg, ns), j1 = __builtin_amdgcn_readlane(selreg, 16 + ns), j2 = __builtin_amdgcn_readlane(selreg, 32 + ns), j3 = __builtin_amdgcn_readlane(selreg, 48 + ns);
            if (!(j0 >= 0 && j0 == j1 && j0 == j2 && j0 == j3)) break; }
        for (int hs = 0; hs < 2 * ns; ++hs) {
            const int s = hs >> 1, hh = hs & 1;
            const int j = __builtin_amdgcn_readlane(selreg, s);
            long kh[2][2]; load_kh8(kh, Ks8 + (size_t)j * 4096, hh, lane);
            long vh[4]; load_vh8(vh, Vs8 + (size_t)j * 4096, hh, lane);
            f32x4 acc[2];
            acc[0] = (f32x4){0.f, 0.f, 0.f, 0.f}; acc[1] = (f32x4){0.f, 0.f, 0.f, 0.f};
            qk_acch8(acc, kh, q8);
            if (__all(t - (j * 64 + 32 * hh + 31) >= 1023)) softmax_half_far(acc, lutg, st, Od);
            else { bf16x8 pB; softmax_half<1>(acc, j * 64 + 32 * hh, true, t, g4, lutg, st, Od, pB); }
            pv_acch8(Od, vh, p_to_fp8(acc));
        }
        const int nh = 2 * nvalid, h0 = 2 * ns;
        long q8m[4][2];
#pragma unroll
        for (int q2 = 0; q2 < 4; ++q2) { q8m[q2][0] = (qi == q2) ? q8[0] : 0l; q8m[q2][1] = (qi == q2) ? q8[1] : 0l; }
        long kq[4][2][2], vq[4][4];
        if (h0 < nh) {
#pragma unroll
            for (int q2 = 0; q2 < 4; ++q2) { int j = __builtin_amdgcn_readlane(selreg, 16 * q2 + ns); j = j < 0 ? 0 : j; load_kh8(kq[q2], Ks8 + (size_t)j * 4096, 0, lane); load_vh8(vq[q2], Vs8 + (size_t)j * 4096, 0, lane); } }
        for (int hs = h0; hs < nh; ++hs) {
            const int s = hs >> 1, hh = hs & 1;
            const int jm = __shfl(selreg, 16 * qi + s);
            f32x4 acc[2];
            acc[0] = (f32x4){0.f, 0.f, 0.f, 0.f}; acc[1] = (f32x4){0.f, 0.f, 0.f, 0.f};
#pragma unroll
            for (int q2 = 0; q2 < 4; ++q2) qk_acch8(acc, kq[q2], q8m[q2]);
            const bool more = hs + 1 < nh; const int s1 = (hs + 1) >> 1, h1 = (hs + 1) & 1;
            int jn[4];
#pragma unroll
            for (int q2 = 0; q2 < 4; ++q2) { int j = more ? __builtin_amdgcn_readlane(selreg, 16 * q2 + s1) : 0; jn[q2] = j < 0 ? 0 : j; }
            if (more) {
#pragma unroll
                for (int q2 = 0; q2 < 4; ++q2) load_kh8(kq[q2], Ks8 + (size_t)jn[q2] * 4096, h1, lane); }
            if (__all(jm >= 0 && t - (jm * 64 + 32 * hh + 31) >= 1023)) softmax_half_far(acc, lutg, st, Od);
            else { bf16x8 pB; softmax_half<1>(acc, (jm < 0 ? 0 : jm) * 64 + 32 * hh, jm >= 0, t, g4, lutg, st, Od, pB); }
            const long p8 = p_to_fp8(acc);
#pragma unroll
            for (int q2 = 0; q2 < 4; ++q2) { const long pm = (qi == q2) ? p8 : 0l; pv_acch8(Od, vq[q2], pm); }
            if (more) {
#pragma unroll
                for (int q2 = 0; q2 < 4; ++q2) load_vh8(vq[q2], Vs8 + (size_t)jn[q2] * 4096, h1, lane); }
        }
        float lt = st.l; lt += __shfl_xor(lt, 16); lt += __shfl_xor(lt, 32);
        const float sc = gt[1] / (P8_SCALE * fmaxf(lt, 1e-30f));
#pragma unroll
        for (int dt = 0; dt < 4; ++dt) outacc[dt] = Od[dt] * sc;
    }

    {
        SmState st{-1e30f, 0.f};
        f32x4 Od[4];
#pragma unroll
        for (int dt = 0; dt < 4; ++dt) Od[dt] = (f32x4){0.f, 0.f, 0.f, 0.f};
        const bf16_t* Kw = (const bf16_t*)(ws + WS_KWT) + (size_t)(b * 4 + g) * 128 * 4096;
        const int lo = tq0 - 511, jb0 = (lo > 0 ? lo : 0) >> 6, jb1 = (tq0 + 3) >> 6;
        for (int jb = jb0; jb <= jb1; ++jb) {
            bf16x8 kf[4][2]; load_k(kf, Kw + (size_t)jb * 4096, lane);
            bf16x8 vf[4][2]; load_v(vf, VWT + (size_t)jb * 4096, lane);
            f32x4 acc[4];
#pragma unroll
            for (int nt = 0; nt < 4; ++nt) acc[nt] = (f32x4){0.f, 0.f, 0.f, 0.f};
            qk_acc(acc, kf, qB);
            bf16x8 pB[2];
            softmax_block<2>(acc, jb * 64, true, t, g4, lutg, st, Od, pB);
            pv_acc(Od, vf, pB);
        }
        float lt = st.l; lt += __shfl_xor(lt, 16); lt += __shfl_xor(lt, 32);
        const float sc = gt[2] / fmaxf(lt, 1e-30f);
#pragma unroll
        for (int dt = 0; dt < 4; ++dt) outacc[dt] = outacc[dt] + Od[dt] * sc;
    }
    wave_lds_fence();
#pragma unroll
    for (int dt = 0; dt < 4; ++dt) outacc[dt] = outacc[dt] + *(const LAS f32x4*)(imp + (dt * 64 + lane) * 4);
    bf16_t* orow = MIX + ((size_t)b * SEQ + t) * DM + DSSM + (4 * g + r) * 64 + 4 * g4;
#pragma unroll
    for (int dt = 0; dt < 4; ++dt) { u32x2 w; w.x = pk2(outacc[dt][0], outacc[dt][1]); w.y = pk2(outacc[dt][2], outacc[dt][3]); *(u32x2*)(orow + 16 * dt) = w; }
    wave_lds_fence();
}

__global__ void __launch_bounds__(512, 2) hymba_fwd(Args A_unused) {
    extern __shared__ __attribute__((aligned(16))) unsigned char lds_raw[];
    LAS unsigned char* lds = (LAS unsigned char*)lds_raw;
    cg::grid_group grid = cg::this_grid();
#define GRID_SYNC() do { asm volatile("s_waitcnt vmcnt(0) lgkmcnt(0)" ::: "memory"); grid.sync(); \
    asm volatile("buffer_inv sc1\n\ts_waitcnt vmcnt(0) lgkmcnt(0)" ::: "memory"); } while (0)
    const int wave0 = __builtin_amdgcn_readfirstlane(threadIdx.x >> 6);
#define PHASE_IDS() int wv_ = wave0; asm volatile("" : "+s"(wv_)); int tid; asm volatile("v_mbcnt_lo_u32_b32 %0, -1, 0\n\tv_mbcnt_hi_u32_b32 %0, -1, %0" : "=v"(tid)); tid += wv_ * 64; asm volatile("" : "+v"(tid)); const int lane = tid & 63, wave = __builtin_amdgcn_readfirstlane(tid >> 6); \
    int G = gridDim.x, blk = blockIdx.x; asm volatile("" : "+s"(G), "+s"(blk)); const int gw = blk * 8 + wave, NGW = G * 8; (void)lane; (void)gw; (void)NGW;

    unsigned nsync = 0;
#define FAST_SYNC() do { asm volatile("s_waitcnt vmcnt(0) lgkmcnt(0)" ::: "memory"); __syncthreads(); ++nsync; \
    { int l0_; asm volatile("v_mbcnt_lo_u32_b32 %0, -1, 0\n\tv_mbcnt_hi_u32_b32 %0, -1, %0" : "=v"(l0_)); \
      if (wave0 == 0 && l0_ == 0) { unsigned* bar_ = (unsigned*)(get_args()->ws + WS_CTL); const unsigned tgt_ = nsync * gridDim.x; \
        __builtin_amdgcn_fence(__ATOMIC_RELEASE, "agent"); asm volatile("s_waitcnt vmcnt(0)" ::: "memory"); \
        __hip_atomic_fetch_add(bar_, 1u, __ATOMIC_RELAXED, __HIP_MEMORY_SCOPE_AGENT); \
        for (unsigned sp_ = 0; sp_ < (1u << 22); ++sp_) { if (__hip_atomic_load(bar_, __ATOMIC_RELAXED, __HIP_MEMORY_SCOPE_AGENT) >= tgt_) break; __builtin_amdgcn_s_sleep(2); } } } \
    __syncthreads(); asm volatile("buffer_inv sc1\n\ts_waitcnt vmcnt(0) lgkmcnt(0)" ::: "memory"); } while (0)

    { PHASE_IDS(); if (blk == 0 && tid == 0) __hip_atomic_store((unsigned*)(get_args()->ws + WS_CTL), 0u, __ATOMIC_RELAXED, __HIP_MEMORY_SCOPE_AGENT);
      prologue(lds, wave, lane, gw, NGW); }
    GRID_SYNC();

#pragma nounroll
    for (int l = 0; l < DEPTH; ++l) {
        {
            PHASE_IDS(); CArgs* Ap = get_args(); unsigned char* ws = Ap->ws;
            pg8::Gemm g{(const bf16_t*)(ws + WS_XB), (const bf16_t*)(ws + WS_WIN) + (size_t)l * NINP * DM, MTOK, NINP, DM}; pg8::StaticOrder S; S.init(MTOK, NINP, G, blk);
            const float* rq = (const float*)(ws + WS_RSQ) + (size_t)(2 * l) * RSQ_BUF; LAS float* tab = (LAS float*)(lds + 131072);
            pg8::Unit u0; const int pm0 = S.next(0, u0) ? u0.pm : -1; if (pm0 >= 0) rstd_table(rq, pm0, tab, tid); else __syncthreads();
            EpiInProj E{ws, rq, tab, pm0};
            pg8::gemm_phase<EpiInProj, pg8::StaticOrder, true, true>(lds, g, S, E, tid);
        }
        FAST_SYNC();
        {
            PHASE_IDS(); CArgs* Ap = get_args();
            for (int wt = blk; wt < 256; wt += G) { const int b_ = wt >> 7, cp_ = (wt >> 4) & 7, gq_ = wt & 15;
                s5_task<1>(Ap, l, b_, 4 * gq_ + (wave & 3), 2 * cp_ + (wave >> 2), lds + wave * 8192, lane); }
            if (wave < 2) for (int task = blk * 2 + wave; task < 512; task += G * 2) compress_task(Ap, l, task, lane);
        }
        FAST_SYNC();
        {
            PHASE_IDS(); CArgs* Ap = get_args();
            for (int wt = blk; wt < 256; wt += G) { const int b_ = wt >> 7, cp_ = (wt >> 4) & 7, gq_ = wt & 15;
                s5_task<2>(Ap, l, b_, 4 * gq_ + (wave & 3), 2 * cp_ + (wave >> 2), lds + wave * 8192, lane); }
            __syncthreads();
            LAS float* lut = (LAS float*)lds;
            { const float* tab = Ap->in[1];
              for (int e = tid; e < 4 * 1024 * 4; e += 512) { const int r = e & 3, dist = (e >> 2) & 1023, gg = e >> 12; lut[e] = tab[rel_bucket_i(dist) * 16 + gg * 4 + r]; } }
            __syncthreads();
            LAS float* imp = (LAS float*)(lds + 65536 + wave * 8192);
            for (int i = 0; ; ++i) {
                const int unit = i * G + blk; if (unit >= 2048) break;
                const int bg = unit >> 8; int qt = unit & 255; qt = ((qt & 7) << 5) | (qt >> 3);
                if (i & 1) qt = 255 - qt;
                nsa_wave(Ap, l, bg >> 2, bg & 3, qt * 32 + wave * 4, lut, imp, lane);
            }
            __syncthreads();
        }
        FAST_SYNC();
        {
            PHASE_IDS(); CArgs* Ap = get_args(); unsigned char* ws = Ap->ws;
            pg8::Gemm g{(const bf16_t*)(ws + WS_Y1), (const bf16_t*)(ws + WS_WGLU) + (size_t)l * 2 * DSSM * DSSM, MTOK, 2 * DSSM, DSSM}; pg8::StaticOrder S; S.init(MTOK, 2 * DSSM, G, blk);
            EpiGlu E{(bf16_t*)(ws + WS_MIX), Ap->in[15] + (size_t)l * 2 * DSSM};
            pg8::gemm_phase<EpiGlu, pg8::StaticOrder, true, true>(lds, g, S, E, tid);
        }
        FAST_SYNC();
        {
            PHASE_IDS(); CArgs* Ap = get_args(); unsigned char* ws = Ap->ws;
            pg8::Gemm g{(const bf16_t*)(ws + WS_MIX), (const bf16_t*)(ws + WS_WOUT) + (size_t)l * DM * DM, MTOK, DM, DM}; pg8::StaticOrder S; S.init(MTOK, DM, G, blk);
            EpiResid E{(bf16_t*)(ws + WS_XB), (float*)(ws + WS_RSQ) + (size_t)(2 * l + 1) * RSQ_BUF};
            pg8::gemm_phase<EpiResid, pg8::StaticOrder, true, true>(lds, g, S, E, tid);
        }
        FAST_SYNC();
        {
            PHASE_IDS(); CArgs* Ap = get_args(); unsigned char* ws = Ap->ws;
            pg8::Gemm g{(const bf16_t*)(ws + WS_XB), (const bf16_t*)(ws + WS_WGU) + (size_t)l * 2 * DFF * DM, MTOK, 2 * DFF, DM}; pg8::StaticOrder S; S.init(MTOK, 2 * DFF, G, blk);
            const float* rq = (const float*)(ws + WS_RSQ) + (size_t)(2 * l + 1) * RSQ_BUF; LAS float* tab = (LAS float*)(lds + 131072);
            pg8::Unit u0; const int pm0 = S.next(0, u0) ? u0.pm : -1; if (pm0 >= 0) rstd_table(rq, pm0, tab, tid); else __syncthreads();
            EpiSwiglu E{(bf16_t*)(ws + WS_HID), rq, tab, pm0};
            pg8::gemm_phase<EpiSwiglu, pg8::StaticOrder, true, true>(lds, g, S, E, tid);
        }
        FAST_SYNC();
        {
            PHASE_IDS(); CArgs* Ap = get_args(); unsigned char* ws = Ap->ws;
            pg8::Gemm g{(const bf16_t*)(ws + WS_HID), (const bf16_t*)(ws + WS_WDN) + (size_t)l * DM * DFF, MTOK, DM, DFF}; pg8::StaticOrder S; S.init(MTOK, DM, G, blk);
            EpiResid E{(bf16_t*)(ws + WS_XB), (float*)(ws + WS_RSQ) + (size_t)(2 * l + 2) * RSQ_BUF};
            pg8::gemm_phase<EpiResid, pg8::StaticOrder, true, true>(lds, g, S, E, tid);
        }
        FAST_SYNC();
    }
    {
        PHASE_IDS(); CArgs* Ap = get_args();
        const float* fr = (const float*)(Ap->ws + WS_RSQ) + (size_t)(2 * DEPTH) * RSQ_BUF; const float* gn = Ap->in[4]; float* out = Ap->out;
        for (int m = gw; m < MTOK; m += NGW) {
            const float sq = wave_sum(lane < 32 ? fr[(size_t)lane * MTOK + m] : 0.f);
            const float rstd = rsqrtf(sq * (1.f / DM) + EPS);
            f32x4* xo = (f32x4*)(out + (size_t)m * DM) + lane; const f32x4* gp = (const f32x4*)gn + lane; const u32x2* xb = (const u32x2*)((const bf16_t*)(Ap->ws + WS_XB) + (size_t)m * DM) + lane;
#pragma unroll
            for (int j = 0; j < 8; ++j) { const u32x2 q = xb[64 * j]; f32x4 v = (f32x4){bflo(q.x), bfhi(q.x), bflo(q.y), bfhi(q.y)}; const f32x4 gg = gp[64 * j]; v = v * rstd * gg; xo[64 * j] = v; }
        }
    }
}

extern "C" void kernel_launch(void* const* d_in, const int* in_sizes, int n_in, void* d_out, int out_size, void* d_ws, size_t ws_size, hipStream_t stream) {
    static int grid = 0;
    if (grid == 0) {
        if (n_in != 26 || ws_size < WS_END) { fprintf(stderr, "kernel_launch: unexpected inputs (n_in %d, ws %zu, need %zu)\n", n_in, ws_size, (size_t)WS_END); grid = -1; return; }
        int dev = 0, cus = 0, per_cu = 0;
        hipGetDevice(&dev); hipDeviceGetAttribute(&cus, hipDeviceAttributeMultiprocessorCount, dev);
        hipFuncSetAttribute((const void*)hymba_fwd, hipFuncAttributeMaxDynamicSharedMemorySize, LDS_BYTES);
        hipOccupancyMaxActiveBlocksPerMultiprocessor(&per_cu, (const void*)hymba_fwd, 512, LDS_BYTES);
        if (per_cu < 1) { fprintf(stderr, "kernel_launch: occupancy query says %d blocks per CU\n", per_cu); per_cu = 1; }
        grid = cus * 1;
        (void)hipGetLastError();
    }
    if (grid < 0) return;
    Args a{};
    for (int i = 0; i < 26; ++i) a.in[i] = (const float*)d_in[i];
    a.out = (float*)d_out; a.ws = (unsigned char*)d_ws;
    void* args[] = {&a};
    hipError_t e = hipLaunchCooperativeKernel((const void*)hymba_fwd, dim3(grid), dim3(512), args, LDS_BYTES, stream);
    if (e != hipSuccess) fprintf(stderr, "cooperative launch failed: %s (grid %d)\n", hipGetErrorString(e), grid);
}
```

```cpp
#include <hip/hip_runtime.h>
#include <hip/hip_cooperative_groups.h>
#include <cstdio>
#include <cstdint>
namespace cg = cooperative_groups;

#define LAS __attribute__((address_space(3)))
typedef unsigned short bf16_t;
typedef short bf16x8 __attribute__((ext_vector_type(8)));
typedef short s16x4 __attribute__((ext_vector_type(4)));
typedef float f32x4 __attribute__((ext_vector_type(4)));
typedef float f32x2 __attribute__((ext_vector_type(2)));
typedef unsigned u32x4 __attribute__((ext_vector_type(4)));
typedef unsigned u32x2 __attribute__((ext_vector_type(2)));

constexpr int NB = 2, SEQ = 8192, MTOK = NB * SEQ, DM = 2048, DEPTH = 4;
constexpr int NIN = 3632, NINP = 3840;
constexpr int DSSM = 1024, NGRP = 64, NST = 64;
constexpr int NKV = 4, HD = 64;
constexpr int DFF = 5632;
constexpr int NCHUNK = 16, CHUNK = SEQ / NCHUNK;
constexpr float EPS = 1e-6f;
constexpr int C_Q = 1024, C_KC = 2048, C_VC = 2304, C_KS = 2560, C_KW = 3072, C_GATE = 3584;

constexpr size_t MiB = 1u << 20;
constexpr size_t WS_CTL = 0;
constexpr size_t WS_WIN = 1 * MiB;
constexpr size_t WS_WGLU = WS_WIN + 60 * MiB;
constexpr size_t WS_WOUT = WS_WGLU + 16 * MiB;
constexpr size_t WS_WGU = WS_WOUT + 32 * MiB;
constexpr size_t WS_WDN = WS_WGU + 176 * MiB;
constexpr size_t WS_CW1 = WS_WDN + 88 * MiB;
constexpr size_t WS_CW2 = WS_CW1 + 4 * MiB;
constexpr size_t WS_XB = WS_CW2 + 1 * MiB;
constexpr size_t WS_P = WS_XB + 64 * MiB;
constexpr size_t WS_Y1 = WS_P + 120 * MiB;
constexpr size_t WS_MIX = WS_Y1 + 32 * MiB;
constexpr size_t WS_HID = WS_P;
constexpr size_t WS_VST = WS_MIX + 64 * MiB;
constexpr size_t WS_VWT = WS_VST + 8 * MiB;
constexpr size_t WS_KC = WS_VWT + 8 * MiB;
constexpr size_t WS_VCT = WS_KC + 4 * MiB;
constexpr size_t WS_SST = WS_VCT + 4 * MiB;
constexpr size_t WS_RSQ = WS_SST + 4 * MiB;
constexpr size_t WS_P1 = WS_RSQ + 18 * MiB;
constexpr size_t WS_VT1 = WS_P1 + 120 * MiB;
constexpr size_t WS_END = WS_P1 + 16 * MiB;
__host__ __device__ __forceinline__ size_t p_off(int) { return WS_P; }
__host__ __device__ __forceinline__ size_t vt_off(int) { return WS_VST; }
constexpr size_t WS_KST = WS_P1;
constexpr size_t WS_KWT = WS_P1 + 8 * MiB;
constexpr size_t RSQ_BUF = (size_t)32 * MTOK;

constexpr int LDS_BYTES = 135168;

namespace pg8 {
constexpr int BM = 256, BK = 64, HALF = 128, HTB = HALF * BK * 2, STAGE_BYTES = 8 * HTB, NXCD = 8, WGM = 8;
__host__ __device__ __forceinline__ int lds_byte(int r, int c) { const int st = (r >> 4) * 2 + (c >> 5), rr = r & 15, cc = c & 31, ob = rr * 64 + cc * 2; return st * 1024 + (ob ^ (((ob >> 9) & 1) << 5)); }
__host__ __device__ __forceinline__ void stage_rc(int b, int& R, int& C) { const int st = b / 1024, sb = b % 1024, swz = sb ^ (((sb >> 9) & 1) << 5); R = (st >> 1) * 16 + swz / 64; C = (st & 1) * 32 + (swz % 64) / 2; }
struct Unit { int pm, pn; };
struct Gemm { const bf16_t* A; const bf16_t* Bt; int M, N, K; };
struct StaticOrder {
    int nM, nN, nwg, G, c;
    __host__ __device__ void init(int M, int N, int G_, int c_) { nM = M / BM; nN = N / BM; nwg = nM * nN; G = G_; c = c_; }
    __host__ __device__ bool next(int i, Unit& u) const {
        const long L = (long)i * G + c; if (L >= nwg) return false;
        int wgid = (int)L; { const int q = nwg / NXCD, r = nwg % NXCD, xcd = wgid % NXCD, off = wgid / NXCD; wgid = (xcd < r ? xcd * (q + 1) : r * (q + 1) + (xcd - r) * q) + off; }
        const int nig = WGM * nN, gid = wgid / nig, fm = gid * WGM, gsz = (nM - fm) < WGM ? (nM - fm) : WGM;
        u.pm = fm + ((wgid % nig) % gsz); u.pn = (wgid % nig) / gsz; return true;
    }
};
typedef float f32x2_cv __attribute__((ext_vector_type(2))); typedef __bf16 bf16x2_cv __attribute__((ext_vector_type(2)));
__device__ __forceinline__ unsigned cvt_pk_bf16(float lo, float hi) { const f32x2_cv v = {lo, hi}; const bf16x2_cv b = __builtin_convertvector(v, bf16x2_cv); return __builtin_bit_cast(unsigned, b); }

template <class Epi, class Sched, bool ALIGN_EPI = false, bool SP2 = false>
__device__ __forceinline__ void gemm_phase(LAS unsigned char* lds, const Gemm g, const Sched& S, const Epi& E, const int tid) {
    const int wid = __builtin_amdgcn_readfirstlane(tid >> 6), lane = tid & 63, wr = wid >> 2, wc = wid & 3, fr = lane & 15, fq = lane >> 4;
    const int K = g.K, nt = K / BK;
    unsigned voffA[2], voffB[2];
#pragma unroll
    for (int i = 0; i < 2; ++i) { int R, C; stage_rc(tid * 16 + i * 8192, R, C); voffA[i] = (unsigned)(R * K + C) * 2u; voffB[i] = voffA[i]; }
    const size_t kstep = (size_t)(BK * 2);
    const size_t hstep = (size_t)HALF * K * 2;
    const size_t tstep = 2 * hstep;
    const unsigned ldsw = (unsigned)wid * 1024u;
    const int aoff = lds_byte(wr * 64 + fr, fq * 8), boff = lds_byte(wc * 32 + fr, fq * 8);
#define PG8_SA(b, h) (((b) * 2 + (h)) * HTB)
#define PG8_SB(b, h) ((4 + (b) * 2 + (h)) * HTB)
#define PG8_STAGE(bufoff, gbase, voff) do { _Pragma("unroll") for (int _i = 0; _i < 2; ++_i) \
        __builtin_amdgcn_global_load_lds((const unsigned*)((const char*)(gbase) + (voff)[_i]), (LAS unsigned*)(lds + (bufoff) + ldsw + _i * 8192), 16, 0, 0); } while (0)
#define PG8_LDA(dst, b, h) do { _Pragma("unroll") for (int m = 0; m < 4; ++m) _Pragma("unroll") for (int k = 0; k < 2; ++k) dst[m][k] = *(const LAS bf16x8*)(lds + PG8_SA(b, h) + aoff + m * 2048 + k * 1024); } while (0)
#define PG8_LDB(dst, b, h) do { _Pragma("unroll") for (int n = 0; n < 2; ++n) _Pragma("unroll") for (int k = 0; k < 2; ++k) dst[n][k] = *(const LAS bf16x8*)(lds + PG8_SB(b, h) + boff + n * 2048 + k * 1024); } while (0)
#define PG8_MMA(ai, bj, At, Bt) do { __builtin_amdgcn_s_setprio(1); _Pragma("unroll") for (int m = 0; m < 4; ++m) _Pragma("unroll") for (int n = 0; n < 2; ++n) _Pragma("unroll") for (int k = 0; k < 2; ++k) \
        acc[ai][bj][m][n] = __builtin_amdgcn_mfma_f32_16x16x32_bf16(Bt[n][k], At[m][k], acc[ai][bj][m][n], 0, 0, 0); __builtin_amdgcn_s_setprio(0); } while (0)
#define PG8_WAIT_V(n) asm volatile("s_waitcnt vmcnt(" #n ")" ::: "memory")
#define PG8_WAIT_L(n) asm volatile("s_waitcnt lgkmcnt(" #n ")" ::: "memory")
#define PG8_BAR __builtin_amdgcn_s_barrier()
#define PG8_SCHED __builtin_amdgcn_sched_barrier(0)
    Unit cur, nxt; int ui = 0;
    if (!S.next(0, cur)) return;
    f32x4 acc[2][2][4][2];
#pragma unroll
    for (int a = 0; a < 2; ++a)
#pragma unroll
        for (int b = 0; b < 2; ++b)
#pragma unroll
            for (int m = 0; m < 4; ++m)
#pragma unroll
                for (int n = 0; n < 2; ++n) acc[a][b][m][n] = (f32x4){0.f, 0.f, 0.f, 0.f};
    bf16x8 At[4][2], B0[2][2], B1[2][2];
    const char* cA = (const char*)g.A + (size_t)cur.pm * tstep; const char* cB = (const char*)g.Bt + (size_t)cur.pn * tstep;
    if constexpr (SP2) {
        PG8_STAGE(PG8_SB(0, 0), cB, voffB); PG8_STAGE(PG8_SB(0, 1), cB + hstep, voffB); PG8_STAGE(PG8_SA(0, 0), cA, voffA); PG8_STAGE(PG8_SA(0, 1), cA + hstep, voffA);
        if (wr == 1) PG8_BAR;
        PG8_WAIT_V(2); PG8_BAR;
        PG8_STAGE(PG8_SB(1, 0), cB + kstep, voffB); PG8_STAGE(PG8_SA(1, 0), cA + kstep, voffA); PG8_STAGE(PG8_SB(1, 1), cB + hstep + kstep, voffB);
        PG8_WAIT_V(6); PG8_BAR;
    } else {
        PG8_STAGE(PG8_SB(0, 0), cB, voffB); PG8_STAGE(PG8_SA(0, 0), cA, voffA); PG8_STAGE(PG8_SB(0, 1), cB + hstep, voffB); PG8_STAGE(PG8_SA(0, 1), cA + hstep, voffA);
        if (wr == 1) PG8_BAR;
        PG8_WAIT_V(4); PG8_BAR;
        PG8_STAGE(PG8_SB(1, 0), cB + kstep, voffB); PG8_STAGE(PG8_SA(1, 0), cA + kstep, voffA); PG8_STAGE(PG8_SB(1, 1), cB + hstep + kstep, voffB);
        PG8_WAIT_V(6); PG8_BAR;
    }
    for (;;) {
        const bool has_next = S.next(ui + 1, nxt);
        const char* nA = has_next ? (const char*)g.A + (size_t)nxt.pm * tstep : cA; const char* nB = has_next ? (const char*)g.Bt + (size_t)nxt.pn * tstep : cB;
        for (int t = 0; t < nt; t += 2) {
            const bool last = (t == nt - 2);
            const char* a1 = cA + (size_t)(t + 1) * kstep;
            const char* a2 = last ? nA : cA + (size_t)(t + 2) * kstep; const char* b2 = last ? nB : cB + (size_t)(t + 2) * kstep;
            const char* a3 = a2 + kstep; const char* b3 = b2 + kstep;
            if constexpr (SP2) {
            PG8_LDB(B0, 0, 0); PG8_LDB(B1, 0, 1); PG8_SCHED; PG8_LDA(At, 0, 0); PG8_STAGE(PG8_SA(1, 1), a1 + hstep, voffA);
            PG8_WAIT_V(8); PG8_WAIT_L(0); PG8_BAR; PG8_MMA(0, 0, At, B0); PG8_MMA(0, 1, At, B1); PG8_BAR; PG8_SCHED;
            PG8_LDA(At, 0, 1); PG8_STAGE(PG8_SB(0, 0), b2, voffB); PG8_STAGE(PG8_SB(0, 1), b2 + hstep, voffB); PG8_STAGE(PG8_SA(0, 0), a2, voffA);
            PG8_WAIT_V(8); PG8_WAIT_L(0); PG8_BAR; PG8_MMA(1, 0, At, B0); PG8_MMA(1, 1, At, B1); PG8_BAR; PG8_SCHED;
            PG8_LDB(B0, 1, 0); PG8_LDB(B1, 1, 1); PG8_SCHED; PG8_LDA(At, 1, 0); PG8_STAGE(PG8_SA(0, 1), a2 + hstep, voffA);
            PG8_WAIT_V(8); PG8_WAIT_L(0); PG8_BAR; PG8_MMA(0, 0, At, B0); PG8_MMA(0, 1, At, B1); PG8_BAR; PG8_SCHED;
            PG8_LDA(At, 1, 1); PG8_STAGE(PG8_SB(1, 0), b3, voffB); PG8_STAGE(PG8_SB(1, 1), b3 + hstep, voffB); PG8_STAGE(PG8_SA(1, 0), a3, voffA);
            PG8_WAIT_V(8); PG8_WAIT_L(0); PG8_BAR; PG8_MMA(1, 0, At, B0); PG8_MMA(1, 1, At, B1); PG8_BAR; PG8_SCHED;
            } else {
            PG8_LDB(B0, 0, 0); PG8_SCHED; PG8_LDA(At, 0, 0); PG8_STAGE(PG8_SA(1, 1), a1 + hstep, voffA);
            PG8_WAIT_L(8); PG8_BAR; PG8_WAIT_L(0); PG8_MMA(0, 0, At, B0); PG8_BAR; PG8_SCHED;
            PG8_LDB(B1, 0, 1); PG8_STAGE(PG8_SB(0, 0), b2, voffB);
            PG8_BAR; PG8_WAIT_L(0); PG8_MMA(0, 1, At, B1); PG8_BAR;
            PG8_LDA(At, 0, 1); PG8_STAGE(PG8_SA(0, 0), a2, voffA);
            PG8_BAR; PG8_WAIT_L(0); PG8_MMA(1, 0, At, B0); PG8_BAR; PG8_SCHED;
            PG8_STAGE(PG8_SB(0, 1), b2 + hstep, voffB);
            PG8_WAIT_V(6); PG8_BAR; PG8_MMA(1, 1, At, B1); PG8_BAR;
            PG8_LDB(B0, 1, 0); PG8_SCHED; PG8_LDA(At, 1, 0); PG8_STAGE(PG8_SA(0, 1), a2 + hstep, voffA);
            PG8_WAIT_L(8); PG8_BAR; PG8_WAIT_L(0); PG8_MMA(0, 0, At, B0); PG8_BAR; PG8_SCHED;
            PG8_LDB(B1, 1, 1); PG8_STAGE(PG8_SB(1, 0), b3, voffB);
            PG8_BAR; PG8_WAIT_L(0); PG8_MMA(0, 1, At, B1); PG8_BAR;
            PG8_LDA(At, 1, 1); PG8_STAGE(PG8_SA(1, 0), a3, voffA);
            PG8_BAR; PG8_WAIT_L(0); PG8_MMA(1, 0, At, B0); PG8_BAR; PG8_SCHED;
            PG8_STAGE(PG8_SB(1, 1), b3 + hstep, voffB);
            PG8_WAIT_V(6); PG8_BAR; PG8_MMA(1, 1, At, B1); PG8_BAR;
            }
        }
        if constexpr (ALIGN_EPI) { if (wr == 0) PG8_BAR; }
        E(acc, cur, wr, wc, fr, fq);
        if (!has_next) break;
#pragma unroll
        for (int a = 0; a < 2; ++a)
#pragma unroll
            for (int b = 0; b < 2; ++b)
#pragma unroll
                for (int m = 0; m < 4; ++m)
#pragma unroll
                    for (int n = 0; n < 2; ++n) acc[a][b][m][n] = (f32x4){0.f, 0.f, 0.f, 0.f};
        cur = nxt; cA = nA; cB = nB; ++ui;
        if constexpr (ALIGN_EPI) { if (wr == 1) PG8_BAR; }
    }
    PG8_WAIT_V(0);
    if constexpr (!ALIGN_EPI) { if (wr == 0) PG8_BAR; }
    PG8_BAR;
#undef PG8_SA
#undef PG8_SB
#undef PG8_STAGE
#undef PG8_LDA
#undef PG8_LDB
#undef PG8_MMA
#undef PG8_WAIT_V
#undef PG8_WAIT_L
#undef PG8_BAR
#undef PG8_SCHED
}
}

__device__ __forceinline__ unsigned pk2(float lo, float hi) { return pg8::cvt_pk_bf16(lo, hi); }
__device__ __forceinline__ bf16_t f2bf(float f) { return (bf16_t)(pk2(f, f) & 0xffffu); }
__device__ __forceinline__ float bf2f(bf16_t h) { return __uint_as_float(((unsigned)h) << 16); }
__device__ __forceinline__ float bflo(unsigned w) { return __uint_as_float(w << 16); }
__device__ __forceinline__ float bfhi(unsigned w) { return __uint_as_float(w & 0xffff0000u); }
__device__ __forceinline__ float fexp(float x) { return __expf(x); }
__device__ __forceinline__ float sigmoidf_(float x) { return __builtin_amdgcn_rcpf(1.f + fexp(-x)); }
__device__ __forceinline__ float gelu_tanh(float x) { const float z = 0.7978845608f * (x + 0.044715f * x * x * x); const float e = fexp(2.f * z); const float th = 1.f - 2.f / (e + 1.f); return 0.5f * x * (1.f + th); }
__device__ __forceinline__ int vperm(int k) { return (k & 32) | (((k & 15) >> 2) << 3) | (k & 3) | (((k >> 4) & 1) << 2); }
__device__ __forceinline__ int kswz(int key, int d) { return ((((key >> 4) * 2 + (d >> 5)) * 64) + ((d >> 3) & 3) * 16 + (key & 15)) * 8 + (d & 7); }
__device__ __forceinline__ int vswz(int d, int key) { const int k = key & 31; return ((((d >> 4) * 2 + (key >> 5)) * 64) + ((k & 15) >> 2) * 16 + (d & 15)) * 8 + (k & 3) + 4 * (k >> 4); }
__device__ __forceinline__ void wave_lds_fence() { asm volatile("s_waitcnt lgkmcnt(0)" ::: "memory"); }
__device__ __forceinline__ float wave_sum(float v) {
#pragma unroll
    for (int o = 1; o < 64; o <<= 1) v += __shfl_xor(v, o);
    return v;
}
__device__ __forceinline__ bf16x8 zero8() { return (bf16x8){0, 0, 0, 0, 0, 0, 0, 0}; }

__device__ __forceinline__ long pack8_fp8(float a0, float a1, float a2, float a3, float a4, float a5, float a6, float a7) {
    int lo = 0, hi = 0;
    lo = __builtin_amdgcn_cvt_pk_fp8_f32(a0, a1, lo, false); lo = __builtin_amdgcn_cvt_pk_fp8_f32(a2, a3, lo, true);
    hi = __builtin_amdgcn_cvt_pk_fp8_f32(a4, a5, hi, false); hi = __builtin_amdgcn_cvt_pk_fp8_f32(a6, a7, hi, true);
    return (long)(((unsigned long long)(unsigned)hi << 32) | (unsigned long long)(unsigned)lo);
}
__device__ __forceinline__ unsigned pack4_fp8(float a0, float a1, float a2, float a3) {
    int lo = 0; lo = __builtin_amdgcn_cvt_pk_fp8_f32(a0, a1, lo, false); lo = __builtin_amdgcn_cvt_pk_fp8_f32(a2, a3, lo, true); return (unsigned)lo;
}
__device__ __forceinline__ void rstd_table(const float* part, int pm, LAS float* tab, int tid) {
    const int row = tid >> 1, hf = tid & 1; float s = 0.f;
#pragma unroll
    for (int k = 0; k < 16; ++k) s += part[(size_t)(hf * 16 + k) * MTOK + pm * 256 + row];
    s += __shfl_xor(s, 1);
    if (hf == 0) tab[row] = rsqrtf(s * (1.f / DM) + EPS);
    __syncthreads();
}
__device__ __forceinline__ float row_rstd(const float* part, int r, int fq) {
    float s = 0.f;
#pragma unroll
    for (int k = 0; k < 8; ++k) s += part[(size_t)(fq * 8 + k) * MTOK + r];
    s += __shfl_xor(s, 16); s += __shfl_xor(s, 32);
    return rsqrtf(s * (1.f / DM) + EPS);
}
struct EpiInProj {
    unsigned char* wsb; const float* rowsq; const LAS float* tab; int tab_pm;
    __device__ __forceinline__ float rs(int r, int fq) const { return (r >> 8) == tab_pm ? tab[r & 255] : row_rstd(rowsq, r, fq); }
    __device__ __forceinline__ void operator()(const f32x4 (&acc)[2][2][4][2], const pg8::Unit& u, int wr, int wc, int fr, int fq) const {
        const int row0 = u.pm * 256 + wr * 64 + fr;
        const bool tr = (u.pn >= 10 && u.pn <= 13);
        if (!tr) {
            bf16_t* P = (bf16_t*)(wsb + WS_P);
#pragma unroll
            for (int ai = 0; ai < 2; ++ai)
#pragma unroll
                for (int m = 0; m < 4; ++m) {
                    const int r = row0 + ai * 128 + m * 16;
                    const float rstd = rs(r, fq);
                    bf16_t* rowp = P + (size_t)r * NINP + u.pn * 256 + wc * 32 + 4 * fq;
#pragma unroll
                    for (int bj = 0; bj < 2; ++bj)
#pragma unroll
                        for (int n = 0; n < 2; ++n) { const f32x4 v = acc[ai][bj][m][n] * rstd; u32x2 w; w.x = pk2(v[0], v[1]); w.y = pk2(v[2], v[3]); *(u32x2*)(rowp + bj * 128 + n * 16) = w; }
                }
        } else {
            const bool isv = (u.pn & 1); const bool sel8 = (u.pn < 12);
            bf16_t* BT = (bf16_t*)(wsb + ((u.pn == 10) ? WS_KST : (u.pn == 11) ? WS_VST : (u.pn == 12) ? WS_KWT : WS_VWT));
            const int b = u.pm >> 5, blk0 = (u.pm & 31) * 4 + wr;
            const int lk = (((fq >> 1) * 16 + fr) * 8) + 4 * (fq & 1);
            const int lv = (((fr >> 2) * 16 + 4 * fq) * 8) + (fr & 3);
#pragma unroll
            for (int ai = 0; ai < 2; ++ai)
#pragma unroll
                for (int m = 0; m < 4; ++m) {
                    const int r = row0 + ai * 128 + m * 16;
                    const float rstd = rs(r, fq);
#pragma unroll
                    for (int bj = 0; bj < 2; ++bj) {
                        bf16_t* blkp = BT + (size_t)((b * 4 + 2 * bj + (wc >> 1)) * 128 + blk0 + 2 * ai) * 4096;
#pragma unroll
                        for (int n = 0; n < 2; ++n) { const f32x4 v = acc[ai][bj][m][n] * rstd;
                            if (sel8) {
                                unsigned char* blk8 = (unsigned char*)BT + (size_t)((b * 4 + 2 * bj + (wc >> 1)) * 128 + blk0 + 2 * ai) * 4096;
                                if (!isv) *(unsigned*)(blk8 + ((m * 2 + (wc & 1)) * 64 + 2 * n * 16) * 8 + lk) = pack4_fp8(v[0], v[1], v[2], v[3]);
                                else { unsigned char* vp = blk8 + ((((wc & 1) * 2 + n) * 2 + (m >> 1)) * 64) * 8 + 4 * (m & 1) + lv; const unsigned w4 = pack4_fp8(v[0], v[1], v[2], v[3]);
#pragma unroll
                                    for (int i = 0; i < 4; ++i) vp[8 * i] = (unsigned char)(w4 >> (8 * i)); }
                            } else
                            if (!isv) { u32x2 w; w.x = pk2(v[0], v[1]); w.y = pk2(v[2], v[3]); *(u32x2*)(blkp + ((m * 2 + (wc & 1)) * 64 + 2 * n * 16) * 8 + lk) = w; }
                            else { bf16_t* vp = blkp + ((((wc & 1) * 2 + n) * 2 + (m >> 1)) * 64) * 8 + 4 * (m & 1) + lv;
#pragma unroll
                                for (int i = 0; i < 4; ++i) vp[8 * i] = f2bf(v[i]); } }
                    }
                }
        }
    }
};
struct EpiGlu {
    bf16_t* MIX; const float* bias;
    __device__ __forceinline__ void operator()(const f32x4 (&acc)[2][2][4][2], const pg8::Unit& u, int wr, int wc, int fr, int fq) const {
        const int row0 = u.pm * 256 + wr * 64 + fr;
#pragma unroll
        for (int bj = 0; bj < 2; ++bj) {
            const int j0 = u.pn * 128 + bj * 64 + wc * 16 + 4 * fq;
            const f32x4 ba = *(const f32x4*)(bias + j0), bb = *(const f32x4*)(bias + DSSM + j0);
#pragma unroll
            for (int ai = 0; ai < 2; ++ai)
#pragma unroll
                for (int m = 0; m < 4; ++m) {
                    const int r = row0 + ai * 128 + m * 16;
                    const f32x4 a = acc[ai][bj][m][0] + ba, b = acc[ai][bj][m][1] + bb;
                    float o[4];
#pragma unroll
                    for (int i = 0; i < 4; ++i) o[i] = a[i] * sigmoidf_(b[i]);
                    u32x2 w; w.x = pk2(o[0], o[1]); w.y = pk2(o[2], o[3]);
                    *(u32x2*)(MIX + (size_t)r * DM + j0) = w;
                }
        }
    }
};
struct EpiResid {
    bf16_t* XB; float* rowsq;
    __device__ __forceinline__ void operator()(const f32x4 (&acc)[2][2][4][2], const pg8::Unit& u, int wr, int wc, int fr, int fq) const {
        const int row0 = u.pm * 256 + wr * 64 + fr; const int col0 = u.pn * 256 + wc * 32 + 4 * fq;
#pragma unroll
        for (int ai = 0; ai < 2; ++ai)
#pragma unroll
            for (int m = 0; m < 4; ++m) {
                const int r = row0 + ai * 128 + m * 16; float ss = 0.f;
#pragma unroll
                for (int bj = 0; bj < 2; ++bj)
#pragma unroll
                    for (int n = 0; n < 2; ++n) {
                        const size_t off = (size_t)r * DM + col0 + bj * 128 + n * 16;
                        const u32x2 old = *(const u32x2*)(XB + off);
                        f32x4 x = (f32x4){bflo(old.x), bfhi(old.x), bflo(old.y), bfhi(old.y)} + acc[ai][bj][m][n];
                        u32x2 w; w.x = pk2(x[0], x[1]); w.y = pk2(x[2], x[3]); *(u32x2*)(XB + off) = w;
                        ss += (x[0] * x[0] + x[1] * x[1]) + (x[2] * x[2] + x[3] * x[3]);
                    }
                ss += __shfl_xor(ss, 16); ss += __shfl_xor(ss, 32);
                if (fq == 0) rowsq[(size_t)(u.pn * 4 + wc) * MTOK + r] = ss;
            }
    }
};
struct EpiSwiglu {
    bf16_t* HID; const float* rowsq; const LAS float* tab; int tab_pm;
    __device__ __forceinline__ float rs(int r, int fq) const { return (r >> 8) == tab_pm ? tab[r & 255] : row_rstd(rowsq, r, fq); }
    __device__ __forceinline__ void operator()(const f32x4 (&acc)[2][2][4][2], const pg8::Unit& u, int wr, int wc, int fr, int fq) const {
        const int row0 = u.pm * 256 + wr * 64 + fr;
#pragma unroll
        for (int ai = 0; ai < 2; ++ai)
#pragma unroll
            for (int m = 0; m < 4; ++m) {
                const int r = row0 + ai * 128 + m * 16;
                const float rstd = rs(r, fq);
#pragma unroll
                for (int bj = 0; bj < 2; ++bj) {
                    const int j0 = u.pn * 128 + bj * 64 + wc * 16 + 4 * fq;
                    const f32x4 gv = acc[ai][bj][m][0] * rstd, uv = acc[ai][bj][m][1] * rstd;
                    float o[4];
#pragma unroll
                    for (int i = 0; i < 4; ++i) o[i] = gv[i] * sigmoidf_(gv[i]) * uv[i];
                    u32x2 w; w.x = pk2(o[0], o[1]); w.y = pk2(o[2], o[3]);
                    *(u32x2*)(HID + (size_t)r * DFF + j0) = w;
                }
            }
    }
};

__device__ __forceinline__ void transpose_item(const float* W, int K, int N, bf16_t* WT, int mode, const float* gain, LAS float* scr, int item, int lane) {
    const int nblk = (N + 31) / 32, kb = item / nblk, nb = item % nblk, k0 = 64 * kb, n0 = 32 * nb;
    const int nn = n0 + (lane & 31);
    float cs = 1.f; if (mode == 4 && nn >= C_Q && nn < C_KC) cs = 0.125f;
#pragma unroll
    for (int i = 0; i < 32; ++i) { const int kk = 2 * i + (lane >> 5);
        float v = (nn < N) ? __builtin_nontemporal_load(&W[(size_t)(k0 + kk) * N + nn]) : 0.f;
        if (gain) v *= gain[k0 + kk];
        scr[kk * 33 + (lane & 31)] = v * cs; }
    wave_lds_fence();
    const int c = lane & 7;
#pragma unroll
    for (int j = 0; j < 4; ++j) { const int n = (lane >> 3) + 8 * j; const LAS float* s = scr + (8 * c) * 33 + n;
        u32x4 o; o.x = pk2(s[0 * 33], s[1 * 33]); o.y = pk2(s[2 * 33], s[3 * 33]); o.z = pk2(s[4 * 33], s[5 * 33]); o.w = pk2(s[6 * 33], s[7 * 33]);
        const int ng = n0 + n; int dest = ng;
        if (mode == 1) { const int hf = ng >= DSSM, jj = ng - DSSM * hf; dest = (jj >> 4) * 32 + 16 * hf + (jj & 15); }
        else if (mode == 2 || mode == 3) dest = (ng >> 4) * 32 + 16 * (mode - 2) + (ng & 15);
        *(u32x4*)(WT + (size_t)dest * K + k0 + 8 * c) = o; }
    wave_lds_fence();
}

struct Args {
    const float* in[26];
    float* out; unsigned char* ws;
};
typedef const Args __attribute__((address_space(4))) CArgs;
__device__ __forceinline__ CArgs* get_args() { CArgs* p = (CArgs*)__builtin_amdgcn_kernarg_segment_ptr(); asm volatile("" : "+s"(p)); return p; }

constexpr int IT_WIN = 32 * 114, IT_GLU = 16 * 64, IT_OUT = 32 * 64, IT_G = 32 * 176, IT_U = 32 * 176, IT_D = 88 * 64, IT_C1 = 32 * 4, IT_C2 = 2 * 2;
constexpr int IT_LAYER = IT_WIN + IT_GLU + IT_OUT + IT_G + IT_U + IT_D + 2 * IT_C1 + 2 * IT_C2;

__device__ __forceinline__ void prologue(LAS unsigned char* lds, int wave, int lane, int gw, int NGW) {
    CArgs* Ap = get_args();
    unsigned char* ws = Ap->ws;
    LAS float* scr = (LAS float*)(lds + wave * 16384);
    for (int it = gw; it < DEPTH * IT_LAYER; it += NGW) {
        const int l = it / IT_LAYER; int r = it % IT_LAYER;
        if (r < IT_WIN) { transpose_item(Ap->in[5] + (size_t)l * DM * NIN, DM, NIN, (bf16_t*)(ws + WS_WIN) + (size_t)l * NINP * DM, 4, Ap->in[2] + l * DM, scr, r, lane); continue; } r -= IT_WIN;
        if (r < IT_GLU) { transpose_item(Ap->in[14] + (size_t)l * DSSM * 2 * DSSM, DSSM, 2 * DSSM, (bf16_t*)(ws + WS_WGLU) + (size_t)l * 2 * DSSM * DSSM, 1, nullptr, scr, r, lane); continue; } r -= IT_GLU;
        if (r < IT_OUT) { transpose_item(Ap->in[22] + (size_t)l * DM * DM, DM, DM, (bf16_t*)(ws + WS_WOUT) + (size_t)l * DM * DM, 0, nullptr, scr, r, lane); continue; } r -= IT_OUT;
        if (r < IT_G) { transpose_item(Ap->in[23] + (size_t)l * DM * DFF, DM, DFF, (bf16_t*)(ws + WS_WGU) + (size_t)l * 2 * DFF * DM, 2, Ap->in[3] + l * DM, scr, r, lane); continue; } r -= IT_G;
        if (r < IT_U) { transpose_item(Ap->in[24] + (size_t)l * DM * DFF, DM, DFF, (bf16_t*)(ws + WS_WGU) + (size_t)l * 2 * DFF * DM, 3, Ap->in[3] + l * DM, scr, r, lane); continue; } r -= IT_U;
        if (r < IT_D) { transpose_item(Ap->in[25] + (size_t)l * DFF * DM, DFF, DM, (bf16_t*)(ws + WS_WDN) + (size_t)l * DM * DFF, 0, nullptr, scr, r, lane); continue; } r -= IT_D;
        if (r < IT_C1) { transpose_item(Ap->in[17] + (size_t)l * 2048 * 128, 2048, 128, (bf16_t*)(ws + WS_CW1) + (size_t)(l * 2 + 0) * 128 * 2048, 0, nullptr, scr, r, lane); continue; } r -= IT_C1;
        if (r < IT_C1) { transpose_item(Ap->in[20] + (size_t)l * 2048 * 128, 2048, 128, (bf16_t*)(ws + WS_CW1) + (size_t)(l * 2 + 1) * 128 * 2048, 0, nullptr, scr, r, lane); continue; } r -= IT_C1;
        if (r < IT_C2) { transpose_item(Ap->in[18] + (size_t)l * 128 * 64, 128, 64, (bf16_t*)(ws + WS_CW2) + (size_t)(l * 2 + 0) * 64 * 128, 0, nullptr, scr, r, lane); continue; } r -= IT_C2;
        transpose_item(Ap->in[21] + (size_t)l * 128 * 64, 128, 64, (bf16_t*)(ws + WS_CW2) + (size_t)(l * 2 + 1) * 64 * 128, 0, nullptr, scr, r, lane);
    }
    const float* x = Ap->in[0]; bf16_t* XB = (bf16_t*)(ws + WS_XB); float* rowsq = (float*)(ws + WS_RSQ);
    for (int m = gw; m < MTOK; m += NGW) {
        const f32x4* xr = (const f32x4*)(x + (size_t)m * DM) + lane; u32x2* xb = (u32x2*)(XB + (size_t)m * DM) + lane;
        float s = 0.f;
#pragma unroll
        for (int j = 0; j < 8; ++j) { const f32x4 v = __builtin_nontemporal_load(&xr[64 * j]); u32x2 w; w.x = pk2(v[0], v[1]); w.y = pk2(v[2], v[3]); xb[64 * j] = w; s += (v[0] * v[0] + v[1] * v[1]) + (v[2] * v[2] + v[3] * v[3]); }
        s = wave_sum(s);
        if (lane < 32) rowsq[(size_t)lane * MTOK + m] = (lane == 0) ? s : 0.f;
    }
}

__device__ __forceinline__ void sincos_small(float ang, float& sn, float& cs) {
    const float k = rintf(ang * 0.636619772f);
    float r = fmaf(-k, 1.5707963705f, ang); r = fmaf(-k, -4.37113883e-8f, r);
    const float r2 = r * r;
    const float s = r * (1.f + r2 * (-1.f / 6.f + r2 * (1.f / 120.f + r2 * (-1.f / 5040.f + r2 * (1.f / 362880.f)))));
    const float c = 1.f + r2 * (-0.5f + r2 * (1.f / 24.f + r2 * (-1.f / 720.f + r2 * (1.f / 40320.f))));
    const int q = ((int)k) & 3;
    sn = (q == 0) ? s : (q == 1) ? c : (q == 2) ? -s : -c;
    cs = (q == 0) ? c : (q == 1) ? -s : (q == 2) ? -c : s;
}

template <int PASS>
__device__ __forceinline__ void s5_task(CArgs* Ap, int l, int b, int g, int c, LAS unsigned char* wl, int lane) {
    if (PASS == 1 && c == NCHUNK - 1) return;
    unsigned char* ws = Ap->ws;
    const bf16_t* P = (const bf16_t*)(ws + p_off(l));
    f32x2* SST = (f32x2*)(ws + WS_SST + (size_t)l * MiB);
    LAS float* us = (LAS float*)wl;
    LAS bf16_t* Xs = (LAS bf16_t*)(wl + 1024);
    const int p = lane;
    const float a_re = fminf(Ap->in[6][(l * NGRP + g) * NST + p], -1e-4f), a_im = Ap->in[7][(l * NGRP + g) * NST + p];
    const float dt = expf(Ap->in[8][l * NGRP + g]);
    const float mag = expf(a_re * dt); float sn, cs; sincos_small(a_im * dt, sn, cs);
    const float ab_re = mag * cs, ab_im = mag * sn;
    const float nr = ab_re - 1.f, ni = ab_im, den = a_re * a_re + a_im * a_im;
    const float f_re = (nr * a_re + ni * a_im) / den, f_im = (ni * a_re - nr * a_im) / den;
    float bbr[16], bbi[16]; f32x2 bb2[16];
    {
        const f32x4* br = (const f32x4*)(Ap->in[9] + ((size_t)(l * NGRP + g) * NST + p) * 16); const f32x4* bi = (const f32x4*)(Ap->in[10] + ((size_t)(l * NGRP + g) * NST + p) * 16);
#pragma unroll
        for (int q = 0; q < 4; ++q) { const f32x4 vr = br[q], vi = bi[q];
#pragma unroll
            for (int i = 0; i < 4; ++i) { bbr[4 * q + i] = f_re * vr[i] - f_im * vi[i]; bbi[4 * q + i] = f_re * vi[i] + f_im * vr[i]; bb2[4 * q + i] = (f32x2){bbr[4 * q + i], bbi[4 * q + i]}; } }
    }
    float xr = 0.f, xi = 0.f;
    const int n16 = lane & 15, g4 = lane >> 4;
    bf16x8 cB[4]; float dval = 0.f;
    if (PASS == 2) {
        float pr = ab_re, pi = ab_im;
#pragma unroll
        for (int i = 0; i < 9; ++i) { const float t_ = pr * pr - pi * pi; pi = 2.f * pr * pi; pr = t_; }
        const f32x2* S = SST + (size_t)((b * NGRP + g) * NCHUNK) * NST + p;
        for (int cc = 0; cc < c; ++cc) { const f32x2 s = S[(size_t)cc * NST]; const float t_ = pr * xr - pi * xi + s.x; xi = pr * xi + pi * xr + s.y; xr = t_; }
        const float* cre = Ap->in[11] + ((size_t)(l * NGRP + g) * 16 + n16) * NST; const float* cim = Ap->in[12] + ((size_t)(l * NGRP + g) * 16 + n16) * NST;
#pragma unroll
        for (int kk = 0; kk < 4; ++kk) { const f32x4 r4 = *(const f32x4*)(cre + 16 * kk + 4 * g4), i4 = *(const f32x4*)(cim + 16 * kk + 4 * g4);
            u32x4 w; w.x = pk2(r4[0], -i4[0]); w.y = pk2(r4[1], -i4[1]); w.z = pk2(r4[2], -i4[2]); w.w = pk2(r4[3], -i4[3]);
            cB[kk] = __builtin_bit_cast(bf16x8, w); }
        dval = Ap->in[13][l * DSSM + g * 16 + n16];
    }
    const size_t row0 = (size_t)b * SEQ + (size_t)c * CHUNK;
    const bf16_t* up = P + (row0 + (lane >> 2)) * NINP + g * 16 + 4 * (lane & 3);
    u32x2 unext = *(const u32x2*)up;
    bf16_t* Y1 = (bf16_t*)(ws + WS_Y1);
    for (int tb = 0; tb < CHUNK; tb += 16) {
        const u32x2 ucur = unext;
        if (tb + 16 < CHUNK) unext = *(const u32x2*)(up + (size_t)(tb + 16) * NINP);
        *(LAS f32x4*)(us + (lane >> 2) * 16 + 4 * (lane & 3)) = (f32x4){bflo(ucur.x), bfhi(ucur.x), bflo(ucur.y), bfhi(ucur.y)};
        wave_lds_fence();
#pragma unroll 4
        for (int s = 0; s < 16; ++s) {
            const f32x4 u0 = *(const LAS f32x4*)(us + s * 16), u1 = *(const LAS f32x4*)(us + s * 16 + 4), u2 = *(const LAS f32x4*)(us + s * 16 + 8), u3 = *(const LAS f32x4*)(us + s * 16 + 12);
            f32x2 bu = (f32x2){0.f, 0.f};
#pragma unroll
            for (int i = 0; i < 4; ++i) bu = bb2[i] * (f32x2){u0[i], u0[i]} + bu;
#pragma unroll
            for (int i = 0; i < 4; ++i) bu = bb2[4 + i] * (f32x2){u1[i], u1[i]} + bu;
#pragma unroll
            for (int i = 0; i < 4; ++i) bu = bb2[8 + i] * (f32x2){u2[i], u2[i]} + bu;
#pragma unroll
            for (int i = 0; i < 4; ++i) bu = bb2[12 + i] * (f32x2){u3[i], u3[i]} + bu;
            const float br_ = bu.x, bi_ = bu.y;
            const float nxr = fmaf(ab_re, xr, fmaf(-ab_im, xi, br_)); const float nxi = fmaf(ab_re, xi, fmaf(ab_im, xr, bi_));
            xr = nxr; xi = nxi;
            if (PASS == 2) *(LAS unsigned*)(Xs + s * 136 + 2 * p) = pk2(xr, xi);
        }
        if (PASS == 2) {
            wave_lds_fence();
            f32x4 y = (f32x4){0.f, 0.f, 0.f, 0.f};
#pragma unroll
            for (int kk = 0; kk < 4; ++kk) { const bf16x8 xa = *(const LAS bf16x8*)(Xs + n16 * 136 + 32 * kk + 8 * g4); y = __builtin_amdgcn_mfma_f32_16x16x32_bf16(xa, cB[kk], y, 0, 0, 0); }
#pragma unroll
            for (int i = 0; i < 4; ++i) { const int tl = 4 * g4 + i; const float uv = us[tl * 16 + n16]; const float v = gelu_tanh(y[i] + dval * uv);
                Y1[(row0 + tb + tl) * DSSM + g * 16 + n16] = f2bf(v); }
        }
        wave_lds_fence();
    }
    if (PASS == 1) SST[(size_t)((b * NGRP + g) * NCHUNK + c) * NST + p] = (f32x2){xr, xi};
}

__device__ __forceinline__ void compress_task(CArgs* Ap, int l, int task, int lane) {
    unsigned char* ws = Ap->ws;
    const int kv = task & 1, nb = (task >> 1) & 31, g = (task >> 6) & 3, b = task >> 8;
    const int n16 = lane & 15, g4 = lane >> 4;
    const bf16_t* P = (const bf16_t*)(ws + p_off(l));
    const bf16_t* W1t = (const bf16_t*)(ws + WS_CW1) + (size_t)(l * 2 + kv) * 128 * 2048;
    const bf16_t* W2t = (const bf16_t*)(ws + WS_CW2) + (size_t)(l * 2 + kv) * 64 * 128;
    const float* pos = Ap->in[kv ? 19 : 16] + (size_t)l * 32 * 64;
    const int n = nb * 16 + n16;
    const int colb = (kv ? C_VC : C_KC) + g * 64;
    f32x4 acc[8];
#pragma unroll
    for (int h = 0; h < 8; ++h) acc[h] = (f32x4){0.f, 0.f, 0.f, 0.f};
#pragma unroll 2
    for (int ks = 0; ks < 64; ++ks) {
        const int itok = ks >> 1, d0 = 32 * (ks & 1) + 8 * g4;
        int tok = 16 * n + itok; tok = tok > SEQ - 1 ? SEQ - 1 : tok;
        const u32x4 raw = *(const u32x4*)(P + ((size_t)b * SEQ + tok) * NINP + colb + d0);
        const f32x4 p0 = *(const f32x4*)(pos + itok * 64 + d0), p1 = *(const f32x4*)(pos + itok * 64 + d0 + 4);
        u32x4 w;
        w.x = pk2(bflo(raw.x) + p0[0], bfhi(raw.x) + p0[1]); w.y = pk2(bflo(raw.y) + p0[2], bfhi(raw.y) + p0[3]);
        w.z = pk2(bflo(raw.z) + p1[0], bfhi(raw.z) + p1[1]); w.w = pk2(bflo(raw.w) + p1[2], bfhi(raw.w) + p1[3]);
        const bf16x8 fb = __builtin_bit_cast(bf16x8, w);
#pragma unroll
        for (int h = 0; h < 8; ++h) { const bf16x8 wa = *(const bf16x8*)(W1t + (size_t)(16 * h + n16) * 2048 + 32 * ks + 8 * g4); acc[h] = __builtin_amdgcn_mfma_f32_16x16x32_bf16(wa, fb, acc[h], 0, 0, 0); }
    }
    bf16x8 hB[4];
#pragma unroll
    for (int pp = 0; pp < 4; ++pp) { float v[8];
#pragma unroll
        for (int i = 0; i < 4; ++i) { v[i] = gelu_tanh(acc[2 * pp][i]); v[4 + i] = gelu_tanh(acc[2 * pp + 1][i]); }
        u32x4 w; w.x = pk2(v[0], v[1]); w.y = pk2(v[2], v[3]); w.z = pk2(v[4], v[5]); w.w = pk2(v[6], v[7]); hB[pp] = __builtin_bit_cast(bf16x8, w); }
    bf16_t* KC = (bf16_t*)(ws + WS_KC + (size_t)l * MiB); bf16_t* VCT = (bf16_t*)(ws + WS_VCT + (size_t)l * MiB);
#pragma unroll
    for (int dt = 0; dt < 4; ++dt) {
        f32x4 o = (f32x4){0.f, 0.f, 0.f, 0.f};
#pragma unroll
        for (int pp = 0; pp < 4; ++pp) { const bf16_t* wrow = W2t + (size_t)(16 * dt + n16) * 128 + 32 * pp + 4 * g4;
            const u32x2 lo = *(const u32x2*)wrow, hi = *(const u32x2*)(wrow + 16);
            u32x4 w; w.x = lo.x; w.y = lo.y; w.z = hi.x; w.w = hi.y;
            o = __builtin_amdgcn_mfma_f32_16x16x32_bf16(__builtin_bit_cast(bf16x8, w), hB[pp], o, 0, 0, 0); }
        if (kv == 0) { u32x2 w; w.x = pk2(o[0], o[1]); w.y = pk2(o[2], o[3]); *(u32x2*)(KC + (size_t)((b * 4 + g) * 8 + (n >> 6)) * 4096 + kswz(n & 63, 16 * dt + 4 * g4)) = w; }
        else {
#pragma unroll
            for (int i = 0; i < 4; ++i) VCT[(size_t)((b * 4 + g) * 8 + (n >> 6)) * 4096 + vswz(16 * dt + 4 * g4 + i, n & 63)] = f2bf(o[i]); }
    }
}

__device__ __forceinline__ void compress_simple(CArgs* Ap, int l, int task, LAS float* hs, int lane) {
    unsigned char* ws = Ap->ws;
    const int kv = task & 1, n0 = ((task >> 1) & 127) * 4, g = (task >> 8) & 3, b = task >> 10;
    const bf16_t* P = (const bf16_t*)(ws + p_off(l));
    const float* w1 = Ap->in[kv ? 20 : 17] + (size_t)l * 2048 * 128; const float* w2 = Ap->in[kv ? 21 : 18] + (size_t)l * 128 * 64;
    const float* pos = Ap->in[kv ? 19 : 16] + (size_t)l * 32 * 64;
    const int colb = (kv ? C_VC : C_KC) + g * 64;
    float h0[4] = {0.f, 0.f, 0.f, 0.f}, h1[4] = {0.f, 0.f, 0.f, 0.f};
    for (int i = 0; i < 32; ++i) {
        const bf16_t* pr[4];
#pragma unroll
        for (int r = 0; r < 4; ++r) { int tok = 16 * (n0 + r) + i; tok = tok > SEQ - 1 ? SEQ - 1 : tok; pr[r] = P + ((size_t)b * SEQ + tok) * NINP + colb; }
        for (int d8 = 0; d8 < 8; ++d8) {
            const f32x4 p0 = *(const f32x4*)(pos + i * 64 + d8 * 8), p1 = *(const f32x4*)(pos + i * 64 + d8 * 8 + 4);
            const float pv[8] = {p0[0], p0[1], p0[2], p0[3], p1[0], p1[1], p1[2], p1[3]};
            float f[4][8];
#pragma unroll
            for (int r = 0; r < 4; ++r) { const u32x4 raw = *(const u32x4*)(pr[r] + d8 * 8);
                f[r][0] = bflo(raw.x) + pv[0]; f[r][1] = bfhi(raw.x) + pv[1]; f[r][2] = bflo(raw.y) + pv[2]; f[r][3] = bfhi(raw.y) + pv[3];
                f[r][4] = bflo(raw.z) + pv[4]; f[r][5] = bfhi(raw.z) + pv[5]; f[r][6] = bflo(raw.w) + pv[6]; f[r][7] = bfhi(raw.w) + pv[7]; }
            const float* wr = w1 + (size_t)(i * 64 + d8 * 8) * 128 + lane;
#pragma unroll
            for (int e = 0; e < 8; ++e) { const float wa = wr[e * 128], wb = wr[e * 128 + 64];
#pragma unroll
                for (int r = 0; r < 4; ++r) { h0[r] = fmaf(f[r][e], wa, h0[r]); h1[r] = fmaf(f[r][e], wb, h1[r]); } }
        }
    }
#pragma unroll
    for (int r = 0; r < 4; ++r) { hs[r * 128 + lane] = gelu_tanh(h0[r]); hs[r * 128 + lane + 64] = gelu_tanh(h1[r]); }
    wave_lds_fence();
    float o[4] = {0.f, 0.f, 0.f, 0.f};
    for (int k = 0; k < 128; ++k) { const float w = w2[k * 64 + lane];
#pragma unroll
        for (int r = 0; r < 4; ++r) o[r] = fmaf(hs[r * 128 + k], w, o[r]); }
    wave_lds_fence();
    bf16_t* KC = (bf16_t*)(ws + WS_KC + (size_t)l * MiB); bf16_t* VCT = (bf16_t*)(ws + WS_VCT + (size_t)l * MiB);
#pragma unroll
    for (int r = 0; r < 4; ++r) { const int n = n0 + r;
        if (kv == 0) KC[(size_t)((b * 4 + g) * 8 + (n >> 6)) * 4096 + kswz(n & 63, lane)] = f2bf(o[r]);
        else VCT[(size_t)((b * 4 + g) * 8 + (n >> 6)) * 4096 + vswz(lane, n & 63)] = f2bf(o[r]); }
}

__device__ __forceinline__ int rel_bucket_i(int n) {
    if (n < 16) return n;
    int c = 0;
    c += n >= 16; c += n >= 21; c += n >= 27; c += n >= 35; c += n >= 46; c += n >= 59; c += n >= 77; c += n >= 99;
    c += n >= 128; c += n >= 166; c += n >= 216; c += n >= 280; c += n >= 363; c += n >= 470; c += n >= 609; c += n >= 790;
    return 15 + c;
}

struct SmState { float m, l; };

template <int MODE>
__device__ __forceinline__ void softmax_block(f32x4 (&acc)[4], int base, bool ok, int t, int g4, const LAS float* lutg, SmState& st, f32x4 (&O)[4], bf16x8 (&pB)[2]) {
    float mx = -1e30f; unsigned vm = 0u;
#pragma unroll
    for (int nt = 0; nt < 4; ++nt)
#pragma unroll
        for (int i = 0; i < 4; ++i) {
            const int key = base + 16 * nt + 4 * g4 + i;
            const int dist = (MODE == 0) ? t - (16 * key + 31) : t - key;
            bool valid = dist >= 0;
            if (MODE == 1) valid = valid && ok;
            if (MODE == 2) valid = valid && dist < 512;
            int dc = dist < 0 ? 0 : dist; dc = dc > 1023 ? 1023 : dc;
            const float lg = acc[nt][i] + lutg[dc * 4];
            acc[nt][i] = lg;
            if (valid) { mx = fmaxf(mx, lg); vm |= 1u << (nt * 4 + i); }
        }
    mx = fmaxf(mx, __shfl_xor(mx, 16)); mx = fmaxf(mx, __shfl_xor(mx, 32));
    const float mn = fmaxf(st.m, mx);
    const float sc = fexp(st.m - mn);
    float ls = 0.f;
#pragma unroll
    for (int nt = 0; nt < 4; ++nt)
#pragma unroll
        for (int i = 0; i < 4; ++i) { const float p = ((vm >> (nt * 4 + i)) & 1u) ? fexp(acc[nt][i] - mn) : 0.f; acc[nt][i] = p; ls += p; }
    st.l = st.l * sc + ls; st.m = mn;
#pragma unroll
    for (int dt = 0; dt < 4; ++dt) O[dt] = O[dt] * sc;
#pragma unroll
    for (int hh = 0; hh < 2; ++hh) { u32x4 w; w.x = pk2(acc[2 * hh][0], acc[2 * hh][1]); w.y = pk2(acc[2 * hh][2], acc[2 * hh][3]); w.z = pk2(acc[2 * hh + 1][0], acc[2 * hh + 1][1]); w.w = pk2(acc[2 * hh + 1][2], acc[2 * hh + 1][3]);
        pB[hh] = __builtin_bit_cast(bf16x8, w); }
}

__device__ __forceinline__ void load_k(bf16x8 (&kf)[4][2], const bf16_t* Kb, int lane) {
#pragma unroll
    for (int nt = 0; nt < 4; ++nt)
#pragma unroll
        for (int kk = 0; kk < 2; ++kk) kf[nt][kk] = *(const bf16x8*)(Kb + ((nt * 2 + kk) * 64 + lane) * 8);
}
__device__ __forceinline__ void load_v(bf16x8 (&vf)[4][2], const bf16_t* Vb, int lane) {
#pragma unroll
    for (int dt = 0; dt < 4; ++dt)
#pragma unroll
        for (int hh = 0; hh < 2; ++hh) vf[dt][hh] = *(const bf16x8*)(Vb + ((dt * 2 + hh) * 64 + lane) * 8);
}
__device__ __forceinline__ void qk_acc(f32x4 (&acc)[4], const bf16x8 (&kf)[4][2], const bf16x8 (&q)[2]) {
#pragma unroll
    for (int nt = 0; nt < 4; ++nt) { acc[nt] = __builtin_amdgcn_mfma_f32_16x16x32_bf16(kf[nt][0], q[0], acc[nt], 0, 0, 0); acc[nt] = __builtin_amdgcn_mfma_f32_16x16x32_bf16(kf[nt][1], q[1], acc[nt], 0, 0, 0); }
}
__device__ __forceinline__ void pv_acc(f32x4 (&O)[4], const bf16x8 (&vf)[4][2], const bf16x8 (&pB)[2]) {
#pragma unroll
    for (int dt = 0; dt < 4; ++dt) { O[dt] = __builtin_amdgcn_mfma_f32_16x16x32_bf16(vf[dt][0], pB[0], O[dt], 0, 0, 0); O[dt] = __builtin_amdgcn_mfma_f32_16x16x32_bf16(vf[dt][1], pB[1], O[dt], 0, 0, 0); }
}


__device__ __forceinline__ void load_kh(bf16x8 (&kf)[2][2], const bf16_t* Kb, int hh, int lane) {
#pragma unroll
    for (int nt = 0; nt < 2; ++nt)
#pragma unroll
        for (int kk = 0; kk < 2; ++kk) kf[nt][kk] = *(const bf16x8*)(Kb + (((2 * hh + nt) * 2 + kk) * 64 + lane) * 8);
}
__device__ __forceinline__ void load_vh(bf16x8 (&vf)[4], const bf16_t* Vb, int hh, int lane) {
#pragma unroll
    for (int dt = 0; dt < 4; ++dt) vf[dt] = *(const bf16x8*)(Vb + ((dt * 2 + hh) * 64 + lane) * 8);
}
__device__ __forceinline__ void qk_acch(f32x4 (&acc)[2], const bf16x8 (&kf)[2][2], const bf16x8 (&q)[2]) {
#pragma unroll
    for (int nt = 0; nt < 2; ++nt) { acc[nt] = __builtin_amdgcn_mfma_f32_16x16x32_bf16(kf[nt][0], q[0], acc[nt], 0, 0, 0); acc[nt] = __builtin_amdgcn_mfma_f32_16x16x32_bf16(kf[nt][1], q[1], acc[nt], 0, 0, 0); }
}
__device__ __forceinline__ void pv_acch(f32x4 (&O)[4], const bf16x8 (&vf)[4], const bf16x8 pB) {
#pragma unroll
    for (int dt = 0; dt < 4; ++dt) O[dt] = __builtin_amdgcn_mfma_f32_16x16x32_bf16(vf[dt], pB, O[dt], 0, 0, 0);
}
__device__ __forceinline__ void softmax_half_far(f32x4 (&acc)[2], const LAS float* lutg, SmState& st, f32x4 (&O)[4]) {
    const float bias = lutg[1023 * 4];
    float mx = -1e30f;
#pragma unroll
    for (int nt = 0; nt < 2; ++nt)
#pragma unroll
        for (int i = 0; i < 4; ++i) { const float lg = acc[nt][i] + bias; acc[nt][i] = lg; mx = fmaxf(mx, lg); }
    mx = fmaxf(mx, __shfl_xor(mx, 16)); mx = fmaxf(mx, __shfl_xor(mx, 32));
    const float mn = fmaxf(st.m, mx);
    const float sc = fexp(st.m - mn);
    float ls = 0.f;
#pragma unroll
    for (int nt = 0; nt < 2; ++nt)
#pragma unroll
        for (int i = 0; i < 4; ++i) { const float p = fexp(acc[nt][i] - mn); acc[nt][i] = p; ls += p; }
    st.l = st.l * sc + ls; st.m = mn;
#pragma unroll
    for (int dt = 0; dt < 4; ++dt) O[dt] = O[dt] * sc;
}
template <int MODE>
__device__ __forceinline__ void softmax_half(f32x4 (&acc)[2], int base, bool ok, int t, int g4, const LAS float* lutg, SmState& st, f32x4 (&O)[4], bf16x8& pB) {
    float mx = -1e30f; unsigned vm = 0u;
#pragma unroll
    for (int nt = 0; nt < 2; ++nt)
#pragma unroll
        for (int i = 0; i < 4; ++i) {
            const int key = base + 16 * nt + 4 * g4 + i;
            const int dist = t - key;
            bool valid = dist >= 0;
            if (MODE == 1) valid = valid && ok;
            if (MODE == 2) valid = valid && dist < 512;
            int dc = dist < 0 ? 0 : dist; dc = dc > 1023 ? 1023 : dc;
            const float lg = acc[nt][i] + lutg[dc * 4];
            acc[nt][i] = lg;
            if (valid) { mx = fmaxf(mx, lg); vm |= 1u << (nt * 4 + i); }
        }
    mx = fmaxf(mx, __shfl_xor(mx, 16)); mx = fmaxf(mx, __shfl_xor(mx, 32));
    const float mn = fmaxf(st.m, mx);
    const float sc = fexp(st.m - mn);
    float ls = 0.f;
#pragma unroll
    for (int nt = 0; nt < 2; ++nt)
#pragma unroll
        for (int i = 0; i < 4; ++i) { const float p = ((vm >> (nt * 4 + i)) & 1u) ? fexp(acc[nt][i] - mn) : 0.f; acc[nt][i] = p; ls += p; }
    st.l = st.l * sc + ls; st.m = mn;
#pragma unroll
    for (int dt = 0; dt < 4; ++dt) O[dt] = O[dt] * sc;
    u32x4 w; w.x = pk2(acc[0][0], acc[0][1]); w.y = pk2(acc[0][2], acc[0][3]); w.z = pk2(acc[1][0], acc[1][1]); w.w = pk2(acc[1][2], acc[1][3]);
    pB = __builtin_bit_cast(bf16x8, w);
}


__device__ __forceinline__ void load_kh8(long (&kf)[2][2], const unsigned char* Kb, int hh, int lane) {
#pragma unroll
    for (int nt = 0; nt < 2; ++nt)
#pragma unroll
        for (int kk = 0; kk < 2; ++kk) kf[nt][kk] = *(const long*)(Kb + (((2 * hh + nt) * 2 + kk) * 64 + lane) * 8);
}
__device__ __forceinline__ void load_vh8(long (&vf)[4], const unsigned char* Vb, int hh, int lane) {
#pragma unroll
    for (int dt = 0; dt < 4; ++dt) vf[dt] = *(const long*)(Vb + ((dt * 2 + hh) * 64 + lane) * 8);
}
__device__ __forceinline__ void qk_acch8(f32x4 (&acc)[2], const long (&kf)[2][2], const long (&q)[2]) {
#pragma unroll
    for (int nt = 0; nt < 2; ++nt) { acc[nt] = __builtin_amdgcn_mfma_f32_16x16x32_fp8_fp8(kf[nt][0], q[0], acc[nt], 0, 0, 0); acc[nt] = __builtin_amdgcn_mfma_f32_16x16x32_fp8_fp8(kf[nt][1], q[1], acc[nt], 0, 0, 0); }
}
__device__ __forceinline__ void pv_acch8(f32x4 (&O)[4], const long (&vf)[4], const long p8) {
#pragma unroll
    for (int dt = 0; dt < 4; ++dt) O[dt] = __builtin_amdgcn_mfma_f32_16x16x32_fp8_fp8(vf[dt], p8, O[dt], 0, 0, 0);
}
constexpr float P8_SCALE = 256.f;
__device__ __forceinline__ long p_to_fp8(const f32x4 (&acc)[2]) {
    return pack8_fp8(acc[0][0] * P8_SCALE, acc[0][1] * P8_SCALE, acc[0][2] * P8_SCALE, acc[0][3] * P8_SCALE, acc[1][0] * P8_SCALE, acc[1][1] * P8_SCALE, acc[1][2] * P8_SCALE, acc[1][3] * P8_SCALE);
}

__device__ __forceinline__ void nsa_wave(CArgs* Ap, int l, int b, int g, int tq0, const LAS float* lut, LAS float* imp, int lane) {
    unsigned char* ws = Ap->ws;
    const bf16_t* P = (const bf16_t*)(ws + p_off(l));
    const bf16_t* KC = (const bf16_t*)(ws + WS_KC + (size_t)l * MiB) + (size_t)(b * 4 + g) * 8 * 4096;
    const bf16_t* VCT = (const bf16_t*)(ws + WS_VCT + (size_t)l * MiB) + (size_t)(b * 4 + g) * 8 * 4096;
    const bf16_t* VST = (const bf16_t*)(ws + vt_off(l)) + (size_t)(b * 4 + g) * 128 * 4096;
    const bf16_t* VWT = (const bf16_t*)(ws + vt_off(l) + 8 * MiB) + (size_t)(b * 4 + g) * 128 * 4096;
    bf16_t* MIX = (bf16_t*)(ws + WS_MIX);
    const int n16 = lane & 15, g4 = lane >> 4, qi = n16 >> 2, r = n16 & 3;
    const int t = tq0 + qi;
    const bf16_t* prow = P + ((size_t)b * SEQ + t) * NINP;
    bf16x8 qB[2];
    qB[0] = *(const bf16x8*)(prow + C_Q + (4 * g + r) * 64 + 8 * g4); qB[1] = *(const bf16x8*)(prow + C_Q + (4 * g + r) * 64 + 8 * g4 + 32);
    float gt[3];
#pragma unroll
    for (int br = 0; br < 3; ++br) gt[br] = sigmoidf_(bf2f(prow[C_GATE + (4 * g + r) * 3 + br]));
    const LAS float* lutg = lut + g * 4096 + r;
    f32x4 outacc[4];
#pragma unroll
    for (int dt = 0; dt < 4; ++dt) outacc[dt] = (f32x4){0.f, 0.f, 0.f, 0.f};
#pragma unroll
    for (int i = 0; i < 8; ++i) *(LAS f32x4*)(imp + (i * 64 + lane) * 4) = (f32x4){0.f, 0.f, 0.f, 0.f};

    const int tmax = tq0 + 3;
    const int ncb = (tmax >= 31) ? ((((tmax - 31) >> 4) >> 6) + 1) : 0;
    {
        SmState st{-1e30f, 0.f};
        f32x4 Od[4];
#pragma unroll
        for (int dt = 0; dt < 4; ++dt) Od[dt] = (f32x4){0.f, 0.f, 0.f, 0.f};
        bf16x8 pB[2];
        for (int cb = 0; cb < ncb; ++cb) {
            bf16x8 kf[4][2]; load_k(kf, KC + (size_t)cb * 4096, lane);
            f32x4 acc[4];
#pragma unroll
            for (int nt = 0; nt < 4; ++nt) acc[nt] = (f32x4){0.f, 0.f, 0.f, 0.f};
            qk_acc(acc, kf, qB);
            softmax_block<0>(acc, cb * 64, true, t, g4, lutg, st, Od, pB);
        }
        float lt = st.l; lt += __shfl_xor(lt, 16); lt += __shfl_xor(lt, 32);
        const float inv = 1.f / fmaxf(lt, 1e-30f), mfin = st.m;
        for (int cb = 0; cb < ncb; ++cb) {
            bf16x8 kf[4][2]; load_k(kf, KC + (size_t)cb * 4096, lane);
            bf16x8 vf[4][2]; load_v(vf, VCT + (size_t)cb * 4096, lane);
            f32x4 acc[4];
#pragma unroll
            for (int nt = 0; nt < 4; ++nt) acc[nt] = (f32x4){0.f, 0.f, 0.f, 0.f};
            qk_acc(acc, kf, qB);
#pragma unroll
            for (int nt = 0; nt < 4; ++nt) {
                f32x4 pi4;
#pragma unroll
                for (int i = 0; i < 4; ++i) {
                    const int key = cb * 64 + 16 * nt + 4 * g4 + i; const int dist = t - (16 * key + 31);
                    int dc = dist < 0 ? 0 : dist; dc = dc > 1023 ? 1023 : dc;
                    const float lg = acc[nt][i] + lutg[dc * 4];
                    float p = (dist >= 0) ? fexp(lg - mfin) * inv : 0.f;
                    acc[nt][i] = p;
                    p += __shfl_xor(p, 1); p += __shfl_xor(p, 2);
                    pi4[i] = p;
                }
                if (r == 0) *(LAS f32x4*)(imp + qi * 512 + cb * 64 + 16 * nt + 4 * g4) = pi4;
            }
#pragma unroll
            for (int hh = 0; hh < 2; ++hh) { u32x4 w; w.x = pk2(acc[2 * hh][0], acc[2 * hh][1]); w.y = pk2(acc[2 * hh][2], acc[2 * hh][3]); w.z = pk2(acc[2 * hh + 1][0], acc[2 * hh + 1][1]); w.w = pk2(acc[2 * hh + 1][2], acc[2 * hh + 1][3]);
                pB[hh] = __builtin_bit_cast(bf16x8, w); }
            pv_acc(outacc, vf, pB);
        }
#pragma unroll
        for (int dt = 0; dt < 4; ++dt) outacc[dt] = outacc[dt] * gt[0];
    }
    wave_lds_fence();

    const int cur = tq0 >> 6;
    int selreg = -1;
    if (cur < 16) selreg = (n16 <= cur) ? n16 : -1;
    else {
        const int sq = lane >> 4, tsel = tq0 + sq; (void)tsel;
        float sc[8];
#pragma unroll
        for (int jj = 0; jj < 8; ++jj) { const int j = n16 + 16 * jj;
            float v;
            if (j > cur) v = -1.f;
            else if (j == 0 || j == cur || j == cur - 1) v = 1e4f;
            else { const LAS float* ip = imp + sq * 512 + 4 * j; v = ip[0] + 2.f * (ip[-1] + ip[-2] + ip[-3]) + ip[-4]; }
            sc[jj] = v; }
        for (int s = 0; s < 16; ++s) {
            float bv = sc[0]; int bj = n16;
#pragma unroll
            for (int jj = 1; jj < 8; ++jj) if (sc[jj] > bv) { bv = sc[jj]; bj = n16 + 16 * jj; }
#pragma unroll
            for (int off = 1; off < 16; off <<= 1) { const float ov = __shfl_xor(bv, off); const int oj = __shfl_xor(bj, off); if (ov > bv || (ov == bv && oj < bj)) { bv = ov; bj = oj; } }
            if (n16 == s) selreg = (bv >= 0.f) ? bj : -1;
#pragma unroll
            for (int jj = 0; jj < 8; ++jj) if (bj == n16 + 16 * jj) sc[jj] = -2.f;
        }
    }
    if (cur >= 16) {
        const int fj = selreg;
        const int key = (fj < 0) ? ((1 << 20) + n16) : ((fj == 0 || fj == cur || fj == cur - 1) ? fj : (1 << 10) + fj);
        int rank = 0;
#pragma unroll
        for (int o = 1; o < 16; ++o) { const int other = __shfl(key, (lane & 48) | ((n16 + o) & 15)); rank += (other < key) ? 1 : 0; }
        selreg = __builtin_amdgcn_ds_permute(((lane & 48) | rank) << 2, fj);
    }
    const int nvalid = (cur + 1) < 16 ? (cur + 1) : 16;
    wave_lds_fence();
#pragma unroll
    for (int dt = 0; dt < 4; ++dt) *(LAS f32x4*)(imp + (dt * 64 + lane) * 4) = outacc[dt];

    {
        SmState st{-1e30f, 0.f};
        f32x4 Od[4];
#pragma unroll
        for (int dt = 0; dt < 4; ++dt) Od[dt] = (f32x4){0.f, 0.f, 0.f, 0.f};
        const unsigned char* Ks8 = (const unsigned char*)(ws + WS_KST) + (size_t)(b * 4 + g) * 128 * 4096;
        const unsigned char* Vs8 = (const unsigned char*)(ws + WS_VST) + (size_t)(b * 4 + g) * 128 * 4096;
        long q8[2];
#pragma unroll
        for (int kk = 0; kk < 2; ++kk) { const u32x4 w = __builtin_bit_cast(u32x4, qB[kk]);
            q8[kk] = pack8_fp8(bflo(w.x), bfhi(w.x), bflo(w.y), bfhi(w.y), bflo(w.z), bfhi(w.z), bflo(w.w), bfhi(w.w)); }
        int ns = 0;
        for (; ns < nvalid; ++ns) { const int j0 = __builtin_amdgcn_readlane(selreg, ns), j1 = __builtin_amdgcn_readlane(selreg, 16 + ns), j2 = __builtin_amdgcn_readlane(selreg, 32 + ns), j3 = __builtin_amdgcn_readlane(selreg, 48 + ns);
            if (!(j0 >= 0 && j0 == j1 && j0 == j2 && j0 == j3)) break; }
        for (int hs = 0; hs < 2 * ns; ++hs) {
            const int s = hs >> 1, hh = hs & 1;
            const int j = __builtin_amdgcn_readlane(selreg, s);
            long kh[2][2]; load_kh8(kh, Ks8 + (size_t)j * 4096, hh, lane);
            long vh[4]; load_vh8(vh, Vs8 + (size_t)j * 4096, hh, lane);
            f32x4 acc[2];
            acc[0] = (f32x4){0.f, 0.f, 0.f, 0.f}; acc[1] = (f32x4){0.f, 0.f, 0.f, 0.f};
            qk_acch8(acc, kh, q8);
            if (__all(t - (j * 64 + 32 * hh + 31) >= 1023)) softmax_half_far(acc, lutg, st, Od);
            else { bf16x8 pB; softmax_half<1>(acc, j * 64 + 32 * hh, true, t, g4, lutg, st, Od, pB); }
            pv_acch8(Od, vh, p_to_fp8(acc));
        }
        const int nh = 2 * nvalid, h0 = 2 * ns;
        long kq[4][2][2], vq[4][4];
        if (h0 < nh) {
#pragma unroll
            for (int q2 = 0; q2 < 4; ++q2) { int j = __builtin_amdgcn_readlane(selreg, 16 * q2 + ns); j = j < 0 ? 0 : j; load_kh8(kq[q2], Ks8 + (size_t)j * 4096, 0, lane); load_vh8(vq[q2], Vs8 + (size_t)j * 4096, 0, lane); } }
        for (int hs = h0; hs < nh; ++hs) {
            const int s = hs >> 1, hh = hs & 1;
            const int jm = __shfl(selreg, 16 * qi + s);
            f32x4 acc[2];
            acc[0] = (f32x4){0.f, 0.f, 0.f, 0.f}; acc[1] = (f32x4){0.f, 0.f, 0.f, 0.f};
#pragma unroll
            for (int q2 = 0; q2 < 4; ++q2) { long qm[2]; qm[0] = (qi == q2) ? q8[0] : 0l; qm[1] = (qi == q2) ? q8[1] : 0l; qk_acch8(acc, kq[q2], qm); }
            const bool more = hs + 1 < nh; const int s1 = (hs + 1) >> 1, h1 = (hs + 1) & 1;
            int jn[4];
#pragma unroll
            for (int q2 = 0; q2 < 4; ++q2) { int j = more ? __builtin_amdgcn_readlane(selreg, 16 * q2 + s1) : 0; jn[q2] = j < 0 ? 0 : j; }
            if (more) {
#pragma unroll
                for (int q2 = 0; q2 < 4; ++q2) load_kh8(kq[q2], Ks8 + (size_t)jn[q2] * 4096, h1, lane); }
            if (__all(jm >= 0 && t - (jm * 64 + 32 * hh + 31) >= 1023)) softmax_half_far(acc, lutg, st, Od);
            else { bf16x8 pB; softmax_half<1>(acc, (jm < 0 ? 0 : jm) * 64 + 32 * hh, jm >= 0, t, g4, lutg, st, Od, pB); }
            const long p8 = p_to_fp8(acc);
#pragma unroll
            for (int q2 = 0; q2 < 4; ++q2) { const long pm = (qi == q2) ? p8 : 0l; pv_acch8(Od, vq[q2], pm); }
            if (more) {
#pragma unroll
                for (int q2 = 0; q2 < 4; ++q2) load_vh8(vq[q2], Vs8 + (size_t)jn[q2] * 4096, h1, lane); }
        }
        float lt = st.l; lt += __shfl_xor(lt, 16); lt += __shfl_xor(lt, 32);
        const float sc = gt[1] / (P8_SCALE * fmaxf(lt, 1e-30f));
#pragma unroll
        for (int dt = 0; dt < 4; ++dt) outacc[dt] = Od[dt] * sc;
    }

    {
        SmState st{-1e30f, 0.f};
        f32x4 Od[4];
#pragma unroll
        for (int dt = 0; dt < 4; ++dt) Od[dt] = (f32x4){0.f, 0.f, 0.f, 0.f};
        const bf16_t* Kw = (const bf16_t*)(ws + WS_KWT) + (size_t)(b * 4 + g) * 128 * 4096;
        const int lo = tq0 - 511, jb0 = (lo > 0 ? lo : 0) >> 6, jb1 = (tq0 + 3) >> 6;
        for (int jb = jb0; jb <= jb1; ++jb) {
            bf16x8 kf[4][2]; load_k(kf, Kw + (size_t)jb * 4096, lane);
            bf16x8 vf[4][2]; load_v(vf, VWT + (size_t)jb * 4096, lane);
            f32x4 acc[4];
#pragma unroll
            for (int nt = 0; nt < 4; ++nt) acc[nt] = (f32x4){0.f, 0.f, 0.f, 0.f};
            qk_acc(acc, kf, qB);
            bf16x8 pB[2];
            softmax_block<2>(acc, jb * 64, true, t, g4, lutg, st, Od, pB);
            pv_acc(Od, vf, pB);
        }
        float lt = st.l; lt += __shfl_xor(lt, 16); lt += __shfl_xor(lt, 32);
        const float sc = gt[2] / fmaxf(lt, 1e-30f);
#pragma unroll
        for (int dt = 0; dt < 4; ++dt) outacc[dt] = outacc[dt] + Od[dt] * sc;
    }
    wave_lds_fence();
#pragma unroll
    for (int dt = 0; dt < 4; ++dt) outacc[dt] = outacc[dt] + *(const LAS f32x4*)(imp + (dt * 64 + lane) * 4);
    bf16_t* orow = MIX + ((size_t)b * SEQ + t) * DM + DSSM + (4 * g + r) * 64 + 4 * g4;
#pragma unroll
    for (int dt = 0; dt < 4; ++dt) { u32x2 w; w.x = pk2(outacc[dt][0], outacc[dt][1]); w.y = pk2(outacc[dt][2], outacc[dt][3]); *(u32x2*)(orow + 16 * dt) = w; }
    wave_lds_fence();
}

__global__ void __launch_bounds__(512, 2) hymba_fwd(Args A_unused) {
    extern __shared__ __attribute__((aligned(16))) unsigned char lds_raw[];
    LAS unsigned char* lds = (LAS unsigned char*)lds_raw;
    cg::grid_group grid = cg::this_grid();
#define GRID_SYNC() do { asm volatile("s_waitcnt vmcnt(0) lgkmcnt(0)" ::: "memory"); grid.sync(); \
    asm volatile("buffer_inv sc1\n\ts_waitcnt vmcnt(0) lgkmcnt(0)" ::: "memory"); } while (0)
    const int wave0 = __builtin_amdgcn_readfirstlane(threadIdx.x >> 6);
#define PHASE_IDS() int wv_ = wave0; asm volatile("" : "+s"(wv_)); int tid; asm volatile("v_mbcnt_lo_u32_b32 %0, -1, 0\n\tv_mbcnt_hi_u32_b32 %0, -1, %0" : "=v"(tid)); tid += wv_ * 64; asm volatile("" : "+v"(tid)); const int lane = tid & 63, wave = __builtin_amdgcn_readfirstlane(tid >> 6); \
    int G = gridDim.x, blk = blockIdx.x; asm volatile("" : "+s"(G), "+s"(blk)); const int gw = blk * 8 + wave, NGW = G * 8; (void)lane; (void)gw; (void)NGW;

    unsigned nsync = 0;
#define FAST_SYNC() do { asm volatile("s_waitcnt vmcnt(0) lgkmcnt(0)" ::: "memory"); __syncthreads(); ++nsync; \
    { int l0_; asm volatile("v_mbcnt_lo_u32_b32 %0, -1, 0\n\tv_mbcnt_hi_u32_b32 %0, -1, %0" : "=v"(l0_)); \
      if (wave0 == 0 && l0_ == 0) { unsigned* bar_ = (unsigned*)(get_args()->ws + WS_CTL); const unsigned tgt_ = nsync * gridDim.x; \
        __builtin_amdgcn_fence(__ATOMIC_RELEASE, "agent"); asm volatile("s_waitcnt vmcnt(0)" ::: "memory"); \
        __hip_atomic_fetch_add(bar_, 1u, __ATOMIC_RELAXED, __HIP_MEMORY_SCOPE_AGENT); \
        for (unsigned sp_ = 0; sp_ < (1u << 22); ++sp_) { if (__hip_atomic_load(bar_, __ATOMIC_RELAXED, __HIP_MEMORY_SCOPE_AGENT) >= tgt_) break; __builtin_amdgcn_s_sleep(2); } } } \
    __syncthreads(); asm volatile("buffer_inv sc1\n\ts_waitcnt vmcnt(0) lgkmcnt(0)" ::: "memory"); } while (0)

    { PHASE_IDS(); if (blk == 0 && tid == 0) __hip_atomic_store((unsigned*)(get_args()->ws + WS_CTL), 0u, __ATOMIC_RELAXED, __HIP_MEMORY_SCOPE_AGENT);
      prologue(lds, wave, lane, gw, NGW); }
    GRID_SYNC();

#pragma nounroll
    for (int l = 0; l < DEPTH; ++l) {
        {
            PHASE_IDS(); CArgs* Ap = get_args(); unsigned char* ws = Ap->ws;
            pg8::Gemm g{(const bf16_t*)(ws + WS_XB), (const bf16_t*)(ws + WS_WIN) + (size_t)l * NINP * DM, MTOK, NINP, DM}; pg8::StaticOrder S; S.init(MTOK, NINP, G, blk);
            const float* rq = (const float*)(ws + WS_RSQ) + (size_t)(2 * l) * RSQ_BUF; LAS float* tab = (LAS float*)(lds + 131072);
            pg8::Unit u0; const int pm0 = S.next(0, u0) ? u0.pm : -1; if (pm0 >= 0) rstd_table(rq, pm0, tab, tid); else __syncthreads();
            EpiInProj E{ws, rq, tab, pm0};
            pg8::gemm_phase<EpiInProj, pg8::StaticOrder, true, true>(lds, g, S, E, tid);
        }
        FAST_SYNC();
        {
            PHASE_IDS(); CArgs* Ap = get_args();
            for (int wt = blk; wt < 256; wt += G) { const int b_ = wt >> 7, cp_ = (wt >> 4) & 7, gq_ = wt & 15;
                s5_task<1>(Ap, l, b_, 4 * gq_ + (wave & 3), 2 * cp_ + (wave >> 2), lds + wave * 8192, lane); }
            if (wave < 2) for (int task = blk * 2 + wave; task < 512; task += G * 2) compress_task(Ap, l, task, lane);
        }
        FAST_SYNC();
        {
            PHASE_IDS(); CArgs* Ap = get_args();
            for (int wt = blk; wt < 256; wt += G) { const int b_ = wt >> 7, cp_ = (wt >> 4) & 7, gq_ = wt & 15;
                s5_task<2>(Ap, l, b_, 4 * gq_ + (wave & 3), 2 * cp_ + (wave >> 2), lds + wave * 8192, lane); }
            __syncthreads();
            LAS float* lut = (LAS float*)lds;
            { const float* tab = Ap->in[1];
              for (int e = tid; e < 4 * 1024 * 4; e += 512) { const int r = e & 3, dist = (e >> 2) & 1023, gg = e >> 12; lut[e] = tab[rel_bucket_i(dist) * 16 + gg * 4 + r]; } }
            __syncthreads();
            LAS float* imp = (LAS float*)(lds + 65536 + wave * 8192);
            for (int i = 0; ; ++i) {
                const int unit = i * G + blk; if (unit >= 2048) break;
                const int bg = unit >> 8; int qt = unit & 255; qt = ((qt & 7) << 5) | (qt >> 3);
                if (i & 1) qt = 255 - qt;
                nsa_wave(Ap, l, bg >> 2, bg & 3, qt * 32 + wave * 4, lut, imp, lane);
            }
            __syncthreads();
        }
        FAST_SYNC();
        {
            PHASE_IDS(); CArgs* Ap = get_args(); unsigned char* ws = Ap->ws;
            pg8::Gemm g{(const bf16_t*)(ws + WS_Y1), (const bf16_t*)(ws + WS_WGLU) + (size_t)l * 2 * DSSM * DSSM, MTOK, 2 * DSSM, DSSM}; pg8::StaticOrder S; S.init(MTOK, 2 * DSSM, G, blk);
            EpiGlu E{(bf16_t*)(ws + WS_MIX), Ap->in[15] + (size_t)l * 2 * DSSM};
            pg8::gemm_phase<EpiGlu, pg8::StaticOrder, true, true>(lds, g, S, E, tid);
        }
        FAST_SYNC();
        {
            PHASE_IDS(); CArgs* Ap = get_args(); unsigned char* ws = Ap->ws;
            pg8::Gemm g{(const bf16_t*)(ws + WS_MIX), (const bf16_t*)(ws + WS_WOUT) + (size_t)l * DM * DM, MTOK, DM, DM}; pg8::StaticOrder S; S.init(MTOK, DM, G, blk);
            EpiResid E{(bf16_t*)(ws + WS_XB), (float*)(ws + WS_RSQ) + (size_t)(2 * l + 1) * RSQ_BUF};
            pg8::gemm_phase<EpiResid, pg8::StaticOrder, true, true>(lds, g, S, E, tid);
        }
        FAST_SYNC();
        {
            PHASE_IDS(); CArgs* Ap = get_args(); unsigned char* ws = Ap->ws;
            pg8::Gemm g{(const bf16_t*)(ws + WS_XB), (const bf16_t*)(ws + WS_WGU) + (size_t)l * 2 * DFF * DM, MTOK, 2 * DFF, DM}; pg8::StaticOrder S; S.init(MTOK, 2 * DFF, G, blk);
            const float* rq = (const float*)(ws + WS_RSQ) + (size_t)(2 * l + 1) * RSQ_BUF; LAS float* tab = (LAS float*)(lds + 131072);
            pg8::Unit u0; const int pm0 = S.next(0, u0) ? u0.pm : -1; if (pm0 >= 0) rstd_table(rq, pm0, tab, tid); else __syncthreads();
            EpiSwiglu E{(bf16_t*)(ws + WS_HID), rq, tab, pm0};
            pg8::gemm_phase<EpiSwiglu, pg8::StaticOrder, true, true>(lds, g, S, E, tid);
        }
        FAST_SYNC();
        {
            PHASE_IDS(); CArgs* Ap = get_args(); unsigned char* ws = Ap->ws;
            pg8::Gemm g{(const bf16_t*)(ws + WS_HID), (const bf16_t*)(ws + WS_WDN) + (size_t)l * DM * DFF, MTOK, DM, DFF}; pg8::StaticOrder S; S.init(MTOK, DM, G, blk);
            EpiResid E{(bf16_t*)(ws + WS_XB), (float*)(ws + WS_RSQ) + (size_t)(2 * l + 2) * RSQ_BUF};
            pg8::gemm_phase<EpiResid, pg8::StaticOrder, true, true>(lds, g, S, E, tid);
        }
        FAST_SYNC();
    }
    {
        PHASE_IDS(); CArgs* Ap = get_args();
        const float* fr = (const float*)(Ap->ws + WS_RSQ) + (size_t)(2 * DEPTH) * RSQ_BUF; const float* gn = Ap->in[4]; float* out = Ap->out;
        for (int m = gw; m < MTOK; m += NGW) {
            const float sq = wave_sum(lane < 32 ? fr[(size_t)lane * MTOK + m] : 0.f);
            const float rstd = rsqrtf(sq * (1.f / DM) + EPS);
            f32x4* xo = (f32x4*)(out + (size_t)m * DM) + lane; const f32x4* gp = (const f32x4*)gn + lane; const u32x2* xb = (const u32x2*)((const bf16_t*)(Ap->ws + WS_XB) + (size_t)m * DM) + lane;
#pragma unroll
            for (int j = 0; j < 8; ++j) { const u32x2 q = xb[64 * j]; f32x4 v = (f32x4){bflo(q.x), bfhi(q.x), bflo(q.y), bfhi(q.y)}; const f32x4 gg = gp[64 * j]; v = v * rstd * gg; xo[64 * j] = v; }
        }
    }
}

extern "C" void kernel_launch(void* const* d_in, const int* in_sizes, int n_in, void* d_out, int out_size, void* d_ws, size_t ws_size, hipStream_t stream) {
    static int grid = 0;
    if (grid == 0) {
        if (n_in != 26 || ws_size < WS_END) { fprintf(stderr, "kernel_launch: unexpected inputs (n_in %d, ws %zu, need %zu)\n", n_in, ws_size, (size_t)WS_END); grid = -1; return; }
        int dev = 0, cus = 0, per_cu = 0;
        hipGetDevice(&dev); hipDeviceGetAttribute(&cus, hipDeviceAttributeMultiprocessorCount, dev);
        hipFuncSetAttribute((const void*)hymba_fwd, hipFuncAttributeMaxDynamicSharedMemorySize, LDS_BYTES);
        hipOccupancyMaxActiveBlocksPerMultiprocessor(&per_cu, (const void*)hymba_fwd, 512, LDS_BYTES);
        if (per_cu < 1) { fprintf(stderr, "kernel_launch: occupancy query says %d blocks per CU\n", per_cu); per_cu = 1; }
        grid = cus * 1;
        (void)hipGetLastError();
    }
    if (grid < 0) return;
    Args a{};
    for (int i = 0; i < 26; ++i) a.in[i] = (const float*)d_in[i];
    a.out = (float*)d_out; a.ws = (unsigned char*)d_ws;
    void* args[] = {&a};
    hipError_t e = hipLaunchCooperativeKernel((const void*)hymba_fwd, dim3(grid), dim3(512), args, LDS_BYTES, stream);
    if (e != hipSuccess) fprintf(stderr, "cooperative launch failed: %s (grid %d)\n", hipGetErrorString(e), grid);
}
```

```cpp
#include <hip/hip_runtime.h>
#include <hip/hip_cooperative_groups.h>
#include <cstdio>
#include <cstdint>
namespace cg = cooperative_groups;

#define LAS __attribute__((address_space(3)))
typedef unsigned short bf16_t;
typedef short bf16x8 __attribute__((ext_vector_type(8)));
typedef short s16x4 __attribute__((ext_vector_type(4)));
typedef float f32x4 __attribute__((ext_vector_type(4)));
typedef float f32x2 __attribute__((ext_vector_type(2)));
typedef unsigned u32x4 __attribute__((ext_vector_type(4)));
typedef unsigned u32x2 __attribute__((ext_vector_type(2)));

constexpr int NB = 2, SEQ = 8192, MTOK = NB * SEQ, DM = 2048, DEPTH = 4;
constexpr int NIN = 3632, NINP = 3840;
constexpr int DSSM = 1024, NGRP = 64, NST = 64;
constexpr int NKV = 4, HD = 64;
constexpr int DFF = 5632;
constexpr int NCHUNK = 16, CHUNK = SEQ / NCHUNK;
constexpr float EPS = 1e-6f;
constexpr int C_Q = 1024, C_KC = 2048, C_VC = 2304, C_KS = 2560, C_KW = 3072, C_GATE = 3584;

constexpr size_t MiB = 1u << 20;
constexpr size_t WS_CTL = 0;
constexpr size_t WS_WIN = 1 * MiB;
constexpr size_t WS_WGLU = WS_WIN + 60 * MiB;
constexpr size_t WS_WOUT = WS_WGLU + 16 * MiB;
constexpr size_t WS_WGU = WS_WOUT + 32 * MiB;
constexpr size_t WS_WDN = WS_WGU + 176 * MiB;
constexpr size_t WS_CW1 = WS_WDN + 88 * MiB;
constexpr size_t WS_CW2 = WS_CW1 + 4 * MiB;
constexpr size_t WS_XB = WS_CW2 + 1 * MiB;
constexpr size_t WS_P = WS_XB + 64 * MiB;
constexpr size_t WS_Y1 = WS_P + 120 * MiB;
constexpr size_t WS_MIX = WS_Y1 + 32 * MiB;
constexpr size_t WS_HID = WS_P;
constexpr size_t WS_VST = WS_MIX + 64 * MiB;
constexpr size_t WS_VWT = WS_VST + 8 * MiB;
constexpr size_t WS_KC = WS_VWT + 8 * MiB;
constexpr size_t WS_VCT = WS_KC + 4 * MiB;
constexpr size_t WS_SST = WS_VCT + 4 * MiB;
constexpr size_t WS_RSQ = WS_SST + 4 * MiB;
constexpr size_t WS_P1 = WS_RSQ + 18 * MiB;
constexpr size_t WS_VT1 = WS_P1 + 120 * MiB;
constexpr size_t WS_END = WS_P1 + 16 * MiB;
__host__ __device__ __forceinline__ size_t p_off(int) { return WS_P; }
__host__ __device__ __forceinline__ size_t vt_off(int) { return WS_VST; }
constexpr size_t WS_KST = WS_P1;
constexpr size_t WS_KWT = WS_P1 + 8 * MiB;
constexpr size_t RSQ_BUF = (size_t)32 * MTOK;

constexpr int LDS_BYTES = 135168;

namespace pg8 {
constexpr int BM = 256, BK = 64, HALF = 128, HTB = HALF * BK * 2, STAGE_BYTES = 8 * HTB, NXCD = 8, WGM = 8;
__host__ __device__ __forceinline__ int lds_byte(int r, int c) { const int st = (r >> 4) * 2 + (c >> 5), rr = r & 15, cc = c & 31, ob = rr * 64 + cc * 2; return st * 1024 + (ob ^ (((ob >> 9) & 1) << 5)); }
__host__ __device__ __forceinline__ void stage_rc(int b, int& R, int& C) { const int st = b / 1024, sb = b % 1024, swz = sb ^ (((sb >> 9) & 1) << 5); R = (st >> 1) * 16 + swz / 64; C = (st & 1) * 32 + (swz % 64) / 2; }
struct Unit { int pm, pn; };
struct Gemm { const bf16_t* A; const bf16_t* Bt; int M, N, K; };
struct StaticOrder {
    int nM, nN, nwg, G, c;
    __host__ __device__ void init(int M, int N, int G_, int c_) { nM = M / BM; nN = N / BM; nwg = nM * nN; G = G_; c = c_; }
    __host__ __device__ bool next(int i, Unit& u) const {
        const long L = (long)i * G + c; if (L >= nwg) return false;
        int wgid = (int)L; { const int q = nwg / NXCD, r = nwg % NXCD, xcd = wgid % NXCD, off = wgid / NXCD; wgid = (xcd < r ? xcd * (q + 1) : r * (q + 1) + (xcd - r) * q) + off; }
        const int nig = WGM * nN, gid = wgid / nig, fm = gid * WGM, gsz = (nM - fm) < WGM ? (nM - fm) : WGM;
        u.pm = fm + ((wgid % nig) % gsz); u.pn = (wgid % nig) / gsz; return true;
    }
};
typedef float f32x2_cv __attribute__((ext_vector_type(2))); typedef __bf16 bf16x2_cv __attribute__((ext_vector_type(2)));
__device__ __forceinline__ unsigned cvt_pk_bf16(float lo, float hi) { const f32x2_cv v = {lo, hi}; const bf16x2_cv b = __builtin_convertvector(v, bf16x2_cv); return __builtin_bit_cast(unsigned, b); }

template <class Epi, class Sched, bool ALIGN_EPI = false, bool SP2 = false>
__device__ __forceinline__ void gemm_phase(LAS unsigned char* lds, const Gemm g, const Sched& S, const Epi& E, const int tid) {
    const int wid = __builtin_amdgcn_readfirstlane(tid >> 6), lane = tid & 63, wr = wid >> 2, wc = wid & 3, fr = lane & 15, fq = lane >> 4;
    const int K = g.K, nt = K / BK;
    unsigned voffA[2], voffB[2];
#pragma unroll
    for (int i = 0; i < 2; ++i) { int R, C; stage_rc(tid * 16 + i * 8192, R, C); voffA[i] = (unsigned)(R * K + C) * 2u; voffB[i] = voffA[i]; }
    const size_t kstep = (size_t)(BK * 2);
    const size_t hstep = (size_t)HALF * K * 2;
    const size_t tstep = 2 * hstep;
    const unsigned ldsw = (unsigned)wid * 1024u;
    const int aoff = lds_byte(wr * 64 + fr, fq * 8), boff = lds_byte(wc * 32 + fr, fq * 8);
#define PG8_SA(b, h) (((b) * 2 + (h)) * HTB)
#define PG8_SB(b, h) ((4 + (b) * 2 + (h)) * HTB)
#define PG8_STAGE(bufoff, gbase, voff) do { _Pragma("unroll") for (int _i = 0; _i < 2; ++_i) \
        __builtin_amdgcn_global_load_lds((const unsigned*)((const char*)(gbase) + (voff)[_i]), (LAS unsigned*)(lds + (bufoff) + ldsw + _i * 8192), 16, 0, 0); } while (0)
#define PG8_LDA(dst, b, h) do { _Pragma("unroll") for (int m = 0; m < 4; ++m) _Pragma("unroll") for (int k = 0; k < 2; ++k) dst[m][k] = *(const LAS bf16x8*)(lds + PG8_SA(b, h) + aoff + m * 2048 + k * 1024); } while (0)
#define PG8_LDB(dst, b, h) do { _Pragma("unroll") for (int n = 0; n < 2; ++n) _Pragma("unroll") for (int k = 0; k < 2; ++k) dst[n][k] = *(const LAS bf16x8*)(lds + PG8_SB(b, h) + boff + n * 2048 + k * 1024); } while (0)
#define PG8_MMA(ai, bj, At, Bt) do { __builtin_amdgcn_s_setprio(1); _Pragma("unroll") for (int m = 0; m < 4; ++m) _Pragma("unroll") for (int n = 0; n < 2; ++n) _Pragma("unroll") for (int k = 0; k < 2; ++k) \
        acc[ai][bj][m][n] = __builtin_amdgcn_mfma_f32_16x16x32_bf16(Bt[n][k], At[m][k], acc[ai][bj][m][n], 0, 0, 0); __builtin_amdgcn_s_setprio(0); } while (0)
#define PG8_WAIT_V(n) asm volatile("s_waitcnt vmcnt(" #n ")" ::: "memory")
#define PG8_WAIT_L(n) asm volatile("s_waitcnt lgkmcnt(" #n ")" ::: "memory")
#define PG8_BAR __builtin_amdgcn_s_barrier()
#define PG8_SCHED __builtin_amdgcn_sched_barrier(0)
    Unit cur, nxt; int ui = 0;
    if (!S.next(0, cur)) return;
    f32x4 acc[2][2][4][2];
#pragma unroll
    for (int a = 0; a < 2; ++a)
#pragma unroll
        for (int b = 0; b < 2; ++b)
#pragma unroll
            for (int m = 0; m < 4; ++m)
#pragma unroll
                for (int n = 0; n < 2; ++n) acc[a][b][m][n] = (f32x4){0.f, 0.f, 0.f, 0.f};
    bf16x8 At[4][2], B0[2][2], B1[2][2];
    const char* cA = (const char*)g.A + (size_t)cur.pm * tstep; const char* cB = (const char*)g.Bt + (size_t)cur.pn * tstep;
    if constexpr (SP2) {
        PG8_STAGE(PG8_SB(0, 0), cB, voffB); PG8_STAGE(PG8_SB(0, 1), cB + hstep, voffB); PG8_STAGE(PG8_SA(0, 0), cA, voffA); PG8_STAGE(PG8_SA(0, 1), cA + hstep, voffA);
        if (wr == 1) PG8_BAR;
        PG8_WAIT_V(2); PG8_BAR;
        PG8_STAGE(PG8_SB(1, 0), cB + kstep, voffB); PG8_STAGE(PG8_SA(1, 0), cA + kstep, voffA); PG8_STAGE(PG8_SB(1, 1), cB + hstep + kstep, voffB);
        PG8_WAIT_V(6); PG8_BAR;
    } else {
        PG8_STAGE(PG8_SB(0, 0), cB, voffB); PG8_STAGE(PG8_SA(0, 0), cA, voffA); PG8_STAGE(PG8_SB(0, 1), cB + hstep, voffB); PG8_STAGE(PG8_SA(0, 1), cA + hstep, voffA);
        if (wr == 1) PG8_BAR;
        PG8_WAIT_V(4); PG8_BAR;
        PG8_STAGE(PG8_SB(1, 0), cB + kstep, voffB); PG8_STAGE(PG8_SA(1, 0), cA + kstep, voffA); PG8_STAGE(PG8_SB(1, 1), cB + hstep + kstep, voffB);
        PG8_WAIT_V(6); PG8_BAR;
    }
    for (;;) {
        const bool has_next = S.next(ui + 1, nxt);
        const char* nA = has_next ? (const char*)g.A + (size_t)nxt.pm * tstep : cA; const char* nB = has_next ? (const char*)g.Bt + (size_t)nxt.pn * tstep : cB;
        for (int t = 0; t < nt; t += 2) {
            const bool last = (t == nt - 2);
            const char* a1 = cA + (size_t)(t + 1) * kstep;
            const char* a2 = last ? nA : cA + (size_t)(t + 2) * kstep; const char* b2 = last ? nB : cB + (size_t)(t + 2) * kstep;
            const char* a3 = a2 + kstep; const char* b3 = b2 + kstep;
            if constexpr (SP2) {
            PG8_LDB(B0, 0, 0); PG8_LDB(B1, 0, 1); PG8_SCHED; PG8_LDA(At, 0, 0); PG8_STAGE(PG8_SA(1, 1), a1 + hstep, voffA);
            PG8_WAIT_V(8); PG8_WAIT_L(0); PG8_BAR; PG8_MMA(0, 0, At, B0); PG8_MMA(0, 1, At, B1); PG8_BAR; PG8_SCHED;
            PG8_LDA(At, 0, 1); PG8_STAGE(PG8_SB(0, 0), b2, voffB); PG8_STAGE(PG8_SB(0, 1), b2 + hstep, voffB); PG8_STAGE(PG8_SA(0, 0), a2, voffA);
            PG8_WAIT_V(8); PG8_WAIT_L(0); PG8_BAR; PG8_MMA(1, 0, At, B0); PG8_MMA(1, 1, At, B1); PG8_BAR; PG8_SCHED;
            PG8_LDB(B0, 1, 0); PG8_LDB(B1, 1, 1); PG8_SCHED; PG8_LDA(At, 1, 0); PG8_STAGE(PG8_SA(0, 1), a2 + hstep, voffA);
            PG8_WAIT_V(8); PG8_WAIT_L(0); PG8_BAR; PG8_MMA(0, 0, At, B0); PG8_MMA(0, 1, At, B1); PG8_BAR; PG8_SCHED;
            PG8_LDA(At, 1, 1); PG8_STAGE(PG8_SB(1, 0), b3, voffB); PG8_STAGE(PG8_SB(1, 1), b3 + hstep, voffB); PG8_STAGE(PG8_SA(1, 0), a3, voffA);
            PG8_WAIT_V(8); PG8_WAIT_L(0); PG8_BAR; PG8_MMA(1, 0, At, B0); PG8_MMA(1, 1, At, B1); PG8_BAR; PG8_SCHED;
            } else {
            PG8_LDB(B0, 0, 0); PG8_SCHED; PG8_LDA(At, 0, 0); PG8_STAGE(PG8_SA(1, 1), a1 + hstep, voffA);
            PG8_WAIT_L(8); PG8_BAR; PG8_WAIT_L(0); PG8_MMA(0, 0, At, B0); PG8_BAR; PG8_SCHED;
            PG8_LDB(B1, 0, 1); PG8_STAGE(PG8_SB(0, 0), b2, voffB);
            PG8_BAR; PG8_WAIT_L(0); PG8_MMA(0, 1, At, B1); PG8_BAR;
            PG8_LDA(At, 0, 1); PG8_STAGE(PG8_SA(0, 0), a2, voffA);
            PG8_BAR; PG8_WAIT_L(0); PG8_MMA(1, 0, At, B0); PG8_BAR; PG8_SCHED;
            PG8_STAGE(PG8_SB(0, 1), b2 + hstep, voffB);
            PG8_WAIT_V(6); PG8_BAR; PG8_MMA(1, 1, At, B1); PG8_BAR;
            PG8_LDB(B0, 1, 0); PG8_SCHED; PG8_LDA(At, 1, 0); PG8_STAGE(PG8_SA(0, 1), a2 + hstep, voffA);
            PG8_WAIT_L(8); PG8_BAR; PG8_WAIT_L(0); PG8_MMA(0, 0, At, B0); PG8_BAR; PG8_SCHED;
            PG8_LDB(B1, 1, 1); PG8_STAGE(PG8_SB(1, 0), b3, voffB);
            PG8_BAR; PG8_WAIT_L(0); PG8_MMA(0, 1, At, B1); PG8_BAR;
            PG8_LDA(At, 1, 1); PG8_STAGE(PG8_SA(1, 0), a3, voffA);
            PG8_BAR; PG8_WAIT_L(0); PG8_MMA(1, 0, At, B0); PG8_BAR; PG8_SCHED;
            PG8_STAGE(PG8_SB(1, 1), b3 + hstep, voffB);
            PG8_WAIT_V(6); PG8_BAR; PG8_MMA(1, 1, At, B1); PG8_BAR;
            }
        }
        if constexpr (ALIGN_EPI) { if (wr == 0) PG8_BAR; }
        E(acc, cur, wr, wc, fr, fq);
        if (!has_next) break;
#pragma unroll
        for (int a = 0; a < 2; ++a)
#pragma unroll
            for (int b = 0; b < 2; ++b)
#pragma unroll
                for (int m = 0; m < 4; ++m)
#pragma unroll
                    for (int n = 0; n < 2; ++n) acc[a][b][m][n] = (f32x4){0.f, 0.f, 0.f, 0.f};
        cur = nxt; cA = nA; cB = nB; ++ui;
        if constexpr (ALIGN_EPI) { if (wr == 1) PG8_BAR; }
    }
    PG8_WAIT_V(0);
    if constexpr (!ALIGN_EPI) { if (wr == 0) PG8_BAR; }
    PG8_BAR;
#undef PG8_SA
#undef PG8_SB
#undef PG8_STAGE
#undef PG8_LDA
#undef PG8_LDB
#undef PG8_MMA
#undef PG8_WAIT_V
#undef PG8_WAIT_L
#undef PG8_BAR
#undef PG8_SCHED
}
}

__device__ __forceinline__ unsigned pk2(float lo, float hi) { return pg8::cvt_pk_bf16(lo, hi); }
__device__ __forceinline__ bf16_t f2bf(float f) { return (bf16_t)(pk2(f, f) & 0xffffu); }
__device__ __forceinline__ float bf2f(bf16_t h) { return __uint_as_float(((unsigned)h) << 16); }
__device__ __forceinline__ float bflo(unsigned w) { return __uint_as_float(w << 16); }
__device__ __forceinline__ float bfhi(unsigned w) { return __uint_as_float(w & 0xffff0000u); }
__device__ __forceinline__ float fexp(float x) { return __expf(x); }
__device__ __forceinline__ float sigmoidf_(float x) { return __builtin_amdgcn_rcpf(1.f + fexp(-x)); }
__device__ __forceinline__ float gelu_tanh(float x) { const float z = 0.7978845608f * (x + 0.044715f * x * x * x); const float e = fexp(2.f * z); const float th = 1.f - 2.f * __builtin_amdgcn_rcpf(e + 1.f); return 0.5f * x * (1.f + th); }
__device__ __forceinline__ int vperm(int k) { return (k & 32) | (((k & 15) >> 2) << 3) | (k & 3) | (((k >> 4) & 1) << 2); }
__device__ __forceinline__ int kswz(int key, int d) { return ((((key >> 4) * 2 + (d >> 5)) * 64) + ((d >> 3) & 3) * 16 + (key & 15)) * 8 + (d & 7); }
__device__ __forceinline__ int vswz(int d, int key) { const int k = key & 31; return ((((d >> 4) * 2 + (key >> 5)) * 64) + ((k & 15) >> 2) * 16 + (d & 15)) * 8 + (k & 3) + 4 * (k >> 4); }
__device__ __forceinline__ void wave_lds_fence() { asm volatile("s_waitcnt lgkmcnt(0)" ::: "memory"); }
__device__ __forceinline__ float wave_sum(float v) {
#pragma unroll
    for (int o = 1; o < 64; o <<= 1) v += __shfl_xor(v, o);
    return v;
}
__device__ __forceinline__ bf16x8 zero8() { return (bf16x8){0, 0, 0, 0, 0, 0, 0, 0}; }

__device__ __forceinline__ long pack8_fp8(float a0, float a1, float a2, float a3, float a4, float a5, float a6, float a7) {
    int lo = 0, hi = 0;
    lo = __builtin_amdgcn_cvt_pk_fp8_f32(a0, a1, lo, false); lo = __builtin_amdgcn_cvt_pk_fp8_f32(a2, a3, lo, true);
    hi = __builtin_amdgcn_cvt_pk_fp8_f32(a4, a5, hi, false); hi = __builtin_amdgcn_cvt_pk_fp8_f32(a6, a7, hi, true);
    return (long)(((unsigned long long)(unsigned)hi << 32) | (unsigned long long)(unsigned)lo);
}
__device__ __forceinline__ unsigned pack4_fp8(float a0, float a1, float a2, float a3) {
    int lo = 0; lo = __builtin_amdgcn_cvt_pk_fp8_f32(a0, a1, lo, false); lo = __builtin_amdgcn_cvt_pk_fp8_f32(a2, a3, lo, true); return (unsigned)lo;
}
__device__ __forceinline__ void rstd_table(const float* part, int pm, LAS float* tab, int tid) {
    const int row = tid >> 1, hf = tid & 1; float s = 0.f;
#pragma unroll
    for (int k = 0; k < 16; ++k) s += part[(size_t)(hf * 16 + k) * MTOK + pm * 256 + row];
    s += __shfl_xor(s, 1);
    if (hf == 0) tab[row] = rsqrtf(s * (1.f / DM) + EPS);
    __syncthreads();
}
__device__ __forceinline__ float row_rstd(const float* part, int r, int fq) {
    float s = 0.f;
#pragma unroll
    for (int k = 0; k < 8; ++k) s += part[(size_t)(fq * 8 + k) * MTOK + r];
    s += __shfl_xor(s, 16); s += __shfl_xor(s, 32);
    return rsqrtf(s * (1.f / DM) + EPS);
}
struct EpiInProj {
    unsigned char* wsb; const float* rowsq; const LAS float* tab; int tab_pm;
    __device__ __forceinline__ float rs(int r, int fq) const { return (r >> 8) == tab_pm ? tab[r & 255] : row_rstd(rowsq, r, fq); }
    __device__ __forceinline__ void operator()(const f32x4 (&acc)[2][2][4][2], const pg8::Unit& u, int wr, int wc, int fr, int fq) const {
        const int row0 = u.pm * 256 + wr * 64 + fr;
        const bool tr = (u.pn >= 10 && u.pn <= 13);
        if (!tr) {
            bf16_t* P = (bf16_t*)(wsb + WS_P);
#pragma unroll
            for (int ai = 0; ai < 2; ++ai)
#pragma unroll
                for (int m = 0; m < 4; ++m) {
                    const int r = row0 + ai * 128 + m * 16;
                    const float rstd = rs(r, fq);
                    bf16_t* rowp = P + (size_t)r * NINP + u.pn * 256 + wc * 32 + 4 * fq;
#pragma unroll
                    for (int bj = 0; bj < 2; ++bj)
#pragma unroll
                        for (int n = 0; n < 2; ++n) { const f32x4 v = acc[ai][bj][m][n] * rstd; u32x2 w; w.x = pk2(v[0], v[1]); w.y = pk2(v[2], v[3]); *(u32x2*)(rowp + bj * 128 + n * 16) = w; }
                }
        } else {
            const bool isv = (u.pn & 1); const bool sel8 = (u.pn < 12);
            bf16_t* BT = (bf16_t*)(wsb + ((u.pn == 10) ? WS_KST : (u.pn == 11) ? WS_VST : (u.pn == 12) ? WS_KWT : WS_VWT));
            const int b = u.pm >> 5, blk0 = (u.pm & 31) * 4 + wr;
            const int lk = (((fq >> 1) * 16 + fr) * 8) + 4 * (fq & 1);
            const int lv = (((fr >> 2) * 16 + 4 * fq) * 8) + (fr & 3);
#pragma unroll
            for (int ai = 0; ai < 2; ++ai)
#pragma unroll
                for (int m = 0; m < 4; ++m) {
                    const int r = row0 + ai * 128 + m * 16;
                    const float rstd = rs(r, fq);
#pragma unroll
                    for (int bj = 0; bj < 2; ++bj) {
                        bf16_t* blkp = BT + (size_t)((b * 4 + 2 * bj + (wc >> 1)) * 128 + blk0 + 2 * ai) * 4096;
#pragma unroll
                        for (int n = 0; n < 2; ++n) { const f32x4 v = acc[ai][bj][m][n] * rstd;
                            if (sel8) {
                                unsigned char* blk8 = (unsigned char*)BT + (size_t)((b * 4 + 2 * bj + (wc >> 1)) * 128 + blk0 + 2 * ai) * 4096;
                                if (!isv) *(unsigned*)(blk8 + ((m * 2 + (wc & 1)) * 64 + 2 * n * 16) * 8 + lk) = pack4_fp8(v[0], v[1], v[2], v[3]);
                                else { unsigned char* vp = blk8 + ((((wc & 1) * 2 + n) * 2 + (m >> 1)) * 64) * 8 + 4 * (m & 1) + lv; const unsigned w4 = pack4_fp8(v[0], v[1], v[2], v[3]);
#pragma unroll
                                    for (int i = 0; i < 4; ++i) vp[8 * i] = (unsigned char)(w4 >> (8 * i)); }
                            } else
                            if (!isv) { u32x2 w; w.x = pk2(v[0], v[1]); w.y = pk2(v[2], v[3]); *(u32x2*)(blkp + ((m * 2 + (wc & 1)) * 64 + 2 * n * 16) * 8 + lk) = w; }
                            else { bf16_t* vp = blkp + ((((wc & 1) * 2 + n) * 2 + (m >> 1)) * 64) * 8 + 4 * (m & 1) + lv;
#pragma unroll
                                for (int i = 0; i < 4; ++i) vp[8 * i] = f2bf(v[i]); } }
                    }
                }
        }
    }
};
struct EpiGlu {
    bf16_t* MIX; const float* bias;
    __device__ __forceinline__ void operator()(const f32x4 (&acc)[2][2][4][2], const pg8::Unit& u, int wr, int wc, int fr, int fq) const {
        const int row0 = u.pm * 256 + wr * 64 + fr;
#pragma unroll
        for (int bj = 0; bj < 2; ++bj) {
            const int j0 = u.pn * 128 + bj * 64 + wc * 16 + 4 * fq;
            const f32x4 ba = *(const f32x4*)(bias + j0), bb = *(const f32x4*)(bias + DSSM + j0);
#pragma unroll
            for (int ai = 0; ai < 2; ++ai)
#pragma unroll
                for (int m = 0; m < 4; ++m) {
                    const int r = row0 + ai * 128 + m * 16;
                    const f32x4 a = acc[ai][bj][m][0] + ba, b = acc[ai][bj][m][1] + bb;
                    float o[4];
#pragma unroll
                    for (int i = 0; i < 4; ++i) o[i] = a[i] * sigmoidf_(b[i]);
                    u32x2 w; w.x = pk2(o[0], o[1]); w.y = pk2(o[2], o[3]);
                    *(u32x2*)(MIX + (size_t)r * DM + j0) = w;
                }
        }
    }
};
struct EpiResid {
    bf16_t* XB; float* rowsq;
    __device__ __forceinline__ void operator()(const f32x4 (&acc)[2][2][4][2], const pg8::Unit& u, int wr, int wc, int fr, int fq) const {
        const int row0 = u.pm * 256 + wr * 64 + fr; const int col0 = u.pn * 256 + wc * 32 + 4 * fq;
#pragma unroll
        for (int ai = 0; ai < 2; ++ai)
#pragma unroll
            for (int m = 0; m < 4; ++m) {
                const int r = row0 + ai * 128 + m * 16; float ss = 0.f;
#pragma unroll
                for (int bj = 0; bj < 2; ++bj)
#pragma unroll
                    for (int n = 0; n < 2; ++n) {
                        const size_t off = (size_t)r * DM + col0 + bj * 128 + n * 16;
                        const u32x2 old = *(const u32x2*)(XB + off);
                        f32x4 x = (f32x4){bflo(old.x), bfhi(old.x), bflo(old.y), bfhi(old.y)} + acc[ai][bj][m][n];
                        u32x2 w; w.x = pk2(x[0], x[1]); w.y = pk2(x[2], x[3]); *(u32x2*)(XB + off) = w;
                        ss += (x[0] * x[0] + x[1] * x[1]) + (x[2] * x[2] + x[3] * x[3]);
                    }
                ss += __shfl_xor(ss, 16); ss += __shfl_xor(ss, 32);
                if (fq == 0) rowsq[(size_t)(u.pn * 4 + wc) * MTOK + r] = ss;
            }
    }
};
struct EpiSwiglu {
    bf16_t* HID; const float* rowsq; const LAS float* tab; int tab_pm;
    __device__ __forceinline__ float rs(int r, int fq) const { return (r >> 8) == tab_pm ? tab[r & 255] : row_rstd(rowsq, r, fq); }
    __device__ __forceinline__ void operator()(const f32x4 (&acc)[2][2][4][2], const pg8::Unit& u, int wr, int wc, int fr, int fq) const {
        const int row0 = u.pm * 256 + wr * 64 + fr;
#pragma unroll
        for (int ai = 0; ai < 2; ++ai)
#pragma unroll
            for (int m = 0; m < 4; ++m) {
                const int r = row0 + ai * 128 + m * 16;
                const float rstd = rs(r, fq);
#pragma unroll
                for (int bj = 0; bj < 2; ++bj) {
                    const int j0 = u.pn * 128 + bj * 64 + wc * 16 + 4 * fq;
                    const f32x4 gv = acc[ai][bj][m][0] * rstd, uv = acc[ai][bj][m][1] * rstd;
                    float o[4];
#pragma unroll
                    for (int i = 0; i < 4; ++i) o[i] = gv[i] * sigmoidf_(gv[i]) * uv[i];
                    u32x2 w; w.x = pk2(o[0], o[1]); w.y = pk2(o[2], o[3]);
                    *(u32x2*)(HID + (size_t)r * DFF + j0) = w;
                }
            }
    }
};

__device__ __forceinline__ void transpose_item(const float* W, int K, int N, bf16_t* WT, int mode, const float* gain, LAS float* scr, int item, int lane) {
    const int nblk = (N + 31) / 32, kb = item / nblk, nb = item % nblk, k0 = 64 * kb, n0 = 32 * nb;
    const int nn = n0 + (lane & 31);
    float cs = 1.f; if (mode == 4 && nn >= C_Q && nn < C_KC) cs = 0.125f;
#pragma unroll
    for (int i = 0; i < 32; ++i) { const int kk = 2 * i + (lane >> 5);
        float v = (nn < N) ? __builtin_nontemporal_load(&W[(size_t)(k0 + kk) * N + nn]) : 0.f;
        if (gain) v *= gain[k0 + kk];
        scr[kk * 33 + (lane & 31)] = v * cs; }
    wave_lds_fence();
    const int c = lane & 7;
#pragma unroll
    for (int j = 0; j < 4; ++j) { const int n = (lane >> 3) + 8 * j; const LAS float* s = scr + (8 * c) * 33 + n;
        u32x4 o; o.x = pk2(s[0 * 33], s[1 * 33]); o.y = pk2(s[2 * 33], s[3 * 33]); o.z = pk2(s[4 * 33], s[5 * 33]); o.w = pk2(s[6 * 33], s[7 * 33]);
        const int ng = n0 + n; int dest = ng;
        if (mode == 1) { const int hf = ng >= DSSM, jj = ng - DSSM * hf; dest = (jj >> 4) * 32 + 16 * hf + (jj & 15); }
        else if (mode == 2 || mode == 3) dest = (ng >> 4) * 32 + 16 * (mode - 2) + (ng & 15);
        *(u32x4*)(WT + (size_t)dest * K + k0 + 8 * c) = o; }
    wave_lds_fence();
}

struct Args {
    const float* in[26];
    float* out; unsigned char* ws;
};
typedef const Args __attribute__((address_space(4))) CArgs;
__device__ __forceinline__ CArgs* get_args() { CArgs* p = (CArgs*)__builtin_amdgcn_kernarg_segment_ptr(); asm volatile("" : "+s"(p)); return p; }

constexpr int IT_WIN = 32 * 114, IT_GLU = 16 * 64, IT_OUT = 32 * 64, IT_G = 32 * 176, IT_U = 32 * 176, IT_D = 88 * 64, IT_C1 = 32 * 4, IT_C2 = 2 * 2;
constexpr int IT_LAYER = IT_WIN + IT_GLU + IT_OUT + IT_G + IT_U + IT_D + 2 * IT_C1 + 2 * IT_C2;

__device__ __forceinline__ void prologue(LAS unsigned char* lds, int wave, int lane, int gw, int NGW) {
    CArgs* Ap = get_args();
    unsigned char* ws = Ap->ws;
    LAS float* scr = (LAS float*)(lds + wave * 16384);
    for (int it = gw; it < DEPTH * IT_LAYER; it += NGW) {
        const int l = it / IT_LAYER; int r = it % IT_LAYER;
        if (r < IT_WIN) { transpose_item(Ap->in[5] + (size_t)l * DM * NIN, DM, NIN, (bf16_t*)(ws + WS_WIN) + (size_t)l * NINP * DM, 4, Ap->in[2] + l * DM, scr, r, lane); continue; } r -= IT_WIN;
        if (r < IT_GLU) { transpose_item(Ap->in[14] + (size_t)l * DSSM * 2 * DSSM, DSSM, 2 * DSSM, (bf16_t*)(ws + WS_WGLU) + (size_t)l * 2 * DSSM * DSSM, 1, nullptr, scr, r, lane); continue; } r -= IT_GLU;
        if (r < IT_OUT) { transpose_item(Ap->in[22] + (size_t)l * DM * DM, DM, DM, (bf16_t*)(ws + WS_WOUT) + (size_t)l * DM * DM, 0, nullptr, scr, r, lane); continue; } r -= IT_OUT;
        if (r < IT_G) { transpose_item(Ap->in[23] + (size_t)l * DM * DFF, DM, DFF, (bf16_t*)(ws + WS_WGU) + (size_t)l * 2 * DFF * DM, 2, Ap->in[3] + l * DM, scr, r, lane); continue; } r -= IT_G;
        if (r < IT_U) { transpose_item(Ap->in[24] + (size_t)l * DM * DFF, DM, DFF, (bf16_t*)(ws + WS_WGU) + (size_t)l * 2 * DFF * DM, 3, Ap->in[3] + l * DM, scr, r, lane); continue; } r -= IT_U;
        if (r < IT_D) { transpose_item(Ap->in[25] + (size_t)l * DFF * DM, DFF, DM, (bf16_t*)(ws + WS_WDN) + (size_t)l * DM * DFF, 0, nullptr, scr, r, lane); continue; } r -= IT_D;
        if (r < IT_C1) { transpose_item(Ap->in[17] + (size_t)l * 2048 * 128, 2048, 128, (bf16_t*)(ws + WS_CW1) + (size_t)(l * 2 + 0) * 128 * 2048, 0, nullptr, scr, r, lane); continue; } r -= IT_C1;
        if (r < IT_C1) { transpose_item(Ap->in[20] + (size_t)l * 2048 * 128, 2048, 128, (bf16_t*)(ws + WS_CW1) + (size_t)(l * 2 + 1) * 128 * 2048, 0, nullptr, scr, r, lane); continue; } r -= IT_C1;
        if (r < IT_C2) { transpose_item(Ap->in[18] + (size_t)l * 128 * 64, 128, 64, (bf16_t*)(ws + WS_CW2) + (size_t)(l * 2 + 0) * 64 * 128, 0, nullptr, scr, r, lane); continue; } r -= IT_C2;
        transpose_item(Ap->in[21] + (size_t)l * 128 * 64, 128, 64, (bf16_t*)(ws + WS_CW2) + (size_t)(l * 2 + 1) * 64 * 128, 0, nullptr, scr, r, lane);
    }
    const float* x = Ap->in[0]; bf16_t* XB = (bf16_t*)(ws + WS_XB); float* rowsq = (float*)(ws + WS_RSQ);
    for (int m = gw; m < MTOK; m += NGW) {
        const f32x4* xr = (const f32x4*)(x + (size_t)m * DM) + lane; u32x2* xb = (u32x2*)(XB + (size_t)m * DM) + lane;
        float s = 0.f;
#pragma unroll
        for (int j = 0; j < 8; ++j) { const f32x4 v = __builtin_nontemporal_load(&xr[64 * j]); u32x2 w; w.x = pk2(v[0], v[1]); w.y = pk2(v[2], v[3]); xb[64 * j] = w; s += (v[0] * v[0] + v[1] * v[1]) + (v[2] * v[2] + v[3] * v[3]); }
        s = wave_sum(s);
        if (lane < 32) rowsq[(size_t)lane * MTOK + m] = (lane == 0) ? s : 0.f;
    }
}

__device__ __forceinline__ void sincos_small(float ang, float& sn, float& cs) {
    const float k = rintf(ang * 0.636619772f);
    float r = fmaf(-k, 1.5707963705f, ang); r = fmaf(-k, -4.37113883e-8f, r);
    const float r2 = r * r;
    const float s = r * (1.f + r2 * (-1.f / 6.f + r2 * (1.f / 120.f + r2 * (-1.f / 5040.f + r2 * (1.f / 362880.f)))));
    const float c = 1.f + r2 * (-0.5f + r2 * (1.f / 24.f + r2 * (-1.f / 720.f + r2 * (1.f / 40320.f))));
    const int q = ((int)k) & 3;
    sn = (q == 0) ? s : (q == 1) ? c : (q == 2) ? -s : -c;
    cs = (q == 0) ? c : (q == 1) ? -s : (q == 2) ? -c : s;
}

template <int PASS>
__device__ __forceinline__ void s5_task(CArgs* Ap, int l, int b, int g, int c, LAS unsigned char* wl, int lane) {
    if (PASS == 1 && c == NCHUNK - 1) return;
    unsigned char* ws = Ap->ws;
    const bf16_t* P = (const bf16_t*)(ws + p_off(l));
    f32x2* SST = (f32x2*)(ws + WS_SST + (size_t)l * MiB);
    LAS float* us = (LAS float*)wl;
    LAS bf16_t* Xs = (LAS bf16_t*)(wl + 1024);
    const int p = lane;
    const float a_re = fminf(Ap->in[6][(l * NGRP + g) * NST + p], -1e-4f), a_im = Ap->in[7][(l * NGRP + g) * NST + p];
    const float dt = expf(Ap->in[8][l * NGRP + g]);
    const float mag = expf(a_re * dt); float sn, cs; sincos_small(a_im * dt, sn, cs);
    const float ab_re = mag * cs, ab_im = mag * sn;
    const float nr = ab_re - 1.f, ni = ab_im, den = a_re * a_re + a_im * a_im;
    const float f_re = (nr * a_re + ni * a_im) / den, f_im = (ni * a_re - nr * a_im) / den;
    float bbr[16], bbi[16]; f32x2 bb2[16];
    {
        const f32x4* br = (const f32x4*)(Ap->in[9] + ((size_t)(l * NGRP + g) * NST + p) * 16); const f32x4* bi = (const f32x4*)(Ap->in[10] + ((size_t)(l * NGRP + g) * NST + p) * 16);
#pragma unroll
        for (int q = 0; q < 4; ++q) { const f32x4 vr = br[q], vi = bi[q];
#pragma unroll
            for (int i = 0; i < 4; ++i) { bbr[4 * q + i] = f_re * vr[i] - f_im * vi[i]; bbi[4 * q + i] = f_re * vi[i] + f_im * vr[i]; bb2[4 * q + i] = (f32x2){bbr[4 * q + i], bbi[4 * q + i]}; } }
    }
    float xr = 0.f, xi = 0.f;
    const int n16 = lane & 15, g4 = lane >> 4;
    bf16x8 cB[4]; float dval = 0.f;
    if (PASS == 2) {
        float pr = ab_re, pi = ab_im;
#pragma unroll
        for (int i = 0; i < 9; ++i) { const float t_ = pr * pr - pi * pi; pi = 2.f * pr * pi; pr = t_; }
        const f32x2* S = SST + (size_t)((b * NGRP + g) * NCHUNK) * NST + p;
        for (int cc = 0; cc < c; ++cc) { const f32x2 s = S[(size_t)cc * NST]; const float t_ = pr * xr - pi * xi + s.x; xi = pr * xi + pi * xr + s.y; xr = t_; }
        const float* cre = Ap->in[11] + ((size_t)(l * NGRP + g) * 16 + n16) * NST; const float* cim = Ap->in[12] + ((size_t)(l * NGRP + g) * 16 + n16) * NST;
#pragma unroll
        for (int kk = 0; kk < 4; ++kk) { const f32x4 r4 = *(const f32x4*)(cre + 16 * kk + 4 * g4), i4 = *(const f32x4*)(cim + 16 * kk + 4 * g4);
            u32x4 w; w.x = pk2(r4[0], -i4[0]); w.y = pk2(r4[1], -i4[1]); w.z = pk2(r4[2], -i4[2]); w.w = pk2(r4[3], -i4[3]);
            cB[kk] = __builtin_bit_cast(bf16x8, w); }
        dval = Ap->in[13][l * DSSM + g * 16 + n16];
    }
    const size_t row0 = (size_t)b * SEQ + (size_t)c * CHUNK;
    const bf16_t* up = P + (row0 + (lane >> 2)) * NINP + g * 16 + 4 * (lane & 3);
    u32x2 unext = *(const u32x2*)up;
    bf16_t* Y1 = (bf16_t*)(ws + WS_Y1);
    for (int tb = 0; tb < CHUNK; tb += 16) {
        const u32x2 ucur = unext;
        if (tb + 16 < CHUNK) unext = *(const u32x2*)(up + (size_t)(tb + 16) * NINP);
        *(LAS f32x4*)(us + (lane >> 2) * 16 + 4 * (lane & 3)) = (f32x4){bflo(ucur.x), bfhi(ucur.x), bflo(ucur.y), bfhi(ucur.y)};
        wave_lds_fence();
#pragma unroll 4
        for (int s = 0; s < 16; ++s) {
            const f32x4 u0 = *(const LAS f32x4*)(us + s * 16), u1 = *(const LAS f32x4*)(us + s * 16 + 4), u2 = *(const LAS f32x4*)(us + s * 16 + 8), u3 = *(const LAS f32x4*)(us + s * 16 + 12);
            f32x2 bu = (f32x2){0.f, 0.f};
#pragma unroll
            for (int i = 0; i < 4; ++i) bu = bb2[i] * (f32x2){u0[i], u0[i]} + bu;
#pragma unroll
            for (int i = 0; i < 4; ++i) bu = bb2[4 + i] * (f32x2){u1[i], u1[i]} + bu;
#pragma unroll
            for (int i = 0; i < 4; ++i) bu = bb2[8 + i] * (f32x2){u2[i], u2[i]} + bu;
#pragma unroll
            for (int i = 0; i < 4; ++i) bu = bb2[12 + i] * (f32x2){u3[i], u3[i]} + bu;
            const float br_ = bu.x, bi_ = bu.y;
            const float nxr = fmaf(ab_re, xr, fmaf(-ab_im, xi, br_)); const float nxi = fmaf(ab_re, xi, fmaf(ab_im, xr, bi_));
            xr = nxr; xi = nxi;
            if (PASS == 2) *(LAS unsigned*)(Xs + s * 136 + 2 * p) = pk2(xr, xi);
        }
        if (PASS == 2) {
            wave_lds_fence();
            f32x4 y = (f32x4){0.f, 0.f, 0.f, 0.f};
#pragma unroll
            for (int kk = 0; kk < 4; ++kk) { const bf16x8 xa = *(const LAS bf16x8*)(Xs + n16 * 136 + 32 * kk + 8 * g4); y = __builtin_amdgcn_mfma_f32_16x16x32_bf16(xa, cB[kk], y, 0, 0, 0); }
#pragma unroll
            for (int i = 0; i < 4; ++i) { const int tl = 4 * g4 + i; const float uv = us[tl * 16 + n16]; const float v = gelu_tanh(y[i] + dval * uv);
                Y1[(row0 + tb + tl) * DSSM + g * 16 + n16] = f2bf(v); }
        }
        wave_lds_fence();
    }
    if (PASS == 1) SST[(size_t)((b * NGRP + g) * NCHUNK + c) * NST + p] = (f32x2){xr, xi};
}

__device__ __forceinline__ void compress_task(CArgs* Ap, int l, int task, int lane) {
    unsigned char* ws = Ap->ws;
    const int kv = task & 1, nb = (task >> 1) & 31, g = (task >> 6) & 3, b = task >> 8;
    const int n16 = lane & 15, g4 = lane >> 4;
    const bf16_t* P = (const bf16_t*)(ws + p_off(l));
    const bf16_t* W1t = (const bf16_t*)(ws + WS_CW1) + (size_t)(l * 2 + kv) * 128 * 2048;
    const bf16_t* W2t = (const bf16_t*)(ws + WS_CW2) + (size_t)(l * 2 + kv) * 64 * 128;
    const float* pos = Ap->in[kv ? 19 : 16] + (size_t)l * 32 * 64;
    const int n = nb * 16 + n16;
    const int colb = (kv ? C_VC : C_KC) + g * 64;
    f32x4 acc[8];
#pragma unroll
    for (int h = 0; h < 8; ++h) acc[h] = (f32x4){0.f, 0.f, 0.f, 0.f};
#pragma unroll 2
    for (int ks = 0; ks < 64; ++ks) {
        const int itok = ks >> 1, d0 = 32 * (ks & 1) + 8 * g4;
        int tok = 16 * n + itok; tok = tok > SEQ - 1 ? SEQ - 1 : tok;
        const u32x4 raw = *(const u32x4*)(P + ((size_t)b * SEQ + tok) * NINP + colb + d0);
        const f32x4 p0 = *(const f32x4*)(pos + itok * 64 + d0), p1 = *(const f32x4*)(pos + itok * 64 + d0 + 4);
        u32x4 w;
        w.x = pk2(bflo(raw.x) + p0[0], bfhi(raw.x) + p0[1]); w.y = pk2(bflo(raw.y) + p0[2], bfhi(raw.y) + p0[3]);
        w.z = pk2(bflo(raw.z) + p1[0], bfhi(raw.z) + p1[1]); w.w = pk2(bflo(raw.w) + p1[2], bfhi(raw.w) + p1[3]);
        const bf16x8 fb = __builtin_bit_cast(bf16x8, w);
#pragma unroll
        for (int h = 0; h < 8; ++h) { const bf16x8 wa = *(const bf16x8*)(W1t + (size_t)(16 * h + n16) * 2048 + 32 * ks + 8 * g4); acc[h] = __builtin_amdgcn_mfma_f32_16x16x32_bf16(wa, fb, acc[h], 0, 0, 0); }
    }
    bf16x8 hB[4];
#pragma unroll
    for (int pp = 0; pp < 4; ++pp) { float v[8];
#pragma unroll
        for (int i = 0; i < 4; ++i) { v[i] = gelu_tanh(acc[2 * pp][i]); v[4 + i] = gelu_tanh(acc[2 * pp + 1][i]); }
        u32x4 w; w.x = pk2(v[0], v[1]); w.y = pk2(v[2], v[3]); w.z = pk2(v[4], v[5]); w.w = pk2(v[6], v[7]); hB[pp] = __builtin_bit_cast(bf16x8, w); }
    bf16_t* KC = (bf16_t*)(ws + WS_KC + (size_t)l * MiB); bf16_t* VCT = (bf16_t*)(ws + WS_VCT + (size_t)l * MiB);
#pragma unroll
    for (int dt = 0; dt < 4; ++dt) {
        f32x4 o = (f32x4){0.f, 0.f, 0.f, 0.f};
#pragma unroll
        for (int pp = 0; pp < 4; ++pp) { const bf16_t* wrow = W2t + (size_t)(16 * dt + n16) * 128 + 32 * pp + 4 * g4;
            const u32x2 lo = *(const u32x2*)wrow, hi = *(const u32x2*)(wrow + 16);
            u32x4 w; w.x = lo.x; w.y = lo.y; w.z = hi.x; w.w = hi.y;
            o = __builtin_amdgcn_mfma_f32_16x16x32_bf16(__builtin_bit_cast(bf16x8, w), hB[pp], o, 0, 0, 0); }
        if (kv == 0) { u32x2 w; w.x = pk2(o[0], o[1]); w.y = pk2(o[2], o[3]); *(u32x2*)(KC + (size_t)((b * 4 + g) * 8 + (n >> 6)) * 4096 + kswz(n & 63, 16 * dt + 4 * g4)) = w; }
        else {
#pragma unroll
            for (int i = 0; i < 4; ++i) VCT[(size_t)((b * 4 + g) * 8 + (n >> 6)) * 4096 + vswz(16 * dt + 4 * g4 + i, n & 63)] = f2bf(o[i]); }
    }
}

__device__ __forceinline__ void compress_simple(CArgs* Ap, int l, int task, LAS float* hs, int lane) {
    unsigned char* ws = Ap->ws;
    const int kv = task & 1, n0 = ((task >> 1) & 127) * 4, g = (task >> 8) & 3, b = task >> 10;
    const bf16_t* P = (const bf16_t*)(ws + p_off(l));
    const float* w1 = Ap->in[kv ? 20 : 17] + (size_t)l * 2048 * 128; const float* w2 = Ap->in[kv ? 21 : 18] + (size_t)l * 128 * 64;
    const float* pos = Ap->in[kv ? 19 : 16] + (size_t)l * 32 * 64;
    const int colb = (kv ? C_VC : C_KC) + g * 64;
    float h0[4] = {0.f, 0.f, 0.f, 0.f}, h1[4] = {0.f, 0.f, 0.f, 0.f};
    for (int i = 0; i < 32; ++i) {
        const bf16_t* pr[4];
#pragma unroll
        for (int r = 0; r < 4; ++r) { int tok = 16 * (n0 + r) + i; tok = tok > SEQ - 1 ? SEQ - 1 : tok; pr[r] = P + ((size_t)b * SEQ + tok) * NINP + colb; }
        for (int d8 = 0; d8 < 8; ++d8) {
            const f32x4 p0 = *(const f32x4*)(pos + i * 64 + d8 * 8), p1 = *(const f32x4*)(pos + i * 64 + d8 * 8 + 4);
            const float pv[8] = {p0[0], p0[1], p0[2], p0[3], p1[0], p1[1], p1[2], p1[3]};
            float f[4][8];
#pragma unroll
            for (int r = 0; r < 4; ++r) { const u32x4 raw = *(const u32x4*)(pr[r] + d8 * 8);
                f[r][0] = bflo(raw.x) + pv[0]; f[r][1] = bfhi(raw.x) + pv[1]; f[r][2] = bflo(raw.y) + pv[2]; f[r][3] = bfhi(raw.y) + pv[3];
                f[r][4] = bflo(raw.z) + pv[4]; f[r][5] = bfhi(raw.z) + pv[5]; f[r][6] = bflo(raw.w) + pv[6]; f[r][7] = bfhi(raw.w) + pv[7]; }
            const float* wr = w1 + (size_t)(i * 64 + d8 * 8) * 128 + lane;
#pragma unroll
            for (int e = 0; e < 8; ++e) { const float wa = wr[e * 128], wb = wr[e * 128 + 64];
#pragma unroll
                for (int r = 0; r < 4; ++r) { h0[r] = fmaf(f[r][e], wa, h0[r]); h1[r] = fmaf(f[r][e], wb, h1[r]); } }
        }
    }
#pragma unroll
    for (int r = 0; r < 4; ++r) { hs[r * 128 + lane] = gelu_tanh(h0[r]); hs[r * 128 + lane + 64] = gelu_tanh(h1[r]); }
    wave_lds_fence();
    float o[4] = {0.f, 0.f, 0.f, 0.f};
    for (int k = 0; k < 128; ++k) { const float w = w2[k * 64 + lane];
#pragma unroll
        for (int r = 0; r < 4; ++r) o[r] = fmaf(hs[r * 128 + k], w, o[r]); }
    wave_lds_fence();
    bf16_t* KC = (bf16_t*)(ws + WS_KC + (size_t)l * MiB); bf16_t* VCT = (bf16_t*)(ws + WS_VCT + (size_t)l * MiB);
#pragma unroll
    for (int r = 0; r < 4; ++r) { const int n = n0 + r;
        if (kv == 0) KC[(size_t)((b * 4 + g) * 8 + (n >> 6)) * 4096 + kswz(n & 63, lane)] = f2bf(o[r]);
        else VCT[(size_t)((b * 4 + g) * 8 + (n >> 6)) * 4096 + vswz(lane, n & 63)] = f2bf(o[r]); }
}

__device__ __forceinline__ int rel_bucket_i(int n) {
    if (n < 16) return n;
    int c = 0;
    c += n >= 16; c += n >= 21; c += n >= 27; c += n >= 35; c += n >= 46; c += n >= 59; c += n >= 77; c += n >= 99;
    c += n >= 128; c += n >= 166; c += n >= 216; c += n >= 280; c += n >= 363; c += n >= 470; c += n >= 609; c += n >= 790;
    return 15 + c;
}

struct SmState { float m, l; };

template <int MODE>
__device__ __forceinline__ void softmax_block(f32x4 (&acc)[4], int base, bool ok, int t, int g4, const LAS float* lutg, SmState& st, f32x4 (&O)[4], bf16x8 (&pB)[2]) {
    float mx = -1e30f; unsigned vm = 0u;
#pragma unroll
    for (int nt = 0; nt < 4; ++nt)
#pragma unroll
        for (int i = 0; i < 4; ++i) {
            const int key = base + 16 * nt + 4 * g4 + i;
            const int dist = (MODE == 0) ? t - (16 * key + 31) : t - key;
            bool valid = dist >= 0;
            if (MODE == 1) valid = valid && ok;
            if (MODE == 2) valid = valid && dist < 512;
            int dc = dist < 0 ? 0 : dist; dc = dc > 1023 ? 1023 : dc;
            const float lg = acc[nt][i] + lutg[dc * 4];
            acc[nt][i] = lg;
            if (valid) { mx = fmaxf(mx, lg); vm |= 1u << (nt * 4 + i); }
        }
    mx = fmaxf(mx, __shfl_xor(mx, 16)); mx = fmaxf(mx, __shfl_xor(mx, 32));
    const float mn = fmaxf(st.m, mx);
    const float sc = fexp(st.m - mn);
    float ls = 0.f;
#pragma unroll
    for (int nt = 0; nt < 4; ++nt)
#pragma unroll
        for (int i = 0; i < 4; ++i) { const float p = ((vm >> (nt * 4 + i)) & 1u) ? fexp(acc[nt][i] - mn) : 0.f; acc[nt][i] = p; ls += p; }
    st.l = st.l * sc + ls; st.m = mn;
#pragma unroll
    for (int dt = 0; dt < 4; ++dt) O[dt] = O[dt] * sc;
#pragma unroll
    for (int hh = 0; hh < 2; ++hh) { u32x4 w; w.x = pk2(acc[2 * hh][0], acc[2 * hh][1]); w.y = pk2(acc[2 * hh][2], acc[2 * hh][3]); w.z = pk2(acc[2 * hh + 1][0], acc[2 * hh + 1][1]); w.w = pk2(acc[2 * hh + 1][2], acc[2 * hh + 1][3]);
        pB[hh] = __builtin_bit_cast(bf16x8, w); }
}

__device__ __forceinline__ void load_k(bf16x8 (&kf)[4][2], const bf16_t* Kb, int lane) {
#pragma unroll
    for (int nt = 0; nt < 4; ++nt)
#pragma unroll
        for (int kk = 0; kk < 2; ++kk) kf[nt][kk] = *(const bf16x8*)(Kb + ((nt * 2 + kk) * 64 + lane) * 8);
}
__device__ __forceinline__ void load_v(bf16x8 (&vf)[4][2], const bf16_t* Vb, int lane) {
#pragma unroll
    for (int dt = 0; dt < 4; ++dt)
#pragma unroll
        for (int hh = 0; hh < 2; ++hh) vf[dt][hh] = *(const bf16x8*)(Vb + ((dt * 2 + hh) * 64 + lane) * 8);
}
__device__ __forceinline__ void qk_acc(f32x4 (&acc)[4], const bf16x8 (&kf)[4][2], const bf16x8 (&q)[2]) {
#pragma unroll
    for (int nt = 0; nt < 4; ++nt) { acc[nt] = __builtin_amdgcn_mfma_f32_16x16x32_bf16(kf[nt][0], q[0], acc[nt], 0, 0, 0); acc[nt] = __builtin_amdgcn_mfma_f32_16x16x32_bf16(kf[nt][1], q[1], acc[nt], 0, 0, 0); }
}
__device__ __forceinline__ void pv_acc(f32x4 (&O)[4], const bf16x8 (&vf)[4][2], const bf16x8 (&pB)[2]) {
#pragma unroll
    for (int dt = 0; dt < 4; ++dt) { O[dt] = __builtin_amdgcn_mfma_f32_16x16x32_bf16(vf[dt][0], pB[0], O[dt], 0, 0, 0); O[dt] = __builtin_amdgcn_mfma_f32_16x16x32_bf16(vf[dt][1], pB[1], O[dt], 0, 0, 0); }
}


__device__ __forceinline__ void load_kh(bf16x8 (&kf)[2][2], const bf16_t* Kb, int hh, int lane) {
#pragma unroll
    for (int nt = 0; nt < 2; ++nt)
#pragma unroll
        for (int kk = 0; kk < 2; ++kk) kf[nt][kk] = *(const bf16x8*)(Kb + (((2 * hh + nt) * 2 + kk) * 64 + lane) * 8);
}
__device__ __forceinline__ void load_vh(bf16x8 (&vf)[4], const bf16_t* Vb, int hh, int lane) {
#pragma unroll
    for (int dt = 0; dt < 4; ++dt) vf[dt] = *(const bf16x8*)(Vb + ((dt * 2 + hh) * 64 + lane) * 8);
}
__device__ __forceinline__ void qk_acch(f32x4 (&acc)[2], const bf16x8 (&kf)[2][2], const bf16x8 (&q)[2]) {
#pragma unroll
    for (int nt = 0; nt < 2; ++nt) { acc[nt] = __builtin_amdgcn_mfma_f32_16x16x32_bf16(kf[nt][0], q[0], acc[nt], 0, 0, 0); acc[nt] = __builtin_amdgcn_mfma_f32_16x16x32_bf16(kf[nt][1], q[1], acc[nt], 0, 0, 0); }
}
__device__ __forceinline__ void pv_acch(f32x4 (&O)[4], const bf16x8 (&vf)[4], const bf16x8 pB) {
#pragma unroll
    for (int dt = 0; dt < 4; ++dt) O[dt] = __builtin_amdgcn_mfma_f32_16x16x32_bf16(vf[dt], pB, O[dt], 0, 0, 0);
}
__device__ __forceinline__ void softmax_half_far(f32x4 (&acc)[2], const LAS float* lutg, SmState& st, f32x4 (&O)[4]) {
    const float bias = lutg[1023 * 4];
    float mx = -1e30f;
#pragma unroll
    for (int nt = 0; nt < 2; ++nt)
#pragma unroll
        for (int i = 0; i < 4; ++i) { const float lg = acc[nt][i] + bias; acc[nt][i] = lg; mx = fmaxf(mx, lg); }
    mx = fmaxf(mx, __shfl_xor(mx, 16)); mx = fmaxf(mx, __shfl_xor(mx, 32));
    const float mn = fmaxf(st.m, mx);
    const float sc = fexp(st.m - mn);
    float ls = 0.f;
#pragma unroll
    for (int nt = 0; nt < 2; ++nt)
#pragma unroll
        for (int i = 0; i < 4; ++i) { const float p = fexp(acc[nt][i] - mn); acc[nt][i] = p; ls += p; }
    st.l = st.l * sc + ls; st.m = mn;
#pragma unroll
    for (int dt = 0; dt < 4; ++dt) O[dt] = O[dt] * sc;
}
template <int MODE>
__device__ __forceinline__ void softmax_half(f32x4 (&acc)[2], int base, bool ok, int t, int g4, const LAS float* lutg, SmState& st, f32x4 (&O)[4], bf16x8& pB) {
    float mx = -1e30f; unsigned vm = 0u;
#pragma unroll
    for (int nt = 0; nt < 2; ++nt)
#pragma unroll
        for (int i = 0; i < 4; ++i) {
            const int key = base + 16 * nt + 4 * g4 + i;
            const int dist = t - key;
            bool valid = dist >= 0;
            if (MODE == 1) valid = valid && ok;
            if (MODE == 2) valid = valid && dist < 512;
            int dc = dist < 0 ? 0 : dist; dc = dc > 1023 ? 1023 : dc;
            const float lg = acc[nt][i] + lutg[dc * 4];
            acc[nt][i] = lg;
            if (valid) { mx = fmaxf(mx, lg); vm |= 1u << (nt * 4 + i); }
        }
    mx = fmaxf(mx, __shfl_xor(mx, 16)); mx = fmaxf(mx, __shfl_xor(mx, 32));
    const float mn = fmaxf(st.m, mx);
    const float sc = fexp(st.m - mn);
    float ls = 0.f;
#pragma unroll
    for (int nt = 0; nt < 2; ++nt)
#pragma unroll
        for (int i = 0; i < 4; ++i) { const float p = ((vm >> (nt * 4 + i)) & 1u) ? fexp(acc[nt][i] - mn) : 0.f; acc[nt][i] = p; ls += p; }
    st.l = st.l * sc + ls; st.m = mn;
#pragma unroll
    for (int dt = 0; dt < 4; ++dt) O[dt] = O[dt] * sc;
    u32x4 w; w.x = pk2(acc[0][0], acc[0][1]); w.y = pk2(acc[0][2], acc[0][3]); w.z = pk2(acc[1][0], acc[1][1]); w.w = pk2(acc[1][2], acc[1][3]);
    pB = __builtin_bit_cast(bf16x8, w);
}


__device__ __forceinline__ void load_kh8(long (&kf)[2][2], const unsigned char* Kb, int hh, int lane) {
#pragma unroll
    for (int nt = 0; nt < 2; ++nt)
#pragma unroll
        for (int kk = 0; kk < 2; ++kk) kf[nt][kk] = *(const long*)(Kb + (((2 * hh + nt) * 2 + kk) * 64 + lane) * 8);
}
__device__ __forceinline__ void load_vh8(long (&vf)[4], const unsigned char* Vb, int hh, int lane) {
#pragma unroll
    for (int dt = 0; dt < 4; ++dt) vf[dt] = *(const long*)(Vb + ((dt * 2 + hh) * 64 + lane) * 8);
}
__device__ __forceinline__ void qk_acch8(f32x4 (&acc)[2], const long (&kf)[2][2], const long (&q)[2]) {
#pragma unroll
    for (int nt = 0; nt < 2; ++nt) { acc[nt] = __builtin_amdgcn_mfma_f32_16x16x32_fp8_fp8(kf[nt][0], q[0], acc[nt], 0, 0, 0); acc[nt] = __builtin_amdgcn_mfma_f32_16x16x32_fp8_fp8(kf[nt][1], q[1], acc[nt], 0, 0, 0); }
}
__device__ __forceinline__ void pv_acch8(f32x4 (&O)[4], const long (&vf)[4], const long p8) {
#pragma unroll
    for (int dt = 0; dt < 4; ++dt) O[dt] = __builtin_amdgcn_mfma_f32_16x16x32_fp8_fp8(vf[dt], p8, O[dt], 0, 0, 0);
}
constexpr float P8_SCALE = 256.f;
__device__ __forceinline__ long p_to_fp8(const f32x4 (&acc)[2]) {
    return pack8_fp8(acc[0][0] * P8_SCALE, acc[0][1] * P8_SCALE, acc[0][2] * P8_SCALE, acc[0][3] * P8_SCALE, acc[1][0] * P8_SCALE, acc[1][1] * P8_SCALE, acc[1][2] * P8_SCALE, acc[1][3] * P8_SCALE);
}

__device__ __forceinline__ void nsa_wave(CArgs* Ap, int l, int b, int g, int tq0, const LAS float* lut, LAS float* imp, int lane) {
    unsigned char* ws = Ap->ws;
    const bf16_t* P = (const bf16_t*)(ws + p_off(l));
    const bf16_t* KC = (const bf16_t*)(ws + WS_KC + (size_t)l * MiB) + (size_t)(b * 4 + g) * 8 * 4096;
    const bf16_t* VCT = (const bf16_t*)(ws + WS_VCT + (size_t)l * MiB) + (size_t)(b * 4 + g) * 8 * 4096;
    const bf16_t* VST = (const bf16_t*)(ws + vt_off(l)) + (size_t)(b * 4 + g) * 128 * 4096;
    const bf16_t* VWT = (const bf16_t*)(ws + vt_off(l) + 8 * MiB) + (size_t)(b * 4 + g) * 128 * 4096;
    bf16_t* MIX = (bf16_t*)(ws + WS_MIX);
    const int n16 = lane & 15, g4 = lane >> 4, qi = n16 >> 2, r = n16 & 3;
    const int t = tq0 + qi;
    const bf16_t* prow = P + ((size_t)b * SEQ + t) * NINP;
    bf16x8 qB[2];
    qB[0] = *(const bf16x8*)(prow + C_Q + (4 * g + r) * 64 + 8 * g4); qB[1] = *(const bf16x8*)(prow + C_Q + (4 * g + r) * 64 + 8 * g4 + 32);
    float gt[3];
#pragma unroll
    for (int br = 0; br < 3; ++br) gt[br] = sigmoidf_(bf2f(prow[C_GATE + (4 * g + r) * 3 + br]));
    const LAS float* lutg = lut + g * 4096 + r;
    f32x4 outacc[4];
#pragma unroll
    for (int dt = 0; dt < 4; ++dt) outacc[dt] = (f32x4){0.f, 0.f, 0.f, 0.f};
#pragma unroll
    for (int i = 0; i < 8; ++i) *(LAS f32x4*)(imp + (i * 64 + lane) * 4) = (f32x4){0.f, 0.f, 0.f, 0.f};

    const int tmax = tq0 + 3;
    const int ncb = (tmax >= 31) ? ((((tmax - 31) >> 4) >> 6) + 1) : 0;
    {
        SmState st{-1e30f, 0.f};
        f32x4 Od[4];
#pragma unroll
        for (int dt = 0; dt < 4; ++dt) Od[dt] = (f32x4){0.f, 0.f, 0.f, 0.f};
        bf16x8 pB[2];
        for (int cb = 0; cb < ncb; ++cb) {
            bf16x8 kf[4][2]; load_k(kf, KC + (size_t)cb * 4096, lane);
            f32x4 acc[4];
#pragma unroll
            for (int nt = 0; nt < 4; ++nt) acc[nt] = (f32x4){0.f, 0.f, 0.f, 0.f};
            qk_acc(acc, kf, qB);
            softmax_block<0>(acc, cb * 64, true, t, g4, lutg, st, Od, pB);
        }
        float lt = st.l; lt += __shfl_xor(lt, 16); lt += __shfl_xor(lt, 32);
        const float inv = 1.f / fmaxf(lt, 1e-30f), mfin = st.m;
        for (int cb = 0; cb < ncb; ++cb) {
            bf16x8 kf[4][2]; load_k(kf, KC + (size_t)cb * 4096, lane);
            bf16x8 vf[4][2]; load_v(vf, VCT + (size_t)cb * 4096, lane);
            f32x4 acc[4];
#pragma unroll
            for (int nt = 0; nt < 4; ++nt) acc[nt] = (f32x4){0.f, 0.f, 0.f, 0.f};
            qk_acc(acc, kf, qB);
#pragma unroll
            for (int nt = 0; nt < 4; ++nt) {
                f32x4 pi4;
#pragma unroll
                for (int i = 0; i < 4; ++i) {
                    const int key = cb * 64 + 16 * nt + 4 * g4 + i; const int dist = t - (16 * key + 31);
                    int dc = dist < 0 ? 0 : dist; dc = dc > 1023 ? 1023 : dc;
                    const float lg = acc[nt][i] + lutg[dc * 4];
                    float p = (dist >= 0) ? fexp(lg - mfin) * inv : 0.f;
                    acc[nt][i] = p;
                    p += __shfl_xor(p, 1); p += __shfl_xor(p, 2);
                    pi4[i] = p;
                }
                if (r == 0) *(LAS f32x4*)(imp + qi * 512 + cb * 64 + 16 * nt + 4 * g4) = pi4;
            }
#pragma unroll
            for (int hh = 0; hh < 2; ++hh) { u32x4 w; w.x = pk2(acc[2 * hh][0], acc[2 * hh][1]); w.y = pk2(acc[2 * hh][2], acc[2 * hh][3]); w.z = pk2(acc[2 * hh + 1][0], acc[2 * hh + 1][1]); w.w = pk2(acc[2 * hh + 1][2], acc[2 * hh + 1][3]);
                pB[hh] = __builtin_bit_cast(bf16x8, w); }
            pv_acc(outacc, vf, pB);
        }
#pragma unroll
        for (int dt = 0; dt < 4; ++dt) outacc[dt] = outacc[dt] * gt[0];
    }
    wave_lds_fence();

    const int cur = tq0 >> 6;
    int selreg = -1;
    if (cur < 16) selreg = (n16 <= cur) ? n16 : -1;
    else {
        const int sq = lane >> 4, tsel = tq0 + sq; (void)tsel;
        float sc[8];
#pragma unroll
        for (int jj = 0; jj < 8; ++jj) { const int j = n16 + 16 * jj;
            float v;
            if (j > cur) v = -1.f;
            else if (j == 0 || j == cur || j == cur - 1) v = 1e4f;
            else { const LAS float* ip = imp + sq * 512 + 4 * j; v = ip[0] + 2.f * (ip[-1] + ip[-2] + ip[-3]) + ip[-4]; }
            sc[jj] = v; }
        for (int s = 0; s < 16; ++s) {
            float bv = sc[0]; int bj = n16;
#pragma unroll
            for (int jj = 1; jj < 8; ++jj) if (sc[jj] > bv) { bv = sc[jj]; bj = n16 + 16 * jj; }
#pragma unroll
            for (int off = 1; off < 16; off <<= 1) { const float ov = __shfl_xor(bv, off); const int oj = __shfl_xor(bj, off); if (ov > bv || (ov == bv && oj < bj)) { bv = ov; bj = oj; } }
            if (n16 == s) selreg = (bv >= 0.f) ? bj : -1;
#pragma unroll
            for (int jj = 0; jj < 8; ++jj) if (bj == n16 + 16 * jj) sc[jj] = -2.f;
        }
    }
    if (cur >= 16) {
        const int fj = selreg;
        const int key = (fj < 0) ? ((1 << 20) + n16) : ((fj == 0 || fj == cur || fj == cur - 1) ? fj : (1 << 10) + fj);
        int rank = 0;
#pragma unroll
        for (int o = 1; o < 16; ++o) { const int other = __shfl(key, (lane & 48) | ((n16 + o) & 15)); rank += (other < key) ? 1 : 0; }
        selreg = __builtin_amdgcn_ds_permute(((lane & 48) | rank) << 2, fj);
    }
    const int nvalid = (cur + 1) < 16 ? (cur + 1) : 16;
    wave_lds_fence();
#pragma unroll
    for (int dt = 0; dt < 4; ++dt) *(LAS f32x4*)(imp + (dt * 64 + lane) * 4) = outacc[dt];

    {
        SmState st{-1e30f, 0.f};
        f32x4 Od[4];
#pragma unroll
        for (int dt = 0; dt < 4; ++dt) Od[dt] = (f32x4){0.f, 0.f, 0.f, 0.f};
        const unsigned char* Ks8 = (const unsigned char*)(ws + WS_KST) + (size_t)(b * 4 + g) * 128 * 4096;
        const unsigned char* Vs8 = (const unsigned char*)(ws + WS_VST) + (size_t)(b * 4 + g) * 128 * 4096;
        long q8[2];
#pragma unroll
        for (int kk = 0; kk < 2; ++kk) { const u32x4 w = __builtin_bit_cast(u32x4, qB[kk]);
            q8[kk] = pack8_fp8(bflo(w.x), bfhi(w.x), bflo(w.y), bfhi(w.y), bflo(w.z), bfhi(w.z), bflo(w.w), bfhi(w.w)); }
        int ns = 0;
        for (; ns < nvalid; ++ns) { const int j0 = __builtin_amdgcn_readlane(selreg, ns), j1 = __builtin_amdgcn_readlane(selreg, 16 + ns), j2 = __builtin_amdgcn_readlane(selreg, 32 + ns), j3 = __builtin_amdgcn_readlane(selreg, 48 + ns);
            if (!(j0 >= 0 && j0 == j1 && j0 == j2 && j0 == j3)) break; }
        {
            long kh[2][2], vh[4];
            if (ns > 0) { const int j0_ = __builtin_amdgcn_readlane(selreg, 0); load_kh8(kh, Ks8 + (size_t)j0_ * 4096, 0, lane); load_vh8(vh, Vs8 + (size_t)j0_ * 4096, 0, lane); }
            for (int hs = 0; hs < 2 * ns; ++hs) {
                const int s = hs >> 1, hh = hs & 1;
                const int j = __builtin_amdgcn_readlane(selreg, s);
                const bool more = hs + 1 < 2 * ns; const int s1 = (hs + 1) >> 1, h1 = (hs + 1) & 1;
                const int jn = more ? __builtin_amdgcn_readlane(selreg, s1) : 0;
                f32x4 acc[2];
                acc[0] = (f32x4){0.f, 0.f, 0.f, 0.f}; acc[1] = (f32x4){0.f, 0.f, 0.f, 0.f};
                qk_acch8(acc, kh, q8);
                if (more) load_kh8(kh, Ks8 + (size_t)jn * 4096, h1, lane);
                if (__all(t - (j * 64 + 32 * hh + 31) >= 1023)) softmax_half_far(acc, lutg, st, Od);
                else { bf16x8 pB; softmax_half<1>(acc, j * 64 + 32 * hh, true, t, g4, lutg, st, Od, pB); }
                pv_acch8(Od, vh, p_to_fp8(acc));
                if (more) load_vh8(vh, Vs8 + (size_t)jn * 4096, h1, lane);
            }
        }
        const int nh = 2 * nvalid, h0 = 2 * ns;
        long kq[4][2][2], vq[4][4];
        if (h0 < nh) {
#pragma unroll
            for (int q2 = 0; q2 < 4; ++q2) { int j = __builtin_amdgcn_readlane(selreg, 16 * q2 + ns); j = j < 0 ? 0 : j; load_kh8(kq[q2], Ks8 + (size_t)j * 4096, 0, lane); load_vh8(vq[q2], Vs8 + (size_t)j * 4096, 0, lane); } }
        for (int hs = h0; hs < nh; ++hs) {
            const int s = hs >> 1, hh = hs & 1;
            const int jm = __shfl(selreg, 16 * qi + s);
            f32x4 acc[2];
            acc[0] = (f32x4){0.f, 0.f, 0.f, 0.f}; acc[1] = (f32x4){0.f, 0.f, 0.f, 0.f};
#pragma unroll
            for (int q2 = 0; q2 < 4; ++q2) { long qm[2]; qm[0] = (qi == q2) ? q8[0] : 0l; qm[1] = (qi == q2) ? q8[1] : 0l; qk_acch8(acc, kq[q2], qm); }
            const bool more = hs + 1 < nh; const int s1 = (hs + 1) >> 1, h1 = (hs + 1) & 1;
            int jn[4];
#pragma unroll
            for (int q2 = 0; q2 < 4; ++q2) { int j = more ? __builtin_amdgcn_readlane(selreg, 16 * q2 + s1) : 0; jn[q2] = j < 0 ? 0 : j; }
            if (more) {
#pragma unroll
                for (int q2 = 0; q2 < 4; ++q2) load_kh8(kq[q2], Ks8 + (size_t)jn[q2] * 4096, h1, lane); }
            if (__all(jm >= 0 && t - (jm * 64 + 32 * hh + 31) >= 1023)) softmax_half_far(acc, lutg, st, Od);
            else { bf16x8 pB; softmax_half<1>(acc, (jm < 0 ? 0 : jm) * 64 + 32 * hh, jm >= 0, t, g4, lutg, st, Od, pB); }
            const long p8 = p_to_fp8(acc);
#pragma unroll
            for (int q2 = 0; q2 < 4; ++q2) { const long pm = (qi == q2) ? p8 : 0l; pv_acch8(Od, vq[q2], pm); }
            if (more) {
#pragma unroll
                for (int q2 = 0; q2 < 4; ++q2) load_vh8(vq[q2], Vs8 + (size_t)jn[q2] * 4096, h1, lane); }
        }
        float lt = st.l; lt += __shfl_xor(lt, 16); lt += __shfl_xor(lt, 32);
        const float sc = gt[1] / (P8_SCALE * fmaxf(lt, 1e-30f));
#pragma unroll
        for (int dt = 0; dt < 4; ++dt) outacc[dt] = Od[dt] * sc;
    }

    {
        SmState st{-1e30f, 0.f};
        f32x4 Od[4];
#pragma unroll
        for (int dt = 0; dt < 4; ++dt) Od[dt] = (f32x4){0.f, 0.f, 0.f, 0.f};
        const bf16_t* Kw = (const bf16_t*)(ws + WS_KWT) + (size_t)(b * 4 + g) * 128 * 4096;
        const int lo = tq0 - 511, jb0 = (lo > 0 ? lo : 0) >> 6, jb1 = (tq0 + 3) >> 6;
        for (int jb = jb0; jb <= jb1; ++jb) {
            bf16x8 kf[4][2]; load_k(kf, Kw + (size_t)jb * 4096, lane);
            bf16x8 vf[4][2]; load_v(vf, VWT + (size_t)jb * 4096, lane);
            f32x4 acc[4];
#pragma unroll
            for (int nt = 0; nt < 4; ++nt) acc[nt] = (f32x4){0.f, 0.f, 0.f, 0.f};
            qk_acc(acc, kf, qB);
            bf16x8 pB[2];
            softmax_block<2>(acc, jb * 64, true, t, g4, lutg, st, Od, pB);
            pv_acc(Od, vf, pB);
        }
        float lt = st.l; lt += __shfl_xor(lt, 16); lt += __shfl_xor(lt, 32);
        const float sc = gt[2] / fmaxf(lt, 1e-30f);
#pragma unroll
        for (int dt = 0; dt < 4; ++dt) outacc[dt] = outacc[dt] + Od[dt] * sc;
    }
    wave_lds_fence();
#pragma unroll
    for (int dt = 0; dt < 4; ++dt) outacc[dt] = outacc[dt] + *(const LAS f32x4*)(imp + (dt * 64 + lane) * 4);
    bf16_t* orow = MIX + ((size_t)b * SEQ + t) * DM + DSSM + (4 * g + r) * 64 + 4 * g4;
#pragma unroll
    for (int dt = 0; dt < 4; ++dt) { u32x2 w; w.x = pk2(outacc[dt][0], outacc[dt][1]); w.y = pk2(outacc[dt][2], outacc[dt][3]); *(u32x2*)(orow + 16 * dt) = w; }
    wave_lds_fence();
}

__global__ void __launch_bounds__(512, 2) hymba_fwd(Args A_unused) {
    extern __shared__ __attribute__((aligned(16))) unsigned char lds_raw[];
    LAS unsigned char* lds = (LAS unsigned char*)lds_raw;
    cg::grid_group grid = cg::this_grid();
#define GRID_SYNC() do { asm volatile("s_waitcnt vmcnt(0) lgkmcnt(0)" ::: "memory"); grid.sync(); \
    asm volatile("buffer_inv sc1\n\ts_waitcnt vmcnt(0) lgkmcnt(0)" ::: "memory"); } while (0)
    const int wave0 = __builtin_amdgcn_readfirstlane(threadIdx.x >> 6);
#define PHASE_IDS() int wv_ = wave0; asm volatile("" : "+s"(wv_)); int tid; asm volatile("v_mbcnt_lo_u32_b32 %0, -1, 0\n\tv_mbcnt_hi_u32_b32 %0, -1, %0" : "=v"(tid)); tid += wv_ * 64; asm volatile("" : "+v"(tid)); const int lane = tid & 63, wave = __builtin_amdgcn_readfirstlane(tid >> 6); \
    int G = gridDim.x, blk = blockIdx.x; asm volatile("" : "+s"(G), "+s"(blk)); const int gw = blk * 8 + wave, NGW = G * 8; (void)lane; (void)gw; (void)NGW;

    unsigned nsync = 0;
#define FAST_SYNC() do { asm volatile("s_waitcnt vmcnt(0) lgkmcnt(0)" ::: "memory"); __syncthreads(); ++nsync; \
    { int l0_; asm volatile("v_mbcnt_lo_u32_b32 %0, -1, 0\n\tv_mbcnt_hi_u32_b32 %0, -1, %0" : "=v"(l0_)); \
      if (wave0 == 0 && l0_ == 0) { unsigned* bar_ = (unsigned*)(get_args()->ws + WS_CTL); const unsigned tgt_ = nsync * gridDim.x; \
        __builtin_amdgcn_fence(__ATOMIC_RELEASE, "agent"); asm volatile("s_waitcnt vmcnt(0)" ::: "memory"); \
        __hip_atomic_fetch_add(bar_, 1u, __ATOMIC_RELAXED, __HIP_MEMORY_SCOPE_AGENT); \
        for (unsigned sp_ = 0; sp_ < (1u << 22); ++sp_) { if (__hip_atomic_load(bar_, __ATOMIC_RELAXED, __HIP_MEMORY_SCOPE_AGENT) >= tgt_) break; __builtin_amdgcn_s_sleep(2); } } } \
    __syncthreads(); asm volatile("buffer_inv sc1\n\ts_waitcnt vmcnt(0) lgkmcnt(0)" ::: "memory"); } while (0)

    { PHASE_IDS(); if (blk == 0 && tid == 0) __hip_atomic_store((unsigned*)(get_args()->ws + WS_CTL), 0u, __ATOMIC_RELAXED, __HIP_MEMORY_SCOPE_AGENT);
      prologue(lds, wave, lane, gw, NGW); }
    GRID_SYNC();

#pragma nounroll
    for (int l = 0; l < DEPTH; ++l) {
        {
            PHASE_IDS(); CArgs* Ap = get_args(); unsigned char* ws = Ap->ws;
            pg8::Gemm g{(const bf16_t*)(ws + WS_XB), (const bf16_t*)(ws + WS_WIN) + (size_t)l * NINP * DM, MTOK, NINP, DM}; pg8::StaticOrder S; S.init(MTOK, NINP, G, blk);
            const float* rq = (const float*)(ws + WS_RSQ) + (size_t)(2 * l) * RSQ_BUF; LAS float* tab = (LAS float*)(lds + 131072);
            pg8::Unit u0; const int pm0 = S.next(0, u0) ? u0.pm : -1; if (pm0 >= 0) rstd_table(rq, pm0, tab, tid); else __syncthreads();
            EpiInProj E{ws, rq, tab, pm0};
            pg8::gemm_phase<EpiInProj, pg8::StaticOrder, true, true>(lds, g, S, E, tid);
        }
        FAST_SYNC();
        {
            PHASE_IDS(); CArgs* Ap = get_args();
            for (int wt = blk; wt < 256; wt += G) { const int b_ = wt >> 7, cp_ = (wt >> 4) & 7, gq_ = wt & 15;
                s5_task<1>(Ap, l, b_, 4 * gq_ + (wave & 3), 2 * cp_ + (wave >> 2), lds + wave * 8192, lane); }
            if (wave < 2) for (int task = blk * 2 + wave; task < 512; task += G * 2) compress_task(Ap, l, task, lane);
        }
        FAST_SYNC();
        {
            PHASE_IDS(); CArgs* Ap = get_args();
            for (int wt = blk; wt < 256; wt += G) { const int b_ = wt >> 7, cp_ = (wt >> 4) & 7, gq_ = wt & 15;
                s5_task<2>(Ap, l, b_, 4 * gq_ + (wave & 3), 2 * cp_ + (wave >> 2), lds + wave * 8192, lane); }
            __syncthreads();
            LAS float* lut = (LAS float*)lds;
            { const float* tab = Ap->in[1];
              for (int e = tid; e < 4 * 1024 * 4; e += 512) { const int r = e & 3, dist = (e >> 2) & 1023, gg = e >> 12; lut[e] = tab[rel_bucket_i(dist) * 16 + gg * 4 + r]; } }
            __syncthreads();
            LAS float* imp = (LAS float*)(lds + 65536 + wave * 8192);
            for (int i = 0; ; ++i) {
                const int unit = i * G + blk; if (unit >= 2048) break;
                const int bg = unit >> 8; int qt = unit & 255; qt = ((qt & 7) << 5) | (qt >> 3);
                if (i & 1) qt = 255 - qt;
                nsa_wave(Ap, l, bg >> 2, bg & 3, qt * 32 + wave * 4, lut, imp, lane);
            }
            __syncthreads();
        }
        FAST_SYNC();
        {
            PHASE_IDS(); CArgs* Ap = get_args(); unsigned char* ws = Ap->ws;
            pg8::Gemm g{(const bf16_t*)(ws + WS_Y1), (const bf16_t*)(ws + WS_WGLU) + (size_t)l * 2 * DSSM * DSSM, MTOK, 2 * DSSM, DSSM}; pg8::StaticOrder S; S.init(MTOK, 2 * DSSM, G, blk);
            EpiGlu E{(bf16_t*)(ws + WS_MIX), Ap->in[15] + (size_t)l * 2 * DSSM};
            pg8::gemm_phase<EpiGlu, pg8::StaticOrder, true, true>(lds, g, S, E, tid);
        }
        FAST_SYNC();
        {
            PHASE_IDS(); CArgs* Ap = get_args(); unsigned char* ws = Ap->ws;
            pg8::Gemm g{(const bf16_t*)(ws + WS_MIX), (const bf16_t*)(ws + WS_WOUT) + (size_t)l * DM * DM, MTOK, DM, DM}; pg8::StaticOrder S; S.init(MTOK, DM, G, blk);
            EpiResid E{(bf16_t*)(ws + WS_XB), (float*)(ws + WS_RSQ) + (size_t)(2 * l + 1) * RSQ_BUF};
            pg8::gemm_phase<EpiResid, pg8::StaticOrder, true, true>(lds, g, S, E, tid);
        }
        FAST_SYNC();
        {
            PHASE_IDS(); CArgs* Ap = get_args(); unsigned char* ws = Ap->ws;
            pg8::Gemm g{(const bf16_t*)(ws + WS_XB), (const bf16_t*)(ws + WS_WGU) + (size_t)l * 2 * DFF * DM, MTOK, 2 * DFF, DM}; pg8::StaticOrder S; S.init(MTOK, 2 * DFF, G, blk);
            const float* rq = (const float*)(ws + WS_RSQ) + (size_t)(2 * l + 1) * RSQ_BUF; LAS float* tab = (LAS float*)(lds + 131072);
            pg8::Unit u0; const int pm0 = S.next(0, u0) ? u0.pm : -1; if (pm0 >= 0) rstd_table(rq, pm0, tab, tid); else __syncthreads();
            EpiSwiglu E{(bf16_t*)(ws + WS_HID), rq, tab, pm0};
            pg8::gemm_phase<EpiSwiglu, pg8::StaticOrder, true, true>(lds, g, S, E, tid);
        }
        FAST_SYNC();
        {
            PHASE_IDS(); CArgs* Ap = get_args(); unsigned char* ws = Ap->ws;
            pg8::Gemm g{(const bf16_t*)(ws + WS_HID), (const bf16_t*)(ws + WS_WDN) + (size_t)l * DM * DFF, MTOK, DM, DFF}; pg8::StaticOrder S; S.init(MTOK, DM, G, blk);
            EpiResid E{(bf16_t*)(ws + WS_XB), (float*)(ws + WS_RSQ) + (size_t)(2 * l + 2) * RSQ_BUF};
            pg8::gemm_phase<EpiResid, pg8::StaticOrder, true, true>(lds, g, S, E, tid);
        }
        FAST_SYNC();
    }
    {
        PHASE_IDS(); CArgs* Ap = get_args();
        const float* fr = (const float*)(Ap->ws + WS_RSQ) + (size_t)(2 * DEPTH) * RSQ_BUF; const float* gn = Ap->in[4]; float* out = Ap->out;
        for (int m = gw; m < MTOK; m += NGW) {
            const float sq = wave_sum(lane < 32 ? fr[(size_t)lane * MTOK + m] : 0.f);
            const float rstd = rsqrtf(sq * (1.f / DM) + EPS);
            f32x4* xo = (f32x4*)(out + (size_t)m * DM) + lane; const f32x4* gp = (const f32x4*)gn + lane; const u32x2* xb = (const u32x2*)((const bf16_t*)(Ap->ws + WS_XB) + (size_t)m * DM) + lane;
#pragma unroll
            for (int j = 0; j < 8; ++j) { const u32x2 q = xb[64 * j]; f32x4 v = (f32x4){bflo(q.x), bfhi(q.x), bflo(q.y), bfhi(q.y)}; const f32x4 gg = gp[64 * j]; v = v * rstd * gg; __builtin_nontemporal_store(v, &xo[64 * j]); }
        }
    }
}

extern "C" void kernel_launch(void* const* d_in, const int* in_sizes, int n_in, void* d_out, int out_size, void* d_ws, size_t ws_size, hipStream_t stream) {
    static int grid = 0;
    if (grid == 0) {
        if (n_in != 26 || ws_size < WS_END) { fprintf(stderr, "kernel_launch: unexpected inputs (n_in %d, ws %zu, need %zu)\n", n_in, ws_size, (size_t)WS_END); grid = -1; return; }
        int dev = 0, cus = 0, per_cu = 0;
        hipGetDevice(&dev); hipDeviceGetAttribute(&cus, hipDeviceAttributeMultiprocessorCount, dev);
        hipFuncSetAttribute((const void*)hymba_fwd, hipFuncAttributeMaxDynamicSharedMemorySize, LDS_BYTES);
        hipOccupancyMaxActiveBlocksPerMultiprocessor(&per_cu, (const void*)hymba_fwd, 512, LDS_BYTES);
        if (per_cu < 1) { fprintf(stderr, "kernel_launch: occupancy query says %d blocks per CU\n", per_cu); per_cu = 1; }
        grid = cus * 1;
        (void)hipGetLastError();
    }
    if (grid < 0) return;
    Args a{};
    for (int i = 0; i < 26; ++i) a.in[i] = (const float*)d_in[i];
    a.out = (float*)d_out; a.ws = (unsigned char*)d_ws;
    void* args[] = {&a};
    hipError_t e = hipLaunchCooperativeKernel((const void*)hymba_fwd, dim3(grid), dim3(512), args, LDS_BYTES, stream);
    if (e != hipSuccess) fprintf(stderr, "cooperative launch failed: %s (grid %d)\n", hipGetErrorString(e), grid);
}
```

```cpp
#include <hip/hip_runtime.h>
#include <hip/hip_cooperative_groups.h>
#include <cstdio>
#include <cstdint>
namespace cg = cooperative_groups;

#define LAS __attribute__((address_space(3)))
typedef unsigned short bf16_t;
typedef short bf16x8 __attribute__((ext_vector_type(8)));
typedef short s16x4 __attribute__((ext_vector_type(4)));
typedef float f32x4 __attribute__((ext_vector_type(4)));
typedef float f32x2 __attribute__((ext_vector_type(2)));
typedef unsigned u32x4 __attribute__((ext_vector_type(4)));
typedef unsigned u32x2 __attribute__((ext_vector_type(2)));

constexpr int NB = 2, SEQ = 8192, MTOK = NB * SEQ, DM = 2048, DEPTH = 4;
constexpr int NIN = 3632, NINP = 3840;
constexpr int DSSM = 1024, NGRP = 64, NST = 64;
constexpr int NKV = 4, HD = 64;
constexpr int DFF = 5632;
constexpr int NCHUNK = 16, CHUNK = SEQ / NCHUNK;
constexpr float EPS = 1e-6f;
constexpr int C_Q = 1024, C_KC = 2048, C_VC = 2304, C_KS = 2560, C_KW = 3072, C_GATE = 3584;

constexpr size_t MiB = 1u << 20;
constexpr size_t WS_CTL = 0;
constexpr size_t WS_WIN = 1 * MiB;
constexpr size_t WS_WGLU = WS_WIN + 60 * MiB;
constexpr size_t WS_WOUT = WS_WGLU + 16 * MiB;
constexpr size_t WS_WGU = WS_WOUT + 32 * MiB;
constexpr size_t WS_WDN = WS_WGU + 176 * MiB;
constexpr size_t WS_CW1 = WS_WDN + 88 * MiB;
constexpr size_t WS_CW2 = WS_CW1 + 4 * MiB;
constexpr size_t WS_XB = WS_CW2 + 1 * MiB;
constexpr size_t WS_P = WS_XB + 64 * MiB;
constexpr size_t WS_Y1 = WS_P + 120 * MiB;
constexpr size_t WS_MIX = WS_Y1 + 32 * MiB;
constexpr size_t WS_HID = WS_P;
constexpr size_t WS_VST = WS_MIX + 64 * MiB;
constexpr size_t WS_VWT = WS_VST + 8 * MiB;
constexpr size_t WS_KC = WS_VWT + 8 * MiB;
constexpr size_t WS_VCT = WS_KC + 4 * MiB;
constexpr size_t WS_SST = WS_VCT + 4 * MiB;
constexpr size_t WS_RSQ = WS_SST + 4 * MiB;
constexpr size_t WS_P1 = WS_RSQ + 18 * MiB;
constexpr size_t WS_VT1 = WS_P1 + 120 * MiB;
constexpr size_t WS_END = WS_P1 + 16 * MiB;
__host__ __device__ __forceinline__ size_t p_off(int) { return WS_P; }
__host__ __device__ __forceinline__ size_t vt_off(int) { return WS_VST; }
constexpr size_t WS_KST = WS_P1;
constexpr size_t WS_KWT = WS_P1 + 8 * MiB;
constexpr size_t RSQ_BUF = (size_t)32 * MTOK;

constexpr int LDS_BYTES = 135168;

namespace pg8 {
constexpr int BM = 256, BK = 64, HALF = 128, HTB = HALF * BK * 2, STAGE_BYTES = 8 * HTB, NXCD = 8, WGM = 8;
__host__ __device__ __forceinline__ int lds_byte(int r, int c) { const int st = (r >> 4) * 2 + (c >> 5), rr = r & 15, cc = c & 31, ob = rr * 64 + cc * 2; return st * 1024 + (ob ^ (((ob >> 9) & 1) << 5)); }
__host__ __device__ __forceinline__ void stage_rc(int b, int& R, int& C) { const int st = b / 1024, sb = b % 1024, swz = sb ^ (((sb >> 9) & 1) << 5); R = (st >> 1) * 16 + swz / 64; C = (st & 1) * 32 + (swz % 64) / 2; }
struct Unit { int pm, pn; };
struct Gemm { const bf16_t* A; const bf16_t* Bt; int M, N, K; };
struct StaticOrder {
    int nM, nN, nwg, G, c;
    __host__ __device__ void init(int M, int N, int G_, int c_) { nM = M / BM; nN = N / BM; nwg = nM * nN; G = G_; c = c_; }
    __host__ __device__ bool next(int i, Unit& u) const {
        const long L = (long)i * G + c; if (L >= nwg) return false;
        int wgid = (int)L; { const int q = nwg / NXCD, r = nwg % NXCD, xcd = wgid % NXCD, off = wgid / NXCD; wgid = (xcd < r ? xcd * (q + 1) : r * (q + 1) + (xcd - r) * q) + off; }
        const int nig = WGM * nN, gid = wgid / nig, fm = gid * WGM, gsz = (nM - fm) < WGM ? (nM - fm) : WGM;
        u.pm = fm + ((wgid % nig) % gsz); u.pn = (wgid % nig) / gsz; return true;
    }
};
typedef float f32x2_cv __attribute__((ext_vector_type(2))); typedef __bf16 bf16x2_cv __attribute__((ext_vector_type(2)));
__device__ __forceinline__ unsigned cvt_pk_bf16(float lo, float hi) { const f32x2_cv v = {lo, hi}; const bf16x2_cv b = __builtin_convertvector(v, bf16x2_cv); return __builtin_bit_cast(unsigned, b); }

template <class Epi, class Sched, bool ALIGN_EPI = false, bool SP2 = false>
__device__ __forceinline__ void gemm_phase(LAS unsigned char* lds, const Gemm g, const Sched& S, const Epi& E, const int tid) {
    const int wid = __builtin_amdgcn_readfirstlane(tid >> 6), lane = tid & 63, wr = wid >> 2, wc = wid & 3, fr = lane & 15, fq = lane >> 4;
    const int K = g.K, nt = K / BK;
    unsigned voffA[2], voffB[2];
#pragma unroll
    for (int i = 0; i < 2; ++i) { int R, C; stage_rc(tid * 16 + i * 8192, R, C); voffA[i] = (unsigned)(R * K + C) * 2u; voffB[i] = voffA[i]; }
    const size_t kstep = (size_t)(BK * 2);
    const size_t hstep = (size_t)HALF * K * 2;
    const size_t tstep = 2 * hstep;
    const unsigned ldsw = (unsigned)wid * 1024u;
    const int aoff = lds_byte(wr * 64 + fr, fq * 8), boff = lds_byte(wc * 32 + fr, fq * 8);
#define PG8_SA(b, h) (((b) * 2 + (h)) * HTB)
#define PG8_SB(b, h) ((4 + (b) * 2 + (h)) * HTB)
#define PG8_STAGE(bufoff, gbase, voff) do { _Pragma("unroll") for (int _i = 0; _i < 2; ++_i) \
        __builtin_amdgcn_global_load_lds((const unsigned*)((const char*)(gbase) + (voff)[_i]), (LAS unsigned*)(lds + (bufoff) + ldsw + _i * 8192), 16, 0, 0); } while (0)
#define PG8_LDA(dst, b, h) do { _Pragma("unroll") for (int m = 0; m < 4; ++m) _Pragma("unroll") for (int k = 0; k < 2; ++k) dst[m][k] = *(const LAS bf16x8*)(lds + PG8_SA(b, h) + aoff + m * 2048 + k * 1024); } while (0)
#define PG8_LDB(dst, b, h) do { _Pragma("unroll") for (int n = 0; n < 2; ++n) _Pragma("unroll") for (int k = 0; k < 2; ++k) dst[n][k] = *(const LAS bf16x8*)(lds + PG8_SB(b, h) + boff + n * 2048 + k * 1024); } while (0)
#define PG8_MMA(ai, bj, At, Bt) do { __builtin_amdgcn_s_setprio(1); _Pragma("unroll") for (int m = 0; m < 4; ++m) _Pragma("unroll") for (int n = 0; n < 2; ++n) _Pragma("unroll") for (int k = 0; k < 2; ++k) \
        acc[ai][bj][m][n] = __builtin_amdgcn_mfma_f32_16x16x32_bf16(Bt[n][k], At[m][k], acc[ai][bj][m][n], 0, 0, 0); __builtin_amdgcn_s_setprio(0); } while (0)
#define PG8_WAIT_V(n) asm volatile("s_waitcnt vmcnt(" #n ")" ::: "memory")
#define PG8_WAIT_L(n) asm volatile("s_waitcnt lgkmcnt(" #n ")" ::: "memory")
#define PG8_BAR __builtin_amdgcn_s_barrier()
#define PG8_SCHED __builtin_amdgcn_sched_barrier(0)
    Unit cur, nxt; int ui = 0;
    if (!S.next(0, cur)) return;
    f32x4 acc[2][2][4][2];
#pragma unroll
    for (int a = 0; a < 2; ++a)
#pragma unroll
        for (int b = 0; b < 2; ++b)
#pragma unroll
            for (int m = 0; m < 4; ++m)
#pragma unroll
                for (int n = 0; n < 2; ++n) acc[a][b][m][n] = (f32x4){0.f, 0.f, 0.f, 0.f};
    bf16x8 At[4][2], B0[2][2], B1[2][2];
    const char* cA = (const char*)g.A + (size_t)cur.pm * tstep; const char* cB = (const char*)g.Bt + (size_t)cur.pn * tstep;
    if constexpr (SP2) {
        PG8_STAGE(PG8_SB(0, 0), cB, voffB); PG8_STAGE(PG8_SB(0, 1), cB + hstep, voffB); PG8_STAGE(PG8_SA(0, 0), cA, voffA); PG8_STAGE(PG8_SA(0, 1), cA + hstep, voffA);
        if (wr == 1) PG8_BAR;
        PG8_WAIT_V(2); PG8_BAR;
        PG8_STAGE(PG8_SB(1, 0), cB + kstep, voffB); PG8_STAGE(PG8_SA(1, 0), cA + kstep, voffA); PG8_STAGE(PG8_SB(1, 1), cB + hstep + kstep, voffB);
        PG8_WAIT_V(6); PG8_BAR;
    } else {
        PG8_STAGE(PG8_SB(0, 0), cB, voffB); PG8_STAGE(PG8_SA(0, 0), cA, voffA); PG8_STAGE(PG8_SB(0, 1), cB + hstep, voffB); PG8_STAGE(PG8_SA(0, 1), cA + hstep, voffA);
        if (wr == 1) PG8_BAR;
        PG8_WAIT_V(4); PG8_BAR;
        PG8_STAGE(PG8_SB(1, 0), cB + kstep, voffB); PG8_STAGE(PG8_SA(1, 0), cA + kstep, voffA); PG8_STAGE(PG8_SB(1, 1), cB + hstep + kstep, voffB);
        PG8_WAIT_V(6); PG8_BAR;
    }
    for (;;) {
        const bool has_next = S.next(ui + 1, nxt);
        const char* nA = has_next ? (const char*)g.A + (size_t)nxt.pm * tstep : cA; const char* nB = has_next ? (const char*)g.Bt + (size_t)nxt.pn * tstep : cB;
        for (int t = 0; t < nt; t += 2) {
            const bool last = (t == nt - 2);
            const char* a1 = cA + (size_t)(t + 1) * kstep;
            const char* a2 = last ? nA : cA + (size_t)(t + 2) * kstep; const char* b2 = last ? nB : cB + (size_t)(t + 2) * kstep;
            const char* a3 = a2 + kstep; const char* b3 = b2 + kstep;
            if constexpr (SP2) {
            PG8_LDB(B0, 0, 0); PG8_LDB(B1, 0, 1); PG8_SCHED; PG8_LDA(At, 0, 0); PG8_STAGE(PG8_SA(1, 1), a1 + hstep, voffA);
            PG8_WAIT_V(8); PG8_WAIT_L(0); PG8_BAR; PG8_MMA(0, 0, At, B0); PG8_MMA(0, 1, At, B1); PG8_BAR; PG8_SCHED;
            PG8_LDA(At, 0, 1); PG8_STAGE(PG8_SB(0, 0), b2, voffB); PG8_STAGE(PG8_SB(0, 1), b2 + hstep, voffB); PG8_STAGE(PG8_SA(0, 0), a2, voffA);
            PG8_WAIT_V(8); PG8_WAIT_L(0); PG8_BAR; PG8_MMA(1, 0, At, B0); PG8_MMA(1, 1, At, B1); PG8_BAR; PG8_SCHED;
            PG8_LDB(B0, 1, 0); PG8_LDB(B1, 1, 1); PG8_SCHED; PG8_LDA(At, 1, 0); PG8_STAGE(PG8_SA(0, 1), a2 + hstep, voffA);
            PG8_WAIT_V(8); PG8_WAIT_L(0); PG8_BAR; PG8_MMA(0, 0, At, B0); PG8_MMA(0, 1, At, B1); PG8_BAR; PG8_SCHED;
            PG8_LDA(At, 1, 1); PG8_STAGE(PG8_SB(1, 0), b3, voffB); PG8_STAGE(PG8_SB(1, 1), b3 + hstep, voffB); PG8_STAGE(PG8_SA(1, 0), a3, voffA);
            PG8_WAIT_V(8); PG8_WAIT_L(0); PG8_BAR; PG8_MMA(1, 0, At, B0); PG8_MMA(1, 1, At, B1); PG8_BAR; PG8_SCHED;
            } else {
            PG8_LDB(B0, 0, 0); PG8_SCHED; PG8_LDA(At, 0, 0); PG8_STAGE(PG8_SA(1, 1), a1 + hstep, voffA);
            PG8_WAIT_L(8); PG8_BAR; PG8_WAIT_L(0); PG8_MMA(0, 0, At, B0); PG8_BAR; PG8_SCHED;
            PG8_LDB(B1, 0, 1); PG8_STAGE(PG8_SB(0, 0), b2, voffB);
            PG8_BAR; PG8_WAIT_L(0); PG8_MMA(0, 1, At, B1); PG8_BAR;
            PG8_LDA(At, 0, 1); PG8_STAGE(PG8_SA(0, 0), a2, voffA);
            PG8_BAR; PG8_WAIT_L(0); PG8_MMA(1, 0, At, B0); PG8_BAR; PG8_SCHED;
            PG8_STAGE(PG8_SB(0, 1), b2 + hstep, voffB);
            PG8_WAIT_V(6); PG8_BAR; PG8_MMA(1, 1, At, B1); PG8_BAR;
            PG8_LDB(B0, 1, 0); PG8_SCHED; PG8_LDA(At, 1, 0); PG8_STAGE(PG8_SA(0, 1), a2 + hstep, voffA);
            PG8_WAIT_L(8); PG8_BAR; PG8_WAIT_L(0); PG8_MMA(0, 0, At, B0); PG8_BAR; PG8_SCHED;
            PG8_LDB(B1, 1, 1); PG8_STAGE(PG8_SB(1, 0), b3, voffB);
            PG8_BAR; PG8_WAIT_L(0); PG8_MMA(0, 1, At, B1); PG8_BAR;
            PG8_LDA(At, 1, 1); PG8_STAGE(PG8_SA(1, 0), a3, voffA);
            PG8_BAR; PG8_WAIT_L(0); PG8_MMA(1, 0, At, B0); PG8_BAR; PG8_SCHED;
            PG8_STAGE(PG8_SB(1, 1), b3 + hstep, voffB);
            PG8_WAIT_V(6); PG8_BAR; PG8_MMA(1, 1, At, B1); PG8_BAR;
            }
        }
        if constexpr (ALIGN_EPI) { if (wr == 0) PG8_BAR; }
        E(acc, cur, wr, wc, fr, fq);
        if (!has_next) break;
#pragma unroll
        for (int a = 0; a < 2; ++a)
#pragma unroll
            for (int b = 0; b < 2; ++b)
#pragma unroll
                for (int m = 0; m < 4; ++m)
#pragma unroll
                    for (int n = 0; n < 2; ++n) acc[a][b][m][n] = (f32x4){0.f, 0.f, 0.f, 0.f};
        cur = nxt; cA = nA; cB = nB; ++ui;
        if constexpr (ALIGN_EPI) { if (wr == 1) PG8_BAR; }
    }
    PG8_WAIT_V(0);
    if constexpr (!ALIGN_EPI) { if (wr == 0) PG8_BAR; }
    PG8_BAR;
#undef PG8_SA
#undef PG8_SB
#undef PG8_STAGE
#undef PG8_LDA
#undef PG8_LDB
#undef PG8_MMA
#undef PG8_WAIT_V
#undef PG8_WAIT_L
#undef PG8_BAR
#undef PG8_SCHED
}
}

__device__ __forceinline__ unsigned pk2(float lo, float hi) { return pg8::cvt_pk_bf16(lo, hi); }
__device__ __forceinline__ bf16_t f2bf(float f) { return (bf16_t)(pk2(f, f) & 0xffffu); }
__device__ __forceinline__ float bf2f(bf16_t h) { return __uint_as_float(((unsigned)h) << 16); }
__device__ __forceinline__ float bflo(unsigned w) { return __uint_as_float(w << 16); }
__device__ __forceinline__ float bfhi(unsigned w) { return __uint_as_float(w & 0xffff0000u); }
__device__ __forceinline__ float fexp(float x) { return __expf(x); }
__device__ __forceinline__ float sigmoidf_(float x) { return __builtin_amdgcn_rcpf(1.f + fexp(-x)); }
__device__ __forceinline__ float gelu_tanh(float x) { const float z = 0.7978845608f * (x + 0.044715f * x * x * x); const float e = fexp(2.f * z); const float th = 1.f - 2.f * __builtin_amdgcn_rcpf(e + 1.f); return 0.5f * x * (1.f + th); }
__device__ __forceinline__ int vperm(int k) { return (k & 32) | (((k & 15) >> 2) << 3) | (k & 3) | (((k >> 4) & 1) << 2); }
__device__ __forceinline__ int kswz(int key, int d) { return ((((key >> 4) * 2 + (d >> 5)) * 64) + ((d >> 3) & 3) * 16 + (key & 15)) * 8 + (d & 7); }
__device__ __forceinline__ int vswz(int d, int key) { const int k = key & 31; return ((((d >> 4) * 2 + (key >> 5)) * 64) + ((k & 15) >> 2) * 16 + (d & 15)) * 8 + (k & 3) + 4 * (k >> 4); }
__device__ __forceinline__ void wave_lds_fence() { asm volatile("s_waitcnt lgkmcnt(0)" ::: "memory"); }
__device__ __forceinline__ float wave_sum(float v) {
#pragma unroll
    for (int o = 1; o < 64; o <<= 1) v += __shfl_xor(v, o);
    return v;
}
__device__ __forceinline__ bf16x8 zero8() { return (bf16x8){0, 0, 0, 0, 0, 0, 0, 0}; }

__device__ __forceinline__ long pack8_fp8(float a0, float a1, float a2, float a3, float a4, float a5, float a6, float a7) {
    int lo = 0, hi = 0;
    lo = __builtin_amdgcn_cvt_pk_fp8_f32(a0, a1, lo, false); lo = __builtin_amdgcn_cvt_pk_fp8_f32(a2, a3, lo, true);
    hi = __builtin_amdgcn_cvt_pk_fp8_f32(a4, a5, hi, false); hi = __builtin_amdgcn_cvt_pk_fp8_f32(a6, a7, hi, true);
    return (long)(((unsigned long long)(unsigned)hi << 32) | (unsigned long long)(unsigned)lo);
}
__device__ __forceinline__ unsigned pack4_fp8(float a0, float a1, float a2, float a3) {
    int lo = 0; lo = __builtin_amdgcn_cvt_pk_fp8_f32(a0, a1, lo, false); lo = __builtin_amdgcn_cvt_pk_fp8_f32(a2, a3, lo, true); return (unsigned)lo;
}
__device__ __forceinline__ void rstd_table(const float* part, int pm, LAS float* tab, int tid) {
    const int row = tid >> 1, hf = tid & 1; float s = 0.f;
#pragma unroll
    for (int k = 0; k < 16; ++k) s += part[(size_t)(hf * 16 + k) * MTOK + pm * 256 + row];
    s += __shfl_xor(s, 1);
    if (hf == 0) tab[row] = rsqrtf(s * (1.f / DM) + EPS);
    __syncthreads();
}
__device__ __forceinline__ float row_rstd(const float* part, int r, int fq) {
    float s = 0.f;
#pragma unroll
    for (int k = 0; k < 8; ++k) s += part[(size_t)(fq * 8 + k) * MTOK + r];
    s += __shfl_xor(s, 16); s += __shfl_xor(s, 32);
    return rsqrtf(s * (1.f / DM) + EPS);
}
struct EpiInProj {
    unsigned char* wsb; const float* rowsq; const LAS float* tab; int tab_pm;
    __device__ __forceinline__ float rs(int r, int fq) const { return (r >> 8) == tab_pm ? tab[r & 255] : row_rstd(rowsq, r, fq); }
    __device__ __forceinline__ void operator()(const f32x4 (&acc)[2][2][4][2], const pg8::Unit& u, int wr, int wc, int fr, int fq) const {
        const int row0 = u.pm * 256 + wr * 64 + fr;
        const bool tr = (u.pn >= 10 && u.pn <= 13);
        if (!tr) {
            bf16_t* P = (bf16_t*)(wsb + WS_P);
#pragma unroll
            for (int ai = 0; ai < 2; ++ai)
#pragma unroll
                for (int m = 0; m < 4; ++m) {
                    const int r = row0 + ai * 128 + m * 16;
                    const float rstd = rs(r, fq);
                    bf16_t* rowp = P + (size_t)r * NINP + u.pn * 256 + wc * 32 + 4 * fq;
#pragma unroll
                    for (int bj = 0; bj < 2; ++bj)
#pragma unroll
                        for (int n = 0; n < 2; ++n) { const f32x4 v = acc[ai][bj][m][n] * rstd; u32x2 w; w.x = pk2(v[0], v[1]); w.y = pk2(v[2], v[3]); *(u32x2*)(rowp + bj * 128 + n * 16) = w; }
                }
        } else {
            const bool isv = (u.pn & 1); const bool sel8 = (u.pn < 12);
            bf16_t* BT = (bf16_t*)(wsb + ((u.pn == 10) ? WS_KST : (u.pn == 11) ? WS_VST : (u.pn == 12) ? WS_KWT : WS_VWT));
            const int b = u.pm >> 5, blk0 = (u.pm & 31) * 4 + wr;
            const int lk = (((fq >> 1) * 16 + fr) * 8) + 4 * (fq & 1);
            const int lv = (((fr >> 2) * 16 + 4 * fq) * 8) + (fr & 3);
#pragma unroll
            for (int ai = 0; ai < 2; ++ai)
#pragma unroll
                for (int m = 0; m < 4; ++m) {
                    const int r = row0 + ai * 128 + m * 16;
                    const float rstd = rs(r, fq);
#pragma unroll
                    for (int bj = 0; bj < 2; ++bj) {
                        bf16_t* blkp = BT + (size_t)((b * 4 + 2 * bj + (wc >> 1)) * 128 + blk0 + 2 * ai) * 4096;
#pragma unroll
                        for (int n = 0; n < 2; ++n) { const f32x4 v = acc[ai][bj][m][n] * rstd;
                            if (sel8) {
                                unsigned char* blk8 = (unsigned char*)BT + (size_t)((b * 4 + 2 * bj + (wc >> 1)) * 128 + blk0 + 2 * ai) * 4096;
                                if (!isv) *(unsigned*)(blk8 + ((m * 2 + (wc & 1)) * 64 + 2 * n * 16) * 8 + lk) = pack4_fp8(v[0], v[1], v[2], v[3]);
                                else { unsigned char* vp = blk8 + ((((wc & 1) * 2 + n) * 2 + (m >> 1)) * 64) * 8 + 4 * (m & 1) + lv; const unsigned w4 = pack4_fp8(v[0], v[1], v[2], v[3]);
#pragma unroll
                                    for (int i = 0; i < 4; ++i) vp[8 * i] = (unsigned char)(w4 >> (8 * i)); }
                            } else
                            if (!isv) { u32x2 w; w.x = pk2(v[0], v[1]); w.y = pk2(v[2], v[3]); *(u32x2*)(blkp + ((m * 2 + (wc & 1)) * 64 + 2 * n * 16) * 8 + lk) = w; }
                            else { bf16_t* vp = blkp + ((((wc & 1) * 2 + n) * 2 + (m >> 1)) * 64) * 8 + 4 * (m & 1) + lv;
#pragma unroll
                                for (int i = 0; i < 4; ++i) vp[8 * i] = f2bf(v[i]); } }
                    }
                }
        }
    }
};
struct EpiGlu {
    bf16_t* MIX; const float* bias;
    __device__ __forceinline__ void operator()(const f32x4 (&acc)[2][2][4][2], const pg8::Unit& u, int wr, int wc, int fr, int fq) const {
        const int row0 = u.pm * 256 + wr * 64 + fr;
#pragma unroll
        for (int bj = 0; bj < 2; ++bj) {
            const int j0 = u.pn * 128 + bj * 64 + wc * 16 + 4 * fq;
            const f32x4 ba = *(const f32x4*)(bias + j0), bb = *(const f32x4*)(bias + DSSM + j0);
#pragma unroll
            for (int ai = 0; ai < 2; ++ai)
#pragma unroll
                for (int m = 0; m < 4; ++m) {
                    const int r = row0 + ai * 128 + m * 16;
                    const f32x4 a = acc[ai][bj][m][0] + ba, b = acc[ai][bj][m][1] + bb;
                    float o[4];
#pragma unroll
                    for (int i = 0; i < 4; ++i) o[i] = a[i] * sigmoidf_(b[i]);
                    u32x2 w; w.x = pk2(o[0], o[1]); w.y = pk2(o[2], o[3]);
                    *(u32x2*)(MIX + (size_t)r * DM + j0) = w;
                }
        }
    }
};
struct EpiResid {
    bf16_t* XB; float* rowsq;
    __device__ __forceinline__ void operator()(const f32x4 (&acc)[2][2][4][2], const pg8::Unit& u, int wr, int wc, int fr, int fq) const {
        const int row0 = u.pm * 256 + wr * 64 + fr; const int col0 = u.pn * 256 + wc * 32 + 4 * fq;
#pragma unroll
        for (int ai = 0; ai < 2; ++ai)
#pragma unroll
            for (int m = 0; m < 4; ++m) {
                const int r = row0 + ai * 128 + m * 16; float ss = 0.f;
#pragma unroll
                for (int bj = 0; bj < 2; ++bj)
#pragma unroll
                    for (int n = 0; n < 2; ++n) {
                        const size_t off = (size_t)r * DM + col0 + bj * 128 + n * 16;
                        const u32x2 old = *(const u32x2*)(XB + off);
                        f32x4 x = (f32x4){bflo(old.x), bfhi(old.x), bflo(old.y), bfhi(old.y)} + acc[ai][bj][m][n];
                        u32x2 w; w.x = pk2(x[0], x[1]); w.y = pk2(x[2], x[3]); *(u32x2*)(XB + off) = w;
                        ss += (x[0] * x[0] + x[1] * x[1]) + (x[2] * x[2] + x[3] * x[3]);
                    }
                ss += __shfl_xor(ss, 16); ss += __shfl_xor(ss, 32);
                if (fq == 0) rowsq[(size_t)(u.pn * 4 + wc) * MTOK + r] = ss;
            }
    }
};
struct EpiSwiglu {
    bf16_t* HID; const float* rowsq; const LAS float* tab; int tab_pm;
    __device__ __forceinline__ float rs(int r, int fq) const { return (r >> 8) == tab_pm ? tab[r & 255] : row_rstd(rowsq, r, fq); }
    __device__ __forceinline__ void operator()(const f32x4 (&acc)[2][2][4][2], const pg8::Unit& u, int wr, int wc, int fr, int fq) const {
        const int row0 = u.pm * 256 + wr * 64 + fr;
#pragma unroll
        for (int ai = 0; ai < 2; ++ai)
#pragma unroll
            for (int m = 0; m < 4; ++m) {
                const int r = row0 + ai * 128 + m * 16;
                const float rstd = rs(r, fq);
                float o[2][4];
#pragma unroll
                for (int bj = 0; bj < 2; ++bj) {
                    const f32x4 gv = acc[ai][bj][m][0] * rstd, uv = acc[ai][bj][m][1] * rstd;
#pragma unroll
                    for (int i = 0; i < 4; ++i) o[bj][i] = gv[i] * sigmoidf_(gv[i]) * uv[i];
                }
                const int j0 = u.pn * 128 + wc * 32 + 8 * fq;
                u32x4 w; w.x = pk2(o[0][0], o[0][1]); w.y = pk2(o[0][2], o[0][3]); w.z = pk2(o[1][0], o[1][1]); w.w = pk2(o[1][2], o[1][3]);
                *(u32x4*)(HID + (size_t)r * DFF + j0) = w;
            }
    }
};

__device__ __forceinline__ void transpose_item(const float* W, int K, int N, bf16_t* WT, int mode, const float* gain, LAS float* scr, int item, int lane) {
    const int nblk = (N + 31) / 32, kb = item / nblk, nb = item % nblk, k0 = 64 * kb, n0 = 32 * nb;
    const int nn = n0 + (lane & 31);
    float cs = 1.f; if (mode == 4 && nn >= C_Q && nn < C_KC) cs = 0.125f;
#pragma unroll
    for (int i = 0; i < 32; ++i) { const int kk = 2 * i + (lane >> 5);
        float v = (nn < N) ? __builtin_nontemporal_load(&W[(size_t)(k0 + kk) * N + nn]) : 0.f;
        if (gain) v *= gain[k0 + kk];
        scr[kk * 33 + (lane & 31)] = v * cs; }
    wave_lds_fence();
    const int c = lane & 7;
#pragma unroll
    for (int j = 0; j < 4; ++j) { const int n = (lane >> 3) + 8 * j; const LAS float* s = scr + (8 * c) * 33 + n;
        u32x4 o; o.x = pk2(s[0 * 33], s[1 * 33]); o.y = pk2(s[2 * 33], s[3 * 33]); o.z = pk2(s[4 * 33], s[5 * 33]); o.w = pk2(s[6 * 33], s[7 * 33]);
        const int ng = n0 + n; int dest = ng;
        if (mode == 1) { const int hf = ng >= DSSM, jj = ng - DSSM * hf; dest = (jj >> 4) * 32 + 16 * hf + (jj & 15); }
        else if (mode == 2 || mode == 3) { const int jl = ng & 127; dest = (ng >> 7) * 256 + 128 * ((jl >> 2) & 1) + 32 * (jl >> 5) + 16 * (mode - 2) + 4 * ((jl >> 3) & 3) + (jl & 3); }
        *(u32x4*)(WT + (size_t)dest * K + k0 + 8 * c) = o; }
    wave_lds_fence();
}

struct Args {
    const float* in[26];
    float* out; unsigned char* ws;
};
typedef const Args __attribute__((address_space(4))) CArgs;
__device__ __forceinline__ CArgs* get_args() { CArgs* p = (CArgs*)__builtin_amdgcn_kernarg_segment_ptr(); asm volatile("" : "+s"(p)); return p; }

constexpr int IT_WIN = 32 * 114, IT_GLU = 16 * 64, IT_OUT = 32 * 64, IT_G = 32 * 176, IT_U = 32 * 176, IT_D = 88 * 64, IT_C1 = 32 * 4, IT_C2 = 2 * 2;
constexpr int IT_LAYER = IT_WIN + IT_GLU + IT_OUT + IT_G + IT_U + IT_D + 2 * IT_C1 + 2 * IT_C2;

__device__ __forceinline__ void prologue(LAS unsigned char* lds, int wave, int lane, int gw, int NGW) {
    CArgs* Ap = get_args();
    unsigned char* ws = Ap->ws;
    LAS float* scr = (LAS float*)(lds + wave * 16384);
    for (int it = gw; it < DEPTH * IT_LAYER; it += NGW) {
        const int l = it / IT_LAYER; int r = it % IT_LAYER;
        if (r < IT_WIN) { transpose_item(Ap->in[5] + (size_t)l * DM * NIN, DM, NIN, (bf16_t*)(ws + WS_WIN) + (size_t)l * NINP * DM, 4, Ap->in[2] + l * DM, scr, r, lane); continue; } r -= IT_WIN;
        if (r < IT_GLU) { transpose_item(Ap->in[14] + (size_t)l * DSSM * 2 * DSSM, DSSM, 2 * DSSM, (bf16_t*)(ws + WS_WGLU) + (size_t)l * 2 * DSSM * DSSM, 1, nullptr, scr, r, lane); continue; } r -= IT_GLU;
        if (r < IT_OUT) { transpose_item(Ap->in[22] + (size_t)l * DM * DM, DM, DM, (bf16_t*)(ws + WS_WOUT) + (size_t)l * DM * DM, 0, nullptr, scr, r, lane); continue; } r -= IT_OUT;
        if (r < IT_G) { transpose_item(Ap->in[23] + (size_t)l * DM * DFF, DM, DFF, (bf16_t*)(ws + WS_WGU) + (size_t)l * 2 * DFF * DM, 2, Ap->in[3] + l * DM, scr, r, lane); continue; } r -= IT_G;
        if (r < IT_U) { transpose_item(Ap->in[24] + (size_t)l * DM * DFF, DM, DFF, (bf16_t*)(ws + WS_WGU) + (size_t)l * 2 * DFF * DM, 3, Ap->in[3] + l * DM, scr, r, lane); continue; } r -= IT_U;
        if (r < IT_D) { transpose_item(Ap->in[25] + (size_t)l * DFF * DM, DFF, DM, (bf16_t*)(ws + WS_WDN) + (size_t)l * DM * DFF, 0, nullptr, scr, r, lane); continue; } r -= IT_D;
        if (r < IT_C1) { transpose_item(Ap->in[17] + (size_t)l * 2048 * 128, 2048, 128, (bf16_t*)(ws + WS_CW1) + (size_t)(l * 2 + 0) * 128 * 2048, 0, nullptr, scr, r, lane); continue; } r -= IT_C1;
        if (r < IT_C1) { transpose_item(Ap->in[20] + (size_t)l * 2048 * 128, 2048, 128, (bf16_t*)(ws + WS_CW1) + (size_t)(l * 2 + 1) * 128 * 2048, 0, nullptr, scr, r, lane); continue; } r -= IT_C1;
        if (r < IT_C2) { transpose_item(Ap->in[18] + (size_t)l * 128 * 64, 128, 64, (bf16_t*)(ws + WS_CW2) + (size_t)(l * 2 + 0) * 64 * 128, 0, nullptr, scr, r, lane); continue; } r -= IT_C2;
        transpose_item(Ap->in[21] + (size_t)l * 128 * 64, 128, 64, (bf16_t*)(ws + WS_CW2) + (size_t)(l * 2 + 1) * 64 * 128, 0, nullptr, scr, r, lane);
    }
    const float* x = Ap->in[0]; bf16_t* XB = (bf16_t*)(ws + WS_XB); float* rowsq = (float*)(ws + WS_RSQ);
    for (int m = gw; m < MTOK; m += NGW) {
        const f32x4* xr = (const f32x4*)(x + (size_t)m * DM) + lane; u32x2* xb = (u32x2*)(XB + (size_t)m * DM) + lane;
        float s = 0.f;
#pragma unroll
        for (int j = 0; j < 8; ++j) { const f32x4 v = __builtin_nontemporal_load(&xr[64 * j]); u32x2 w; w.x = pk2(v[0], v[1]); w.y = pk2(v[2], v[3]); xb[64 * j] = w; s += (v[0] * v[0] + v[1] * v[1]) + (v[2] * v[2] + v[3] * v[3]); }
        s = wave_sum(s);
        if (lane < 32) rowsq[(size_t)lane * MTOK + m] = (lane == 0) ? s : 0.f;
    }
}

__device__ __forceinline__ void sincos_small(float ang, float& sn, float& cs) {
    const float k = rintf(ang * 0.636619772f);
    float r = fmaf(-k, 1.5707963705f, ang); r = fmaf(-k, -4.37113883e-8f, r);
    const float r2 = r * r;
    const float s = r * (1.f + r2 * (-1.f / 6.f + r2 * (1.f / 120.f + r2 * (-1.f / 5040.f + r2 * (1.f / 362880.f)))));
    const float c = 1.f + r2 * (-0.5f + r2 * (1.f / 24.f + r2 * (-1.f / 720.f + r2 * (1.f / 40320.f))));
    const int q = ((int)k) & 3;
    sn = (q == 0) ? s : (q == 1) ? c : (q == 2) ? -s : -c;
    cs = (q == 0) ? c : (q == 1) ? -s : (q == 2) ? -c : s;
}

template <int PASS>
__device__ __forceinline__ void s5_task(CArgs* Ap, int l, int b, int g, int c, LAS unsigned char* wl, int lane) {
    if (PASS == 1 && c == NCHUNK - 1) return;
    unsigned char* ws = Ap->ws;
    const bf16_t* P = (const bf16_t*)(ws + p_off(l));
    f32x2* SST = (f32x2*)(ws + WS_SST + (size_t)l * MiB);
    LAS float* us = (LAS float*)wl;
    LAS bf16_t* Xs = (LAS bf16_t*)(wl + 1024);
    const int p = lane;
    const float a_re = fminf(Ap->in[6][(l * NGRP + g) * NST + p], -1e-4f), a_im = Ap->in[7][(l * NGRP + g) * NST + p];
    const float dt = expf(Ap->in[8][l * NGRP + g]);
    const float mag = expf(a_re * dt); float sn, cs; sincos_small(a_im * dt, sn, cs);
    const float ab_re = mag * cs, ab_im = mag * sn;
    const float nr = ab_re - 1.f, ni = ab_im, den = a_re * a_re + a_im * a_im;
    const float f_re = (nr * a_re + ni * a_im) / den, f_im = (ni * a_re - nr * a_im) / den;
    float bbr[16], bbi[16]; f32x2 bb2[16];
    {
        const f32x4* br = (const f32x4*)(Ap->in[9] + ((size_t)(l * NGRP + g) * NST + p) * 16); const f32x4* bi = (const f32x4*)(Ap->in[10] + ((size_t)(l * NGRP + g) * NST + p) * 16);
#pragma unroll
        for (int q = 0; q < 4; ++q) { const f32x4 vr = br[q], vi = bi[q];
#pragma unroll
            for (int i = 0; i < 4; ++i) { bbr[4 * q + i] = f_re * vr[i] - f_im * vi[i]; bbi[4 * q + i] = f_re * vi[i] + f_im * vr[i]; bb2[4 * q + i] = (f32x2){bbr[4 * q + i], bbi[4 * q + i]}; } }
    }
    float xr = 0.f, xi = 0.f;
    const int n16 = lane & 15, g4 = lane >> 4;
    bf16x8 cB[4]; float dval = 0.f;
    if (PASS == 2) {
        float pr = ab_re, pi = ab_im;
#pragma unroll
        for (int i = 0; i < 9; ++i) { const float t_ = pr * pr - pi * pi; pi = 2.f * pr * pi; pr = t_; }
        const f32x2* S = SST + (size_t)((b * NGRP + g) * NCHUNK) * NST + p;
        for (int cc = 0; cc < c; ++cc) { const f32x2 s = S[(size_t)cc * NST]; const float t_ = pr * xr - pi * xi + s.x; xi = pr * xi + pi * xr + s.y; xr = t_; }
        const float* cre = Ap->in[11] + ((size_t)(l * NGRP + g) * 16 + n16) * NST; const float* cim = Ap->in[12] + ((size_t)(l * NGRP + g) * 16 + n16) * NST;
#pragma unroll
        for (int kk = 0; kk < 4; ++kk) { const f32x4 r4 = *(const f32x4*)(cre + 16 * kk + 4 * g4), i4 = *(const f32x4*)(cim + 16 * kk + 4 * g4);
            u32x4 w; w.x = pk2(r4[0], -i4[0]); w.y = pk2(r4[1], -i4[1]); w.z = pk2(r4[2], -i4[2]); w.w = pk2(r4[3], -i4[3]);
            cB[kk] = __builtin_bit_cast(bf16x8, w); }
        dval = Ap->in[13][l * DSSM + g * 16 + n16];
    }
    const size_t row0 = (size_t)b * SEQ + (size_t)c * CHUNK;
    const bf16_t* up = P + (row0 + (lane >> 2)) * NINP + g * 16 + 4 * (lane & 3);
    u32x2 unext = *(const u32x2*)up;
    bf16_t* Y1 = (bf16_t*)(ws + WS_Y1);
    for (int tb = 0; tb < CHUNK; tb += 16) {
        const u32x2 ucur = unext;
        if (tb + 16 < CHUNK) unext = *(const u32x2*)(up + (size_t)(tb + 16) * NINP);
        *(LAS f32x4*)(us + (lane >> 2) * 16 + 4 * (lane & 3)) = (f32x4){bflo(ucur.x), bfhi(ucur.x), bflo(ucur.y), bfhi(ucur.y)};
        wave_lds_fence();
#pragma unroll 4
        for (int s = 0; s < 16; ++s) {
            const f32x4 u0 = *(const LAS f32x4*)(us + s * 16), u1 = *(const LAS f32x4*)(us + s * 16 + 4), u2 = *(const LAS f32x4*)(us + s * 16 + 8), u3 = *(const LAS f32x4*)(us + s * 16 + 12);
            f32x2 bu = (f32x2){0.f, 0.f};
#pragma unroll
            for (int i = 0; i < 4; ++i) bu = bb2[i] * (f32x2){u0[i], u0[i]} + bu;
#pragma unroll
            for (int i = 0; i < 4; ++i) bu = bb2[4 + i] * (f32x2){u1[i], u1[i]} + bu;
#pragma unroll
            for (int i = 0; i < 4; ++i) bu = bb2[8 + i] * (f32x2){u2[i], u2[i]} + bu;
#pragma unroll
            for (int i = 0; i < 4; ++i) bu = bb2[12 + i] * (f32x2){u3[i], u3[i]} + bu;
            const float br_ = bu.x, bi_ = bu.y;
            const float nxr = fmaf(ab_re, xr, fmaf(-ab_im, xi, br_)); const float nxi = fmaf(ab_re, xi, fmaf(ab_im, xr, bi_));
            xr = nxr; xi = nxi;
            if (PASS == 2) *(LAS unsigned*)(Xs + s * 136 + 2 * p) = pk2(xr, xi);
        }
        if (PASS == 2) {
            wave_lds_fence();
            f32x4 y = (f32x4){0.f, 0.f, 0.f, 0.f};
#pragma unroll
            for (int kk = 0; kk < 4; ++kk) { const bf16x8 xa = *(const LAS bf16x8*)(Xs + n16 * 136 + 32 * kk + 8 * g4); y = __builtin_amdgcn_mfma_f32_16x16x32_bf16(xa, cB[kk], y, 0, 0, 0); }
#pragma unroll
            for (int i = 0; i < 4; ++i) { const int tl = 4 * g4 + i; const float uv = us[tl * 16 + n16]; const float v = gelu_tanh(y[i] + dval * uv);
                Y1[(row0 + tb + tl) * DSSM + g * 16 + n16] = f2bf(v); }
        }
        wave_lds_fence();
    }
    if (PASS == 1) SST[(size_t)((b * NGRP + g) * NCHUNK + c) * NST + p] = (f32x2){xr, xi};
}

__device__ __forceinline__ void compress_task(CArgs* Ap, int l, int task, int lane) {
    unsigned char* ws = Ap->ws;
    const int kv = task & 1, nb = (task >> 1) & 31, g = (task >> 6) & 3, b = task >> 8;
    const int n16 = lane & 15, g4 = lane >> 4;
    const bf16_t* P = (const bf16_t*)(ws + p_off(l));
    const bf16_t* W1t = (const bf16_t*)(ws + WS_CW1) + (size_t)(l * 2 + kv) * 128 * 2048;
    const bf16_t* W2t = (const bf16_t*)(ws + WS_CW2) + (size_t)(l * 2 + kv) * 64 * 128;
    const float* pos = Ap->in[kv ? 19 : 16] + (size_t)l * 32 * 64;
    const int n = nb * 16 + n16;
    const int colb = (kv ? C_VC : C_KC) + g * 64;
    f32x4 acc[8];
#pragma unroll
    for (int h = 0; h < 8; ++h) acc[h] = (f32x4){0.f, 0.f, 0.f, 0.f};
#pragma unroll 2
    for (int ks = 0; ks < 64; ++ks) {
        const int itok = ks >> 1, d0 = 32 * (ks & 1) + 8 * g4;
        int tok = 16 * n + itok; tok = tok > SEQ - 1 ? SEQ - 1 : tok;
        const u32x4 raw = *(const u32x4*)(P + ((size_t)b * SEQ + tok) * NINP + colb + d0);
        const f32x4 p0 = *(const f32x4*)(pos + itok * 64 + d0), p1 = *(const f32x4*)(pos + itok * 64 + d0 + 4);
        u32x4 w;
        w.x = pk2(bflo(raw.x) + p0[0], bfhi(raw.x) + p0[1]); w.y = pk2(bflo(raw.y) + p0[2], bfhi(raw.y) + p0[3]);
        w.z = pk2(bflo(raw.z) + p1[0], bfhi(raw.z) + p1[1]); w.w = pk2(bflo(raw.w) + p1[2], bfhi(raw.w) + p1[3]);
        const bf16x8 fb = __builtin_bit_cast(bf16x8, w);
#pragma unroll
        for (int h = 0; h < 8; ++h) { const bf16x8 wa = *(const bf16x8*)(W1t + (size_t)(16 * h + n16) * 2048 + 32 * ks + 8 * g4); acc[h] = __builtin_amdgcn_mfma_f32_16x16x32_bf16(wa, fb, acc[h], 0, 0, 0); }
    }
    bf16x8 hB[4];
#pragma unroll
    for (int pp = 0; pp < 4; ++pp) { float v[8];
#pragma unroll
        for (int i = 0; i < 4; ++i) { v[i] = gelu_tanh(acc[2 * pp][i]); v[4 + i] = gelu_tanh(acc[2 * pp + 1][i]); }
        u32x4 w; w.x = pk2(v[0], v[1]); w.y = pk2(v[2], v[3]); w.z = pk2(v[4], v[5]); w.w = pk2(v[6], v[7]); hB[pp] = __builtin_bit_cast(bf16x8, w); }
    bf16_t* KC = (bf16_t*)(ws + WS_KC + (size_t)l * MiB); bf16_t* VCT = (bf16_t*)(ws + WS_VCT + (size_t)l * MiB);
#pragma unroll
    for (int dt = 0; dt < 4; ++dt) {
        f32x4 o = (f32x4){0.f, 0.f, 0.f, 0.f};
#pragma unroll
        for (int pp = 0; pp < 4; ++pp) { const bf16_t* wrow = W2t + (size_t)(16 * dt + n16) * 128 + 32 * pp + 4 * g4;
            const u32x2 lo = *(const u32x2*)wrow, hi = *(const u32x2*)(wrow + 16);
            u32x4 w; w.x = lo.x; w.y = lo.y; w.z = hi.x; w.w = hi.y;
            o = __builtin_amdgcn_mfma_f32_16x16x32_bf16(__builtin_bit_cast(bf16x8, w), hB[pp], o, 0, 0, 0); }
        if (kv == 0) { u32x2 w; w.x = pk2(o[0], o[1]); w.y = pk2(o[2], o[3]); *(u32x2*)(KC + (size_t)((b * 4 + g) * 8 + (n >> 6)) * 4096 + kswz(n & 63, 16 * dt + 4 * g4)) = w; }
        else {
#pragma unroll
            for (int i = 0; i < 4; ++i) VCT[(size_t)((b * 4 + g) * 8 + (n >> 6)) * 4096 + vswz(16 * dt + 4 * g4 + i, n & 63)] = f2bf(o[i]); }
    }
}

__device__ __forceinline__ void compress_simple(CArgs* Ap, int l, int task, LAS float* hs, int lane) {
    unsigned char* ws = Ap->ws;
    const int kv = task & 1, n0 = ((task >> 1) & 127) * 4, g = (task >> 8) & 3, b = task >> 10;
    const bf16_t* P = (const bf16_t*)(ws + p_off(l));
    const float* w1 = Ap->in[kv ? 20 : 17] + (size_t)l * 2048 * 128; const float* w2 = Ap->in[kv ? 21 : 18] + (size_t)l * 128 * 64;
    const float* pos = Ap->in[kv ? 19 : 16] + (size_t)l * 32 * 64;
    const int colb = (kv ? C_VC : C_KC) + g * 64;
    float h0[4] = {0.f, 0.f, 0.f, 0.f}, h1[4] = {0.f, 0.f, 0.f, 0.f};
    for (int i = 0; i < 32; ++i) {
        const bf16_t* pr[4];
#pragma unroll
        for (int r = 0; r < 4; ++r) { int tok = 16 * (n0 + r) + i; tok = tok > SEQ - 1 ? SEQ - 1 : tok; pr[r] = P + ((size_t)b * SEQ + tok) * NINP + colb; }
        for (int d8 = 0; d8 < 8; ++d8) {
            const f32x4 p0 = *(const f32x4*)(pos + i * 64 + d8 * 8), p1 = *(const f32x4*)(pos + i * 64 + d8 * 8 + 4);
            const float pv[8] = {p0[0], p0[1], p0[2], p0[3], p1[0], p1[1], p1[2], p1[3]};
            float f[4][8];
#pragma unroll
            for (int r = 0; r < 4; ++r) { const u32x4 raw = *(const u32x4*)(pr[r] + d8 * 8);
                f[r][0] = bflo(raw.x) + pv[0]; f[r][1] = bfhi(raw.x) + pv[1]; f[r][2] = bflo(raw.y) + pv[2]; f[r][3] = bfhi(raw.y) + pv[3];
                f[r][4] = bflo(raw.z) + pv[4]; f[r][5] = bfhi(raw.z) + pv[5]; f[r][6] = bflo(raw.w) + pv[6]; f[r][7] = bfhi(raw.w) + pv[7]; }
            const float* wr = w1 + (size_t)(i * 64 + d8 * 8) * 128 + lane;
#pragma unroll
            for (int e = 0; e < 8; ++e) { const float wa = wr[e * 128], wb = wr[e * 128 + 64];
#pragma unroll
                for (int r = 0; r < 4; ++r) { h0[r] = fmaf(f[r][e], wa, h0[r]); h1[r] = fmaf(f[r][e], wb, h1[r]); } }
        }
    }
#pragma unroll
    for (int r = 0; r < 4; ++r) { hs[r * 128 + lane] = gelu_tanh(h0[r]); hs[r * 128 + lane + 64] = gelu_tanh(h1[r]); }
    wave_lds_fence();
    float o[4] = {0.f, 0.f, 0.f, 0.f};
    for (int k = 0; k < 128; ++k) { const float w = w2[k * 64 + lane];
#pragma unroll
        for (int r = 0; r < 4; ++r) o[r] = fmaf(hs[r * 128 + k], w, o[r]); }
    wave_lds_fence();
    bf16_t* KC = (bf16_t*)(ws + WS_KC + (size_t)l * MiB); bf16_t* VCT = (bf16_t*)(ws + WS_VCT + (size_t)l * MiB);
#pragma unroll
    for (int r = 0; r < 4; ++r) { const int n = n0 + r;
        if (kv == 0) KC[(size_t)((b * 4 + g) * 8 + (n >> 6)) * 4096 + kswz(n & 63, lane)] = f2bf(o[r]);
        else VCT[(size_t)((b * 4 + g) * 8 + (n >> 6)) * 4096 + vswz(lane, n & 63)] = f2bf(o[r]); }
}

__device__ __forceinline__ int rel_bucket_i(int n) {
    if (n < 16) return n;
    int c = 0;
    c += n >= 16; c += n >= 21; c += n >= 27; c += n >= 35; c += n >= 46; c += n >= 59; c += n >= 77; c += n >= 99;
    c += n >= 128; c += n >= 166; c += n >= 216; c += n >= 280; c += n >= 363; c += n >= 470; c += n >= 609; c += n >= 790;
    return 15 + c;
}

struct SmState { float m, l; };

template <int MODE>
__device__ __forceinline__ void softmax_block(f32x4 (&acc)[4], int base, bool ok, int t, int g4, const LAS float* lutg, SmState& st, f32x4 (&O)[4], bf16x8 (&pB)[2]) {
    float mx = -1e30f; unsigned vm = 0u;
#pragma unroll
    for (int nt = 0; nt < 4; ++nt)
#pragma unroll
        for (int i = 0; i < 4; ++i) {
            const int key = base + 16 * nt + 4 * g4 + i;
            const int dist = (MODE == 0) ? t - (16 * key + 31) : t - key;
            bool valid = dist >= 0;
            if (MODE == 1) valid = valid && ok;
            if (MODE == 2) valid = valid && dist < 512;
            int dc = dist < 0 ? 0 : dist; dc = dc > 1023 ? 1023 : dc;
            const float lg = acc[nt][i] + lutg[dc * 4];
            acc[nt][i] = lg;
            if (valid) { mx = fmaxf(mx, lg); vm |= 1u << (nt * 4 + i); }
        }
    mx = fmaxf(mx, __shfl_xor(mx, 16)); mx = fmaxf(mx, __shfl_xor(mx, 32));
    const float mn = fmaxf(st.m, mx);
    const float sc = fexp(st.m - mn);
    float ls = 0.f;
#pragma unroll
    for (int nt = 0; nt < 4; ++nt)
#pragma unroll
        for (int i = 0; i < 4; ++i) { const float p = ((vm >> (nt * 4 + i)) & 1u) ? fexp(acc[nt][i] - mn) : 0.f; acc[nt][i] = p; ls += p; }
    st.l = st.l * sc + ls; st.m = mn;
#pragma unroll
    for (int dt = 0; dt < 4; ++dt) O[dt] = O[dt] * sc;
#pragma unroll
    for (int hh = 0; hh < 2; ++hh) { u32x4 w; w.x = pk2(acc[2 * hh][0], acc[2 * hh][1]); w.y = pk2(acc[2 * hh][2], acc[2 * hh][3]); w.z = pk2(acc[2 * hh + 1][0], acc[2 * hh + 1][1]); w.w = pk2(acc[2 * hh + 1][2], acc[2 * hh + 1][3]);
        pB[hh] = __builtin_bit_cast(bf16x8, w); }
}

__device__ __forceinline__ void load_k(bf16x8 (&kf)[4][2], const bf16_t* Kb, int lane) {
#pragma unroll
    for (int nt = 0; nt < 4; ++nt)
#pragma unroll
        for (int kk = 0; kk < 2; ++kk) kf[nt][kk] = *(const bf16x8*)(Kb + ((nt * 2 + kk) * 64 + lane) * 8);
}
__device__ __forceinline__ void load_v(bf16x8 (&vf)[4][2], const bf16_t* Vb, int lane) {
#pragma unroll
    for (int dt = 0; dt < 4; ++dt)
#pragma unroll
        for (int hh = 0; hh < 2; ++hh) vf[dt][hh] = *(const bf16x8*)(Vb + ((dt * 2 + hh) * 64 + lane) * 8);
}
__device__ __forceinline__ void qk_acc(f32x4 (&acc)[4], const bf16x8 (&kf)[4][2], const bf16x8 (&q)[2]) {
#pragma unroll
    for (int nt = 0; nt < 4; ++nt) { acc[nt] = __builtin_amdgcn_mfma_f32_16x16x32_bf16(kf[nt][0], q[0], acc[nt], 0, 0, 0); acc[nt] = __builtin_amdgcn_mfma_f32_16x16x32_bf16(kf[nt][1], q[1], acc[nt], 0, 0, 0); }
}
__device__ __forceinline__ void pv_acc(f32x4 (&O)[4], const bf16x8 (&vf)[4][2], const bf16x8 (&pB)[2]) {
#pragma unroll
    for (int dt = 0; dt < 4; ++dt) { O[dt] = __builtin_amdgcn_mfma_f32_16x16x32_bf16(vf[dt][0], pB[0], O[dt], 0, 0, 0); O[dt] = __builtin_amdgcn_mfma_f32_16x16x32_bf16(vf[dt][1], pB[1], O[dt], 0, 0, 0); }
}


__device__ __forceinline__ void load_kh(bf16x8 (&kf)[2][2], const bf16_t* Kb, int hh, int lane) {
#pragma unroll
    for (int nt = 0; nt < 2; ++nt)
#pragma unroll
        for (int kk = 0; kk < 2; ++kk) kf[nt][kk] = *(const bf16x8*)(Kb + (((2 * hh + nt) * 2 + kk) * 64 + lane) * 8);
}
__device__ __forceinline__ void load_vh(bf16x8 (&vf)[4], const bf16_t* Vb, int hh, int lane) {
#pragma unroll
    for (int dt = 0; dt < 4; ++dt) vf[dt] = *(const bf16x8*)(Vb + ((dt * 2 + hh) * 64 + lane) * 8);
}
__device__ __forceinline__ void qk_acch(f32x4 (&acc)[2], const bf16x8 (&kf)[2][2], const bf16x8 (&q)[2]) {
#pragma unroll
    for (int nt = 0; nt < 2; ++nt) { acc[nt] = __builtin_amdgcn_mfma_f32_16x16x32_bf16(kf[nt][0], q[0], acc[nt], 0, 0, 0); acc[nt] = __builtin_amdgcn_mfma_f32_16x16x32_bf16(kf[nt][1], q[1], acc[nt], 0, 0, 0); }
}
__device__ __forceinline__ void pv_acch(f32x4 (&O)[4], const bf16x8 (&vf)[4], const bf16x8 pB) {
#pragma unroll
    for (int dt = 0; dt < 4; ++dt) O[dt] = __builtin_amdgcn_mfma_f32_16x16x32_bf16(vf[dt], pB, O[dt], 0, 0, 0);
}
__device__ __forceinline__ void softmax_half_far(f32x4 (&acc)[2], const LAS float* lutg, SmState& st, f32x4 (&O)[4]) {
    const float bias = lutg[1023 * 4];
    float mx = -1e30f;
#pragma unroll
    for (int nt = 0; nt < 2; ++nt)
#pragma unroll
        for (int i = 0; i < 4; ++i) { const float lg = acc[nt][i] + bias; acc[nt][i] = lg; mx = fmaxf(mx, lg); }
    mx = fmaxf(mx, __shfl_xor(mx, 16)); mx = fmaxf(mx, __shfl_xor(mx, 32));
    const float mn = fmaxf(st.m, mx);
    const float sc = fexp(st.m - mn);
    float ls = 0.f;
#pragma unroll
    for (int nt = 0; nt < 2; ++nt)
#pragma unroll
        for (int i = 0; i < 4; ++i) { const float p = fexp(acc[nt][i] - mn); acc[nt][i] = p; ls += p; }
    st.l = st.l * sc + ls; st.m = mn;
#pragma unroll
    for (int dt = 0; dt < 4; ++dt) O[dt] = O[dt] * sc;
}
template <int MODE>
__device__ __forceinline__ void softmax_half(f32x4 (&acc)[2], int base, bool ok, int t, int g4, const LAS float* lutg, SmState& st, f32x4 (&O)[4], bf16x8& pB) {
    float mx = -1e30f; unsigned vm = 0u;
#pragma unroll
    for (int nt = 0; nt < 2; ++nt)
#pragma unroll
        for (int i = 0; i < 4; ++i) {
            const int key = base + 16 * nt + 4 * g4 + i;
            const int dist = t - key;
            bool valid = dist >= 0;
            if (MODE == 1) valid = valid && ok;
            if (MODE == 2) valid = valid && dist < 512;
            int dc = dist < 0 ? 0 : dist; dc = dc > 1023 ? 1023 : dc;
            const float lg = acc[nt][i] + lutg[dc * 4];
            acc[nt][i] = lg;
            if (valid) { mx = fmaxf(mx, lg); vm |= 1u << (nt * 4 + i); }
        }
    mx = fmaxf(mx, __shfl_xor(mx, 16)); mx = fmaxf(mx, __shfl_xor(mx, 32));
    const float mn = fmaxf(st.m, mx);
    const float sc = fexp(st.m - mn);
    float ls = 0.f;
#pragma unroll
    for (int nt = 0; nt < 2; ++nt)
#pragma unroll
        for (int i = 0; i < 4; ++i) { const float p = ((vm >> (nt * 4 + i)) & 1u) ? fexp(acc[nt][i] - mn) : 0.f; acc[nt][i] = p; ls += p; }
    st.l = st.l * sc + ls; st.m = mn;
#pragma unroll
    for (int dt = 0; dt < 4; ++dt) O[dt] = O[dt] * sc;
    u32x4 w; w.x = pk2(acc[0][0], acc[0][1]); w.y = pk2(acc[0][2], acc[0][3]); w.z = pk2(acc[1][0], acc[1][1]); w.w = pk2(acc[1][2], acc[1][3]);
    pB = __builtin_bit_cast(bf16x8, w);
}


__device__ __forceinline__ void load_kh8(long (&kf)[2][2], const unsigned char* Kb, int hh, int lane) {
#pragma unroll
    for (int nt = 0; nt < 2; ++nt)
#pragma unroll
        for (int kk = 0; kk < 2; ++kk) kf[nt][kk] = *(const long*)(Kb + (((2 * hh + nt) * 2 + kk) * 64 + lane) * 8);
}
__device__ __forceinline__ void load_vh8(long (&vf)[4], const unsigned char* Vb, int hh, int lane) {
#pragma unroll
    for (int dt = 0; dt < 4; ++dt) vf[dt] = *(const long*)(Vb + ((dt * 2 + hh) * 64 + lane) * 8);
}
__device__ __forceinline__ void qk_acch8(f32x4 (&acc)[2], const long (&kf)[2][2], const long (&q)[2]) {
#pragma unroll
    for (int nt = 0; nt < 2; ++nt) { acc[nt] = __builtin_amdgcn_mfma_f32_16x16x32_fp8_fp8(kf[nt][0], q[0], acc[nt], 0, 0, 0); acc[nt] = __builtin_amdgcn_mfma_f32_16x16x32_fp8_fp8(kf[nt][1], q[1], acc[nt], 0, 0, 0); }
}
__device__ __forceinline__ void pv_acch8(f32x4 (&O)[4], const long (&vf)[4], const long p8) {
#pragma unroll
    for (int dt = 0; dt < 4; ++dt) O[dt] = __builtin_amdgcn_mfma_f32_16x16x32_fp8_fp8(vf[dt], p8, O[dt], 0, 0, 0);
}
constexpr float P8_SCALE = 256.f;
__device__ __forceinline__ long p_to_fp8(const f32x4 (&acc)[2]) {
    return pack8_fp8(acc[0][0] * P8_SCALE, acc[0][1] * P8_SCALE, acc[0][2] * P8_SCALE, acc[0][3] * P8_SCALE, acc[1][0] * P8_SCALE, acc[1][1] * P8_SCALE, acc[1][2] * P8_SCALE, acc[1][3] * P8_SCALE);
}

__device__ __forceinline__ void nsa_wave(CArgs* Ap, int l, int b, int g, int tq0, const LAS float* lut, LAS float* imp, int lane) {
    unsigned char* ws = Ap->ws;
    const bf16_t* P = (const bf16_t*)(ws + p_off(l));
    const bf16_t* KC = (const bf16_t*)(ws + WS_KC + (size_t)l * MiB) + (size_t)(b * 4 + g) * 8 * 4096;
    const bf16_t* VCT = (const bf16_t*)(ws + WS_VCT + (size_t)l * MiB) + (size_t)(b * 4 + g) * 8 * 4096;
    const bf16_t* VST = (const bf16_t*)(ws + vt_off(l)) + (size_t)(b * 4 + g) * 128 * 4096;
    const bf16_t* VWT = (const bf16_t*)(ws + vt_off(l) + 8 * MiB) + (size_t)(b * 4 + g) * 128 * 4096;
    bf16_t* MIX = (bf16_t*)(ws + WS_MIX);
    const int n16 = lane & 15, g4 = lane >> 4, qi = n16 >> 2, r = n16 & 3;
    const int t = tq0 + qi;
    const bf16_t* prow = P + ((size_t)b * SEQ + t) * NINP;
    bf16x8 qB[2];
    qB[0] = *(const bf16x8*)(prow + C_Q + (4 * g + r) * 64 + 8 * g4); qB[1] = *(const bf16x8*)(prow + C_Q + (4 * g + r) * 64 + 8 * g4 + 32);
    float gt[3];
#pragma unroll
    for (int br = 0; br < 3; ++br) gt[br] = sigmoidf_(bf2f(prow[C_GATE + (4 * g + r) * 3 + br]));
    const LAS float* lutg = lut + g * 4096 + r;
    f32x4 outacc[4];
#pragma unroll
    for (int dt = 0; dt < 4; ++dt) outacc[dt] = (f32x4){0.f, 0.f, 0.f, 0.f};
#pragma unroll
    for (int i = 0; i < 8; ++i) *(LAS f32x4*)(imp + (i * 64 + lane) * 4) = (f32x4){0.f, 0.f, 0.f, 0.f};

    const int tmax = tq0 + 3;
    const int ncb = (tmax >= 31) ? ((((tmax - 31) >> 4) >> 6) + 1) : 0;
    {
        SmState st{-1e30f, 0.f};
        f32x4 Od[4];
#pragma unroll
        for (int dt = 0; dt < 4; ++dt) Od[dt] = (f32x4){0.f, 0.f, 0.f, 0.f};
        bf16x8 pB[2];
        for (int cb = 0; cb < ncb; ++cb) {
            bf16x8 kf[4][2]; load_k(kf, KC + (size_t)cb * 4096, lane);
            f32x4 acc[4];
#pragma unroll
            for (int nt = 0; nt < 4; ++nt) acc[nt] = (f32x4){0.f, 0.f, 0.f, 0.f};
            qk_acc(acc, kf, qB);
            softmax_block<0>(acc, cb * 64, true, t, g4, lutg, st, Od, pB);
        }
        float lt = st.l; lt += __shfl_xor(lt, 16); lt += __shfl_xor(lt, 32);
        const float inv = 1.f / fmaxf(lt, 1e-30f), mfin = st.m;
        for (int cb = 0; cb < ncb; ++cb) {
            bf16x8 kf[4][2]; load_k(kf, KC + (size_t)cb * 4096, lane);
            bf16x8 vf[4][2]; load_v(vf, VCT + (size_t)cb * 4096, lane);
            f32x4 acc[4];
#pragma unroll
            for (int nt = 0; nt < 4; ++nt) acc[nt] = (f32x4){0.f, 0.f, 0.f, 0.f};
            qk_acc(acc, kf, qB);
#pragma unroll
            for (int nt = 0; nt < 4; ++nt) {
                f32x4 pi4;
#pragma unroll
                for (int i = 0; i < 4; ++i) {
                    const int key = cb * 64 + 16 * nt + 4 * g4 + i; const int dist = t - (16 * key + 31);
                    int dc = dist < 0 ? 0 : dist; dc = dc > 1023 ? 1023 : dc;
                    const float lg = acc[nt][i] + lutg[dc * 4];
                    float p = (dist >= 0) ? fexp(lg - mfin) * inv : 0.f;
                    acc[nt][i] = p;
                    p += __shfl_xor(p, 1); p += __shfl_xor(p, 2);
                    pi4[i] = p;
                }
                if (r == 0) *(LAS f32x4*)(imp + qi * 512 + cb * 64 + 16 * nt + 4 * g4) = pi4;
            }
#pragma unroll
            for (int hh = 0; hh < 2; ++hh) { u32x4 w; w.x = pk2(acc[2 * hh][0], acc[2 * hh][1]); w.y = pk2(acc[2 * hh][2], acc[2 * hh][3]); w.z = pk2(acc[2 * hh + 1][0], acc[2 * hh + 1][1]); w.w = pk2(acc[2 * hh + 1][2], acc[2 * hh + 1][3]);
                pB[hh] = __builtin_bit_cast(bf16x8, w); }
            pv_acc(outacc, vf, pB);
        }
#pragma unroll
        for (int dt = 0; dt < 4; ++dt) outacc[dt] = outacc[dt] * gt[0];
    }
    wave_lds_fence();

    const int cur = tq0 >> 6;
    int selreg = -1;
    if (cur < 16) selreg = (n16 <= cur) ? n16 : -1;
    else {
        const int sq = lane >> 4, tsel = tq0 + sq; (void)tsel;
        float sc[8];
#pragma unroll
        for (int jj = 0; jj < 8; ++jj) { const int j = n16 + 16 * jj;
            float v;
            if (j > cur) v = -1.f;
            else if (j == 0 || j == cur || j == cur - 1) v = 1e4f;
            else { const LAS float* ip = imp + sq * 512 + 4 * j; v = ip[0] + 2.f * (ip[-1] + ip[-2] + ip[-3]) + ip[-4]; }
            sc[jj] = v; }
        for (int s = 0; s < 16; ++s) {
            float bv = sc[0]; int bj = n16;
#pragma unroll
            for (int jj = 1; jj < 8; ++jj) if (sc[jj] > bv) { bv = sc[jj]; bj = n16 + 16 * jj; }
#pragma unroll
            for (int off = 1; off < 16; off <<= 1) { const float ov = __shfl_xor(bv, off); const int oj = __shfl_xor(bj, off); if (ov > bv || (ov == bv && oj < bj)) { bv = ov; bj = oj; } }
            if (n16 == s) selreg = (bv >= 0.f) ? bj : -1;
#pragma unroll
            for (int jj = 0; jj < 8; ++jj) if (bj == n16 + 16 * jj) sc[jj] = -2.f;
        }
    }
    if (cur >= 16) {
        const int fj = selreg;
        const int key = (fj < 0) ? ((1 << 20) + n16) : ((fj == 0 || fj == cur || fj == cur - 1) ? fj : (1 << 10) + fj);
        int rank = 0;
#pragma unroll
        for (int o = 1; o < 16; ++o) { const int other = __shfl(key, (lane & 48) | ((n16 + o) & 15)); rank += (other < key) ? 1 : 0; }
        selreg = __builtin_amdgcn_ds_permute(((lane & 48) | rank) << 2, fj);
    }
    const int nvalid = (cur + 1) < 16 ? (cur + 1) : 16;
    wave_lds_fence();
#pragma unroll
    for (int dt = 0; dt < 4; ++dt) *(LAS f32x4*)(imp + (dt * 64 + lane) * 4) = outacc[dt];

    {
        SmState st{-1e30f, 0.f};
        f32x4 Od[4];
#pragma unroll
        for (int dt = 0; dt < 4; ++dt) Od[dt] = (f32x4){0.f, 0.f, 0.f, 0.f};
        const unsigned char* Ks8 = (const unsigned char*)(ws + WS_KST) + (size_t)(b * 4 + g) * 128 * 4096;
        const unsigned char* Vs8 = (const unsigned char*)(ws + WS_VST) + (size_t)(b * 4 + g) * 128 * 4096;
        long q8[2];
#pragma unroll
        for (int kk = 0; kk < 2; ++kk) { const u32x4 w = __builtin_bit_cast(u32x4, qB[kk]);
            q8[kk] = pack8_fp8(bflo(w.x), bfhi(w.x), bflo(w.y), bfhi(w.y), bflo(w.z), bfhi(w.z), bflo(w.w), bfhi(w.w)); }
        int ns = 0;
        for (; ns < nvalid; ++ns) { const int j0 = __builtin_amdgcn_readlane(selreg, ns), j1 = __builtin_amdgcn_readlane(selreg, 16 + ns), j2 = __builtin_amdgcn_readlane(selreg, 32 + ns), j3 = __builtin_amdgcn_readlane(selreg, 48 + ns);
            if (!(j0 >= 0 && j0 == j1 && j0 == j2 && j0 == j3)) break; }
        {
            long kh[2][2], vh[4];
            if (ns > 0) { const int j0_ = __builtin_amdgcn_readlane(selreg, 0); load_kh8(kh, Ks8 + (size_t)j0_ * 4096, 0, lane); load_vh8(vh, Vs8 + (size_t)j0_ * 4096, 0, lane); }
            for (int hs = 0; hs < 2 * ns; ++hs) {
                const int s = hs >> 1, hh = hs & 1;
                const int j = __builtin_amdgcn_readlane(selreg, s);
                const bool more = hs + 1 < 2 * ns; const int s1 = (hs + 1) >> 1, h1 = (hs + 1) & 1;
                const int jn = more ? __builtin_amdgcn_readlane(selreg, s1) : 0;
                f32x4 acc[2];
                acc[0] = (f32x4){0.f, 0.f, 0.f, 0.f}; acc[1] = (f32x4){0.f, 0.f, 0.f, 0.f};
                qk_acch8(acc, kh, q8);
                if (more) load_kh8(kh, Ks8 + (size_t)jn * 4096, h1, lane);
                if (__all(t - (j * 64 + 32 * hh + 31) >= 1023)) softmax_half_far(acc, lutg, st, Od);
                else { bf16x8 pB; softmax_half<1>(acc, j * 64 + 32 * hh, true, t, g4, lutg, st, Od, pB); }
                pv_acch8(Od, vh, p_to_fp8(acc));
                if (more) load_vh8(vh, Vs8 + (size_t)jn * 4096, h1, lane);
            }
        }
        const int nh = 2 * nvalid, h0 = 2 * ns;
        long kq[4][2][2], vq[4][4];
        if (h0 < nh) {
#pragma unroll
            for (int q2 = 0; q2 < 4; ++q2) { int j = __builtin_amdgcn_readlane(selreg, 16 * q2 + ns); j = j < 0 ? 0 : j; load_kh8(kq[q2], Ks8 + (size_t)j * 4096, 0, lane); load_vh8(vq[q2], Vs8 + (size_t)j * 4096, 0, lane); } }
        for (int hs = h0; hs < nh; ++hs) {
            const int s = hs >> 1, hh = hs & 1;
            const int jm = __shfl(selreg, 16 * qi + s);
            f32x4 acc[2];
            acc[0] = (f32x4){0.f, 0.f, 0.f, 0.f}; acc[1] = (f32x4){0.f, 0.f, 0.f, 0.f};
#pragma unroll
            for (int q2 = 0; q2 < 4; ++q2) { long qm[2]; qm[0] = (qi == q2) ? q8[0] : 0l; qm[1] = (qi == q2) ? q8[1] : 0l; qk_acch8(acc, kq[q2], qm); }
            const bool more = hs + 1 < nh; const int s1 = (hs + 1) >> 1, h1 = (hs + 1) & 1;
            int jn[4];
#pragma unroll
            for (int q2 = 0; q2 < 4; ++q2) { int j = more ? __builtin_amdgcn_readlane(selreg, 16 * q2 + s1) : 0; jn[q2] = j < 0 ? 0 : j; }
            if (more) {
#pragma unroll
                for (int q2 = 0; q2 < 4; ++q2) load_kh8(kq[q2], Ks8 + (size_t)jn[q2] * 4096, h1, lane); }
            if (__all(jm >= 0 && t - (jm * 64 + 32 * hh + 31) >= 1023)) softmax_half_far(acc, lutg, st, Od);
            else { bf16x8 pB; softmax_half<1>(acc, (jm < 0 ? 0 : jm) * 64 + 32 * hh, jm >= 0, t, g4, lutg, st, Od, pB); }
            const long p8 = p_to_fp8(acc);
#pragma unroll
            for (int q2 = 0; q2 < 4; ++q2) { const long pm = (qi == q2) ? p8 : 0l; pv_acch8(Od, vq[q2], pm); }
            if (more) {
#pragma unroll
                for (int q2 = 0; q2 < 4; ++q2) load_vh8(vq[q2], Vs8 + (size_t)jn[q2] * 4096, h1, lane); }
        }
        float lt = st.l; lt += __shfl_xor(lt, 16); lt += __shfl_xor(lt, 32);
        const float sc = gt[1] / (P8_SCALE * fmaxf(lt, 1e-30f));
#pragma unroll
        for (int dt = 0; dt < 4; ++dt) outacc[dt] = Od[dt] * sc;
    }

    {
        SmState st{-1e30f, 0.f};
        f32x4 Od[4];
#pragma unroll
        for (int dt = 0; dt < 4; ++dt) Od[dt] = (f32x4){0.f, 0.f, 0.f, 0.f};
        const bf16_t* Kw = (const bf16_t*)(ws + WS_KWT) + (size_t)(b * 4 + g) * 128 * 4096;
        const int lo = tq0 - 511, jb0 = (lo > 0 ? lo : 0) >> 6, jb1 = (tq0 + 3) >> 6;
        for (int jb = jb0; jb <= jb1; ++jb) {
            bf16x8 kf[4][2]; load_k(kf, Kw + (size_t)jb * 4096, lane);
            bf16x8 vf[4][2]; load_v(vf, VWT + (size_t)jb * 4096, lane);
            f32x4 acc[4];
#pragma unroll
            for (int nt = 0; nt < 4; ++nt) acc[nt] = (f32x4){0.f, 0.f, 0.f, 0.f};
            qk_acc(acc, kf, qB);
            bf16x8 pB[2];
            softmax_block<2>(acc, jb * 64, true, t, g4, lutg, st, Od, pB);
            pv_acc(Od, vf, pB);
        }
        float lt = st.l; lt += __shfl_xor(lt, 16); lt += __shfl_xor(lt, 32);
        const float sc = gt[2] / fmaxf(lt, 1e-30f);
#pragma unroll
        for (int dt = 0; dt < 4; ++dt) outacc[dt] = outacc[dt] + Od[dt] * sc;
    }
    wave_lds_fence();
#pragma unroll
    for (int dt = 0; dt < 4; ++dt) outacc[dt] = outacc[dt] + *(const LAS f32x4*)(imp + (dt * 64 + lane) * 4);
    bf16_t* orow = MIX + ((size_t)b * SEQ + t) * DM + DSSM + (4 * g + r) * 64 + 4 * g4;
#pragma unroll
    for (int dt = 0; dt < 4; ++dt) { u32x2 w; w.x = pk2(outacc[dt][0], outacc[dt][1]); w.y = pk2(outacc[dt][2], outacc[dt][3]); *(u32x2*)(orow + 16 * dt) = w; }
    wave_lds_fence();
}

__global__ void __launch_bounds__(512, 2) hymba_fwd(Args A_unused) {
    extern __shared__ __attribute__((aligned(16))) unsigned char lds_raw[];
    LAS unsigned char* lds = (LAS unsigned char*)lds_raw;
    cg::grid_group grid = cg::this_grid();
#define GRID_SYNC() do { asm volatile("s_waitcnt vmcnt(0) lgkmcnt(0)" ::: "memory"); grid.sync(); \
    asm volatile("buffer_inv sc1\n\ts_waitcnt vmcnt(0) lgkmcnt(0)" ::: "memory"); } while (0)
    const int wave0 = __builtin_amdgcn_readfirstlane(threadIdx.x >> 6);
#define PHASE_IDS() int wv_ = wave0; asm volatile("" : "+s"(wv_)); int tid; asm volatile("v_mbcnt_lo_u32_b32 %0, -1, 0\n\tv_mbcnt_hi_u32_b32 %0, -1, %0" : "=v"(tid)); tid += wv_ * 64; asm volatile("" : "+v"(tid)); const int lane = tid & 63, wave = __builtin_amdgcn_readfirstlane(tid >> 6); \
    int G = gridDim.x, blk = blockIdx.x; asm volatile("" : "+s"(G), "+s"(blk)); const int gw = blk * 8 + wave, NGW = G * 8; (void)lane; (void)gw; (void)NGW;

    unsigned nsync = 0;
#define FAST_SYNC() do { asm volatile("s_waitcnt vmcnt(0) lgkmcnt(0)" ::: "memory"); __syncthreads(); ++nsync; \
    { int l0_; asm volatile("v_mbcnt_lo_u32_b32 %0, -1, 0\n\tv_mbcnt_hi_u32_b32 %0, -1, %0" : "=v"(l0_)); \
      if (wave0 == 0 && l0_ == 0) { unsigned* bar_ = (unsigned*)(get_args()->ws + WS_CTL); const unsigned tgt_ = nsync * gridDim.x; \
        __builtin_amdgcn_fence(__ATOMIC_RELEASE, "agent"); asm volatile("s_waitcnt vmcnt(0)" ::: "memory"); \
        __hip_atomic_fetch_add(bar_, 1u, __ATOMIC_RELAXED, __HIP_MEMORY_SCOPE_AGENT); \
        for (unsigned sp_ = 0; sp_ < (1u << 22); ++sp_) { if (__hip_atomic_load(bar_, __ATOMIC_RELAXED, __HIP_MEMORY_SCOPE_AGENT) >= tgt_) break; __builtin_amdgcn_s_sleep(2); } } } \
    __syncthreads(); asm volatile("buffer_inv sc1\n\ts_waitcnt vmcnt(0) lgkmcnt(0)" ::: "memory"); } while (0)

    { PHASE_IDS(); if (blk == 0 && tid == 0) __hip_atomic_store((unsigned*)(get_args()->ws + WS_CTL), 0u, __ATOMIC_RELAXED, __HIP_MEMORY_SCOPE_AGENT);
      prologue(lds, wave, lane, gw, NGW); }
    GRID_SYNC();

#pragma nounroll
    for (int l = 0; l < DEPTH; ++l) {
        {
            PHASE_IDS(); CArgs* Ap = get_args(); unsigned char* ws = Ap->ws;
            pg8::Gemm g{(const bf16_t*)(ws + WS_XB), (const bf16_t*)(ws + WS_WIN) + (size_t)l * NINP * DM, MTOK, NINP, DM}; pg8::StaticOrder S; S.init(MTOK, NINP, G, blk);
            const float* rq = (const float*)(ws + WS_RSQ) + (size_t)(2 * l) * RSQ_BUF; LAS float* tab = (LAS float*)(lds + 131072);
            pg8::Unit u0; const int pm0 = S.next(0, u0) ? u0.pm : -1; if (pm0 >= 0) rstd_table(rq, pm0, tab, tid); else __syncthreads();
            EpiInProj E{ws, rq, tab, pm0};
            pg8::gemm_phase<EpiInProj, pg8::StaticOrder, true, true>(lds, g, S, E, tid);
        }
        FAST_SYNC();
        {
            PHASE_IDS(); CArgs* Ap = get_args();
            for (int wt = blk; wt < 256; wt += G) { const int b_ = wt >> 7, cp_ = (wt >> 4) & 7, gq_ = wt & 15;
                s5_task<1>(Ap, l, b_, 4 * gq_ + (wave & 3), 2 * cp_ + (wave >> 2), lds + wave * 8192, lane); }
            if (wave < 2) for (int task = blk * 2 + wave; task < 512; task += G * 2) compress_task(Ap, l, task, lane);
        }
        FAST_SYNC();
        {
            PHASE_IDS(); CArgs* Ap = get_args();
            for (int wt = blk; wt < 256; wt += G) { const int b_ = wt >> 7, cp_ = (wt >> 4) & 7, gq_ = wt & 15;
                s5_task<2>(Ap, l, b_, 4 * gq_ + (wave & 3), 2 * cp_ + (wave >> 2), lds + wave * 8192, lane); }
            __syncthreads();
            LAS float* lut = (LAS float*)lds;
            { const float* tab = Ap->in[1];
              for (int e = tid; e < 4 * 1024 * 4; e += 512) { const int r = e & 3, dist = (e >> 2) & 1023, gg = e >> 12; lut[e] = tab[rel_bucket_i(dist) * 16 + gg * 4 + r]; } }
            __syncthreads();
            LAS float* imp = (LAS float*)(lds + 65536 + wave * 8192);
            for (int i = 0; ; ++i) {
                const int unit = i * G + blk; if (unit >= 2048) break;
                const int bg = unit >> 8; int qt = unit & 255; qt = ((qt & 7) << 5) | (qt >> 3);
                if (i & 1) qt = 255 - qt;
                nsa_wave(Ap, l, bg >> 2, bg & 3, qt * 32 + wave * 4, lut, imp, lane);
            }
            __syncthreads();
        }
        FAST_SYNC();
        {
            PHASE_IDS(); CArgs* Ap = get_args(); unsigned char* ws = Ap->ws;
            pg8::Gemm g{(const bf16_t*)(ws + WS_Y1), (const bf16_t*)(ws + WS_WGLU) + (size_t)l * 2 * DSSM * DSSM, MTOK, 2 * DSSM, DSSM}; pg8::StaticOrder S; S.init(MTOK, 2 * DSSM, G, blk);
            EpiGlu E{(bf16_t*)(ws + WS_MIX), Ap->in[15] + (size_t)l * 2 * DSSM};
            pg8::gemm_phase<EpiGlu, pg8::StaticOrder, true, true>(lds, g, S, E, tid);
        }
        FAST_SYNC();
        {
            PHASE_IDS(); CArgs* Ap = get_args(); unsigned char* ws = Ap->ws;
            pg8::Gemm g{(const bf16_t*)(ws + WS_MIX), (const bf16_t*)(ws + WS_WOUT) + (size_t)l * DM * DM, MTOK, DM, DM}; pg8::StaticOrder S; S.init(MTOK, DM, G, blk);
            EpiResid E{(bf16_t*)(ws + WS_XB), (float*)(ws + WS_RSQ) + (size_t)(2 * l + 1) * RSQ_BUF};
            pg8::gemm_phase<EpiResid, pg8::StaticOrder, true, true>(lds, g, S, E, tid);
        }
        FAST_SYNC();
        {
            PHASE_IDS(); CArgs* Ap = get_args(); unsigned char* ws = Ap->ws;
            pg8::Gemm g{(const bf16_t*)(ws + WS_XB), (const bf16_t*)(ws + WS_WGU) + (size_t)l * 2 * DFF * DM, MTOK, 2 * DFF, DM}; pg8::StaticOrder S; S.init(MTOK, 2 * DFF, G, blk);
            const float* rq = (const float*)(ws + WS_RSQ) + (size_t)(2 * l + 1) * RSQ_BUF; LAS float* tab = (LAS float*)(lds + 131072);
            pg8::Unit u0; const int pm0 = S.next(0, u0) ? u0.pm : -1; if (pm0 >= 0) rstd_table(rq, pm0, tab, tid); else __syncthreads();
            EpiSwiglu E{(bf16_t*)(ws + WS_HID), rq, tab, pm0};
            pg8::gemm_phase<EpiSwiglu, pg8::StaticOrder, true, true>(lds, g, S, E, tid);
        }
        FAST_SYNC();
        {
            PHASE_IDS(); CArgs* Ap = get_args(); unsigned char* ws = Ap->ws;
            pg8::Gemm g{(const bf16_t*)(ws + WS_HID), (const bf16_t*)(ws + WS_WDN) + (size_t)l * DM * DFF, MTOK, DM, DFF}; pg8::StaticOrder S; S.init(MTOK, DM, G, blk);
            EpiResid E{(bf16_t*)(ws + WS_XB), (float*)(ws + WS_RSQ) + (size_t)(2 * l + 2) * RSQ_BUF};
            pg8::gemm_phase<EpiResid, pg8::StaticOrder, true, true>(lds, g, S, E, tid);
        }
        FAST_SYNC();
    }
    {
        PHASE_IDS(); CArgs* Ap = get_args();
        const float* fr = (const float*)(Ap->ws + WS_RSQ) + (size_t)(2 * DEPTH) * RSQ_BUF; const float* gn = Ap->in[4]; float* out = Ap->out;
        for (int m = gw; m < MTOK; m += NGW) {
            const float sq = wave_sum(lane < 32 ? fr[(size_t)lane * MTOK + m] : 0.f);
            const float rstd = rsqrtf(sq * (1.f / DM) + EPS);
            f32x4* xo = (f32x4*)(out + (size_t)m * DM) + lane; const f32x4* gp = (const f32x4*)gn + lane; const u32x2* xb = (const u32x2*)((const bf16_t*)(Ap->ws + WS_XB) + (size_t)m * DM) + lane;
#pragma unroll
            for (int j = 0; j < 8; ++j) { const u32x2 q = xb[64 * j]; f32x4 v = (f32x4){bflo(q.x), bfhi(q.x), bflo(q.y), bfhi(q.y)}; const f32x4 gg = gp[64 * j]; v = v * rstd * gg; __builtin_nontemporal_store(v, &xo[64 * j]); }
        }
    }
}

extern "C" void kernel_launch(void* const* d_in, const int* in_sizes, int n_in, void* d_out, int out_size, void* d_ws, size_t ws_size, hipStream_t stream) {
    static int grid = 0;
    if (grid == 0) {
        if (n_in != 26 || ws_size < WS_END) { fprintf(stderr, "kernel_launch: unexpected inputs (n_in %d, ws %zu, need %zu)\n", n_in, ws_size, (size_t)WS_END); grid = -1; return; }
        int dev = 0, cus = 0, per_cu = 0;
        hipGetDevice(&dev); hipDeviceGetAttribute(&cus, hipDeviceAttributeMultiprocessorCount, dev);
        hipFuncSetAttribute((const void*)hymba_fwd, hipFuncAttributeMaxDynamicSharedMemorySize, LDS_BYTES);
        hipOccupancyMaxActiveBlocksPerMultiprocessor(&per_cu, (const void*)hymba_fwd, 512, LDS_BYTES);
        if (per_cu < 1) { fprintf(stderr, "kernel_launch: occupancy query says %d blocks per CU\n", per_cu); per_cu = 1; }
        grid = cus * 1;
        (void)hipGetLastError();
    }
    if (grid < 0) return;
    Args a{};
    for (int i = 0; i < 26; ++i) a.in[i] = (const float*)d_in[i];
    a.out = (float*)d_out; a.ws = (unsigned char*)d_ws;
    void* args[] = {&a};
    hipError_t e = hipLaunchCooperativeKernel((const void*)hymba_fwd, dim3(grid), dim3(512), args, LDS_BYTES, stream);
    if (e != hipSuccess) fprintf(stderr, "cooperative launch failed: %s (grid %d)\n", hipGetErrorString(e), grid);
}
```

```cpp
#include <hip/hip_runtime.h>
#include <hip/hip_cooperative_groups.h>
#include <cstdio>
#include <cstdint>
namespace cg = cooperative_groups;

#define LAS __attribute__((address_space(3)))
typedef unsigned short bf16_t;
typedef short bf16x8 __attribute__((ext_vector_type(8)));
typedef short s16x4 __attribute__((ext_vector_type(4)));
typedef float f32x4 __attribute__((ext_vector_type(4)));
typedef float f32x2 __attribute__((ext_vector_type(2)));
typedef unsigned u32x4 __attribute__((ext_vector_type(4)));
typedef unsigned u32x2 __attribute__((ext_vector_type(2)));

constexpr int NB = 2, SEQ = 8192, MTOK = NB * SEQ, DM = 2048, DEPTH = 4;
constexpr int NIN = 3632, NINP = 3840;
constexpr int DSSM = 1024, NGRP = 64, NST = 64;
constexpr int NKV = 4, HD = 64;
constexpr int DFF = 5632;
constexpr int NCHUNK = 16, CHUNK = SEQ / NCHUNK;
constexpr float EPS = 1e-6f;
constexpr int C_Q = 1024, C_KC = 2048, C_VC = 2304, C_KS = 2560, C_KW = 3072, C_GATE = 3584;

constexpr size_t MiB = 1u << 20;
constexpr size_t WS_CTL = 0;
constexpr size_t WS_WIN = 1 * MiB;
constexpr size_t WS_WGLU = WS_WIN + 60 * MiB;
constexpr size_t WS_WOUT = WS_WGLU + 16 * MiB;
constexpr size_t WS_WGU = WS_WOUT + 32 * MiB;
constexpr size_t WS_WDN = WS_WGU + 176 * MiB;
constexpr size_t WS_CW1 = WS_WDN + 88 * MiB;
constexpr size_t WS_CW2 = WS_CW1 + 4 * MiB;
constexpr size_t WS_XB = WS_CW2 + 1 * MiB;
constexpr size_t WS_P = WS_XB + 64 * MiB;
constexpr size_t WS_Y1 = WS_P + 120 * MiB;
constexpr size_t WS_MIX = WS_Y1 + 32 * MiB;
constexpr size_t WS_HID = WS_P;
constexpr size_t WS_VST = WS_MIX + 64 * MiB;
constexpr size_t WS_VWT = WS_VST + 8 * MiB;
constexpr size_t WS_KC = WS_VWT + 8 * MiB;
constexpr size_t WS_VCT = WS_KC + 4 * MiB;
constexpr size_t WS_SST = WS_VCT + 4 * MiB;
constexpr size_t WS_RSQ = WS_SST + 4 * MiB;
constexpr size_t WS_P1 = WS_RSQ + 18 * MiB;
constexpr size_t WS_VT1 = WS_P1 + 120 * MiB;
constexpr size_t WS_END = WS_P1 + 16 * MiB;
__host__ __device__ __forceinline__ size_t p_off(int) { return WS_P; }
__host__ __device__ __forceinline__ size_t vt_off(int) { return WS_VST; }
constexpr size_t WS_KST = WS_P1;
constexpr size_t WS_KWT = WS_P1 + 8 * MiB;
constexpr size_t RSQ_BUF = (size_t)32 * MTOK;

constexpr int LDS_BYTES = 135168;

namespace pg8 {
constexpr int BM = 256, BK = 64, HALF = 128, HTB = HALF * BK * 2, STAGE_BYTES = 8 * HTB, NXCD = 8, WGM = 8;
__host__ __device__ __forceinline__ int lds_byte(int r, int c) { const int st = (r >> 4) * 2 + (c >> 5), rr = r & 15, cc = c & 31, ob = rr * 64 + cc * 2; return st * 1024 + (ob ^ (((ob >> 9) & 1) << 5)); }
__host__ __device__ __forceinline__ void stage_rc(int b, int& R, int& C) { const int st = b / 1024, sb = b % 1024, swz = sb ^ (((sb >> 9) & 1) << 5); R = (st >> 1) * 16 + swz / 64; C = (st & 1) * 32 + (swz % 64) / 2; }
struct Unit { int pm, pn; };
struct Gemm { const bf16_t* A; const bf16_t* Bt; int M, N, K; };
struct StaticOrder {
    int nM, nN, nwg, G, c;
    __host__ __device__ void init(int M, int N, int G_, int c_) { nM = M / BM; nN = N / BM; nwg = nM * nN; G = G_; c = c_; }
    __host__ __device__ bool next(int i, Unit& u) const {
        const long L = (long)i * G + c; if (L >= nwg) return false;
        int wgid = (int)L; { const int q = nwg / NXCD, r = nwg % NXCD, xcd = wgid % NXCD, off = wgid / NXCD; wgid = (xcd < r ? xcd * (q + 1) : r * (q + 1) + (xcd - r) * q) + off; }
        const int nig = WGM * nN, gid = wgid / nig, fm = gid * WGM, gsz = (nM - fm) < WGM ? (nM - fm) : WGM;
        u.pm = fm + ((wgid % nig) % gsz); u.pn = (wgid % nig) / gsz; return true;
    }
};
typedef float f32x2_cv __attribute__((ext_vector_type(2))); typedef __bf16 bf16x2_cv __attribute__((ext_vector_type(2)));
__device__ __forceinline__ unsigned cvt_pk_bf16(float lo, float hi) { const f32x2_cv v = {lo, hi}; const bf16x2_cv b = __builtin_convertvector(v, bf16x2_cv); return __builtin_bit_cast(unsigned, b); }

template <class Epi, class Sched, bool ALIGN_EPI = false, bool SP2 = false>
__device__ __forceinline__ void gemm_phase(LAS unsigned char* lds, const Gemm g, const Sched& S, const Epi& E, const int tid) {
    const int wid = __builtin_amdgcn_readfirstlane(tid >> 6), lane = tid & 63, wr = wid >> 2, wc = wid & 3, fr = lane & 15, fq = lane >> 4;
    const int K = g.K, nt = K / BK;
    unsigned voffA[2], voffB[2];
#pragma unroll
    for (int i = 0; i < 2; ++i) { int R, C; stage_rc(tid * 16 + i * 8192, R, C); voffA[i] = (unsigned)(R * K + C) * 2u; voffB[i] = voffA[i]; }
    const size_t kstep = (size_t)(BK * 2);
    const size_t hstep = (size_t)HALF * K * 2;
    const size_t tstep = 2 * hstep;
    const unsigned ldsw = (unsigned)wid * 1024u;
    const int aoff = lds_byte(wr * 64 + fr, fq * 8), boff = lds_byte(wc * 32 + fr, fq * 8);
#define PG8_SA(b, h) (((b) * 2 + (h)) * HTB)
#define PG8_SB(b, h) ((4 + (b) * 2 + (h)) * HTB)
#define PG8_STAGE(bufoff, gbase, voff) do { _Pragma("unroll") for (int _i = 0; _i < 2; ++_i) \
        __builtin_amdgcn_global_load_lds((const unsigned*)((const char*)(gbase) + (voff)[_i]), (LAS unsigned*)(lds + (bufoff) + ldsw + _i * 8192), 16, 0, 0); } while (0)
#define PG8_LDA(dst, b, h) do { _Pragma("unroll") for (int m = 0; m < 4; ++m) _Pragma("unroll") for (int k = 0; k < 2; ++k) dst[m][k] = *(const LAS bf16x8*)(lds + PG8_SA(b, h) + aoff + m * 2048 + k * 1024); } while (0)
#define PG8_LDB(dst, b, h) do { _Pragma("unroll") for (int n = 0; n < 2; ++n) _Pragma("unroll") for (int k = 0; k < 2; ++k) dst[n][k] = *(const LAS bf16x8*)(lds + PG8_SB(b, h) + boff + n * 2048 + k * 1024); } while (0)
#define PG8_MMA(ai, bj, At, Bt) do { __builtin_amdgcn_s_setprio(1); _Pragma("unroll") for (int m = 0; m < 4; ++m) _Pragma("unroll") for (int n = 0; n < 2; ++n) _Pragma("unroll") for (int k = 0; k < 2; ++k) \
        acc[ai][bj][m][n] = __builtin_amdgcn_mfma_f32_16x16x32_bf16(Bt[n][k], At[m][k], acc[ai][bj][m][n], 0, 0, 0); __builtin_amdgcn_s_setprio(0); } while (0)
#define PG8_WAIT_V(n) asm volatile("s_waitcnt vmcnt(" #n ")" ::: "memory")
#define PG8_WAIT_L(n) asm volatile("s_waitcnt lgkmcnt(" #n ")" ::: "memory")
#define PG8_BAR __builtin_amdgcn_s_barrier()
#define PG8_SCHED __builtin_amdgcn_sched_barrier(0)
    Unit cur, nxt; int ui = 0;
    if (!S.next(0, cur)) return;
    f32x4 acc[2][2][4][2];
#pragma unroll
    for (int a = 0; a < 2; ++a)
#pragma unroll
        for (int b = 0; b < 2; ++b)
#pragma unroll
            for (int m = 0; m < 4; ++m)
#pragma unroll
                for (int n = 0; n < 2; ++n) acc[a][b][m][n] = (f32x4){0.f, 0.f, 0.f, 0.f};
    bf16x8 At[4][2], B0[2][2], B1[2][2];
    const char* cA = (const char*)g.A + (size_t)cur.pm * tstep; const char* cB = (const char*)g.Bt + (size_t)cur.pn * tstep;
    if constexpr (SP2) {
        PG8_STAGE(PG8_SB(0, 0), cB, voffB); PG8_STAGE(PG8_SB(0, 1), cB + hstep, voffB); PG8_STAGE(PG8_SA(0, 0), cA, voffA); PG8_STAGE(PG8_SA(0, 1), cA + hstep, voffA);
        if (wr == 1) PG8_BAR;
        PG8_WAIT_V(2); PG8_BAR;
        PG8_STAGE(PG8_SB(1, 0), cB + kstep, voffB); PG8_STAGE(PG8_SA(1, 0), cA + kstep, voffA); PG8_STAGE(PG8_SB(1, 1), cB + hstep + kstep, voffB);
        PG8_WAIT_V(6); PG8_BAR;
    } else {
        PG8_STAGE(PG8_SB(0, 0), cB, voffB); PG8_STAGE(PG8_SA(0, 0), cA, voffA); PG8_STAGE(PG8_SB(0, 1), cB + hstep, voffB); PG8_STAGE(PG8_SA(0, 1), cA + hstep, voffA);
        if (wr == 1) PG8_BAR;
        PG8_WAIT_V(4); PG8_BAR;
        PG8_STAGE(PG8_SB(1, 0), cB + kstep, voffB); PG8_STAGE(PG8_SA(1, 0), cA + kstep, voffA); PG8_STAGE(PG8_SB(1, 1), cB + hstep + kstep, voffB);
        PG8_WAIT_V(6); PG8_BAR;
    }
    for (;;) {
        const bool has_next = S.next(ui + 1, nxt);
        const char* nA = has_next ? (const char*)g.A + (size_t)nxt.pm * tstep : cA; const char* nB = has_next ? (const char*)g.Bt + (size_t)nxt.pn * tstep : cB;
        for (int t = 0; t < nt; t += 2) {
            const bool last = (t == nt - 2);
            const char* a1 = cA + (size_t)(t + 1) * kstep;
            const char* a2 = last ? nA : cA + (size_t)(t + 2) * kstep; const char* b2 = last ? nB : cB + (size_t)(t + 2) * kstep;
            const char* a3 = a2 + kstep; const char* b3 = b2 + kstep;
            if constexpr (SP2) {
            PG8_LDB(B0, 0, 0); PG8_LDB(B1, 0, 1); PG8_SCHED; PG8_LDA(At, 0, 0); PG8_STAGE(PG8_SA(1, 1), a1 + hstep, voffA);
            PG8_WAIT_V(8); PG8_WAIT_L(0); PG8_BAR; PG8_MMA(0, 0, At, B0); PG8_MMA(0, 1, At, B1); PG8_BAR; PG8_SCHED;
            PG8_LDA(At, 0, 1); PG8_STAGE(PG8_SB(0, 0), b2, voffB); PG8_STAGE(PG8_SB(0, 1), b2 + hstep, voffB); PG8_STAGE(PG8_SA(0, 0), a2, voffA);
            PG8_WAIT_V(8); PG8_WAIT_L(0); PG8_BAR; PG8_MMA(1, 0, At, B0); PG8_MMA(1, 1, At, B1); PG8_BAR; PG8_SCHED;
            PG8_LDB(B0, 1, 0); PG8_LDB(B1, 1, 1); PG8_SCHED; PG8_LDA(At, 1, 0); PG8_STAGE(PG8_SA(0, 1), a2 + hstep, voffA);
            PG8_WAIT_V(8); PG8_WAIT_L(0); PG8_BAR; PG8_MMA(0, 0, At, B0); PG8_MMA(0, 1, At, B1); PG8_BAR; PG8_SCHED;
            PG8_LDA(At, 1, 1); PG8_STAGE(PG8_SB(1, 0), b3, voffB); PG8_STAGE(PG8_SB(1, 1), b3 + hstep, voffB); PG8_STAGE(PG8_SA(1, 0), a3, voffA);
            PG8_WAIT_V(8); PG8_WAIT_L(0); PG8_BAR; PG8_MMA(1, 0, At, B0); PG8_MMA(1, 1, At, B1); PG8_BAR; PG8_SCHED;
            } else {
            PG8_LDB(B0, 0, 0); PG8_SCHED; PG8_LDA(At, 0, 0); PG8_STAGE(PG8_SA(1, 1), a1 + hstep, voffA);
            PG8_WAIT_L(8); PG8_BAR; PG8_WAIT_L(0); PG8_MMA(0, 0, At, B0); PG8_BAR; PG8_SCHED;
            PG8_LDB(B1, 0, 1); PG8_STAGE(PG8_SB(0, 0), b2, voffB);
            PG8_BAR; PG8_WAIT_L(0); PG8_MMA(0, 1, At, B1); PG8_BAR;
            PG8_LDA(At, 0, 1); PG8_STAGE(PG8_SA(0, 0), a2, voffA);
            PG8_BAR; PG8_WAIT_L(0); PG8_MMA(1, 0, At, B0); PG8_BAR; PG8_SCHED;
            PG8_STAGE(PG8_SB(0, 1), b2 + hstep, voffB);
            PG8_WAIT_V(6); PG8_BAR; PG8_MMA(1, 1, At, B1); PG8_BAR;
            PG8_LDB(B0, 1, 0); PG8_SCHED; PG8_LDA(At, 1, 0); PG8_STAGE(PG8_SA(0, 1), a2 + hstep, voffA);
            PG8_WAIT_L(8); PG8_BAR; PG8_WAIT_L(0); PG8_MMA(0, 0, At, B0); PG8_BAR; PG8_SCHED;
            PG8_LDB(B1, 1, 1); PG8_STAGE(PG8_SB(1, 0), b3, voffB);
            PG8_BAR; PG8_WAIT_L(0); PG8_MMA(0, 1, At, B1); PG8_BAR;
            PG8_LDA(At, 1, 1); PG8_STAGE(PG8_SA(1, 0), a3, voffA);
            PG8_BAR; PG8_WAIT_L(0); PG8_MMA(1, 0, At, B0); PG8_BAR; PG8_SCHED;
            PG8_STAGE(PG8_SB(1, 1), b3 + hstep, voffB);
            PG8_WAIT_V(6); PG8_BAR; PG8_MMA(1, 1, At, B1); PG8_BAR;
            }
        }
        if constexpr (ALIGN_EPI) { if (wr == 0) PG8_BAR; }
        E(acc, cur, wr, wc, fr, fq);
        if (!has_next) break;
#pragma unroll
        for (int a = 0; a < 2; ++a)
#pragma unroll
            for (int b = 0; b < 2; ++b)
#pragma unroll
                for (int m = 0; m < 4; ++m)
#pragma unroll
                    for (int n = 0; n < 2; ++n) acc[a][b][m][n] = (f32x4){0.f, 0.f, 0.f, 0.f};
        cur = nxt; cA = nA; cB = nB; ++ui;
        if constexpr (ALIGN_EPI) { if (wr == 1) PG8_BAR; }
    }
    PG8_WAIT_V(0);
    if constexpr (!ALIGN_EPI) { if (wr == 0) PG8_BAR; }
    PG8_BAR;
#undef PG8_SA
#undef PG8_SB
#undef PG8_STAGE
#undef PG8_LDA
#undef PG8_LDB
#undef PG8_MMA
#undef PG8_WAIT_V
#undef PG8_WAIT_L
#undef PG8_BAR
#undef PG8_SCHED
}
}

__device__ __forceinline__ unsigned pk2(float lo, float hi) { return pg8::cvt_pk_bf16(lo, hi); }
__device__ __forceinline__ bf16_t f2bf(float f) { return (bf16_t)(pk2(f, f) & 0xffffu); }
__device__ __forceinline__ float bf2f(bf16_t h) { return __uint_as_float(((unsigned)h) << 16); }
__device__ __forceinline__ float bflo(unsigned w) { return __uint_as_float(w << 16); }
__device__ __forceinline__ float bfhi(unsigned w) { return __uint_as_float(w & 0xffff0000u); }
__device__ __forceinline__ float fexp(float x) { return __expf(x); }
__device__ __forceinline__ float sigmoidf_(float x) { return __builtin_amdgcn_rcpf(1.f + fexp(-x)); }
__device__ __forceinline__ float gelu_tanh(float x) { const float z = 0.7978845608f * (x + 0.044715f * x * x * x); const float e = fexp(2.f * z); const float th = 1.f - 2.f * __builtin_amdgcn_rcpf(e + 1.f); return 0.5f * x * (1.f + th); }
__device__ __forceinline__ int vperm(int k) { return (k & 32) | (((k & 15) >> 2) << 3) | (k & 3) | (((k >> 4) & 1) << 2); }
__device__ __forceinline__ int kswz(int key, int d) { return ((((key >> 4) * 2 + (d >> 5)) * 64) + ((d >> 3) & 3) * 16 + (key & 15)) * 8 + (d & 7); }
__device__ __forceinline__ int vswz(int d, int key) { const int k = key & 31; return ((((d >> 4) * 2 + (key >> 5)) * 64) + ((k & 15) >> 2) * 16 + (d & 15)) * 8 + (k & 3) + 4 * (k >> 4); }
__device__ __forceinline__ void wave_lds_fence() { asm volatile("s_waitcnt lgkmcnt(0)" ::: "memory"); }
__device__ __forceinline__ float wave_sum(float v) {
#pragma unroll
    for (int o = 1; o < 64; o <<= 1) v += __shfl_xor(v, o);
    return v;
}
__device__ __forceinline__ bf16x8 zero8() { return (bf16x8){0, 0, 0, 0, 0, 0, 0, 0}; }

__device__ __forceinline__ long pack8_fp8(float a0, float a1, float a2, float a3, float a4, float a5, float a6, float a7) {
    int lo = 0, hi = 0;
    lo = __builtin_amdgcn_cvt_pk_fp8_f32(a0, a1, lo, false); lo = __builtin_amdgcn_cvt_pk_fp8_f32(a2, a3, lo, true);
    hi = __builtin_amdgcn_cvt_pk_fp8_f32(a4, a5, hi, false); hi = __builtin_amdgcn_cvt_pk_fp8_f32(a6, a7, hi, true);
    return (long)(((unsigned long long)(unsigned)hi << 32) | (unsigned long long)(unsigned)lo);
}
__device__ __forceinline__ unsigned pack4_fp8(float a0, float a1, float a2, float a3) {
    int lo = 0; lo = __builtin_amdgcn_cvt_pk_fp8_f32(a0, a1, lo, false); lo = __builtin_amdgcn_cvt_pk_fp8_f32(a2, a3, lo, true); return (unsigned)lo;
}
__device__ __forceinline__ void rstd_table(const float* part, int pm, LAS float* tab, int tid) {
    const int row = tid >> 1, hf = tid & 1; float s = 0.f;
#pragma unroll
    for (int k = 0; k < 16; ++k) s += part[(size_t)(hf * 16 + k) * MTOK + pm * 256 + row];
    s += __shfl_xor(s, 1);
    if (hf == 0) tab[row] = rsqrtf(s * (1.f / DM) + EPS);
    __syncthreads();
}
__device__ __forceinline__ float row_rstd(const float* part, int r, int fq) {
    float s = 0.f;
#pragma unroll
    for (int k = 0; k < 8; ++k) s += part[(size_t)(fq * 8 + k) * MTOK + r];
    s += __shfl_xor(s, 16); s += __shfl_xor(s, 32);
    return rsqrtf(s * (1.f / DM) + EPS);
}
struct EpiInProj {
    unsigned char* wsb; const float* rowsq; const LAS float* tab; int tab_pm;
    __device__ __forceinline__ float rs(int r, int fq) const { return (r >> 8) == tab_pm ? tab[r & 255] : row_rstd(rowsq, r, fq); }
    __device__ __forceinline__ void operator()(const f32x4 (&acc)[2][2][4][2], const pg8::Unit& u, int wr, int wc, int fr, int fq) const {
        const int row0 = u.pm * 256 + wr * 64 + fr;
        const bool tr = (u.pn >= 10 && u.pn <= 13);
        if (!tr) {
            bf16_t* P = (bf16_t*)(wsb + WS_P);
#pragma unroll
            for (int ai = 0; ai < 2; ++ai)
#pragma unroll
                for (int m = 0; m < 4; ++m) {
                    const int r = row0 + ai * 128 + m * 16;
                    const float rstd = rs(r, fq);
                    bf16_t* rowp = P + (size_t)r * NINP + u.pn * 256 + wc * 32 + 4 * fq;
#pragma unroll
                    for (int bj = 0; bj < 2; ++bj)
#pragma unroll
                        for (int n = 0; n < 2; ++n) { const f32x4 v = acc[ai][bj][m][n] * rstd; u32x2 w; w.x = pk2(v[0], v[1]); w.y = pk2(v[2], v[3]); *(u32x2*)(rowp + bj * 128 + n * 16) = w; }
                }
        } else {
            const bool isv = (u.pn & 1); const bool sel8 = (u.pn < 12);
            bf16_t* BT = (bf16_t*)(wsb + ((u.pn == 10) ? WS_KST : (u.pn == 11) ? WS_VST : (u.pn == 12) ? WS_KWT : WS_VWT));
            const int b = u.pm >> 5, blk0 = (u.pm & 31) * 4 + wr;
            const int lk = (((fq >> 1) * 16 + fr) * 8) + 4 * (fq & 1);
            const int lv = (((fr >> 2) * 16 + 4 * fq) * 8) + (fr & 3);
#pragma unroll
            for (int ai = 0; ai < 2; ++ai)
#pragma unroll
                for (int m = 0; m < 4; ++m) {
                    const int r = row0 + ai * 128 + m * 16;
                    const float rstd = rs(r, fq);
#pragma unroll
                    for (int bj = 0; bj < 2; ++bj) {
                        bf16_t* blkp = BT + (size_t)((b * 4 + 2 * bj + (wc >> 1)) * 128 + blk0 + 2 * ai) * 4096;
#pragma unroll
                        for (int n = 0; n < 2; ++n) { const f32x4 v = acc[ai][bj][m][n] * rstd;
                            if (sel8) {
                                unsigned char* blk8 = (unsigned char*)BT + (size_t)((b * 4 + 2 * bj + (wc >> 1)) * 128 + blk0 + 2 * ai) * 4096;
                                if (!isv) *(unsigned*)(blk8 + ((m * 2 + (wc & 1)) * 64 + 2 * n * 16) * 8 + lk) = pack4_fp8(v[0], v[1], v[2], v[3]);
                                else { unsigned char* vp = blk8 + ((((wc & 1) * 2 + n) * 2 + (m >> 1)) * 64) * 8 + 4 * (m & 1) + lv; const unsigned w4 = pack4_fp8(v[0], v[1], v[2], v[3]);
#pragma unroll
                                    for (int i = 0; i < 4; ++i) vp[8 * i] = (unsigned char)(w4 >> (8 * i)); }
                            } else
                            if (!isv) { u32x2 w; w.x = pk2(v[0], v[1]); w.y = pk2(v[2], v[3]); *(u32x2*)(blkp + ((m * 2 + (wc & 1)) * 64 + 2 * n * 16) * 8 + lk) = w; }
                            else { bf16_t* vp = blkp + ((((wc & 1) * 2 + n) * 2 + (m >> 1)) * 64) * 8 + 4 * (m & 1) + lv;
#pragma unroll
                                for (int i = 0; i < 4; ++i) vp[8 * i] = f2bf(v[i]); } }
                    }
                }
        }
    }
};
struct EpiGlu {
    bf16_t* MIX; const float* bias;
    __device__ __forceinline__ void operator()(const f32x4 (&acc)[2][2][4][2], const pg8::Unit& u, int wr, int wc, int fr, int fq) const {
        const int row0 = u.pm * 256 + wr * 64 + fr;
#pragma unroll
        for (int bj = 0; bj < 2; ++bj) {
            const int j0 = u.pn * 128 + bj * 64 + wc * 16 + 4 * fq;
            const f32x4 ba = *(const f32x4*)(bias + j0), bb = *(const f32x4*)(bias + DSSM + j0);
#pragma unroll
            for (int ai = 0; ai < 2; ++ai)
#pragma unroll
                for (int m = 0; m < 4; ++m) {
                    const int r = row0 + ai * 128 + m * 16;
                    const f32x4 a = acc[ai][bj][m][0] + ba, b = acc[ai][bj][m][1] + bb;
                    float o[4];
#pragma unroll
                    for (int i = 0; i < 4; ++i) o[i] = a[i] * sigmoidf_(b[i]);
                    u32x2 w; w.x = pk2(o[0], o[1]); w.y = pk2(o[2], o[3]);
                    *(u32x2*)(MIX + (size_t)r * DM + j0) = w;
                }
        }
    }
};
struct EpiResid {
    bf16_t* XB; float* rowsq;
    __device__ __forceinline__ void operator()(const f32x4 (&acc)[2][2][4][2], const pg8::Unit& u, int wr, int wc, int fr, int fq) const {
        const int row0 = u.pm * 256 + wr * 64 + fr; const int col0 = u.pn * 256 + wc * 32 + 8 * fq;
#pragma unroll
        for (int ai = 0; ai < 2; ++ai)
#pragma unroll
            for (int m = 0; m < 4; ++m) {
                const int r = row0 + ai * 128 + m * 16; float ss = 0.f;
#pragma unroll
                for (int bj = 0; bj < 2; ++bj) {
                    const size_t off = (size_t)r * DM + col0 + bj * 128;
                    const u32x4 old = *(const u32x4*)(XB + off);
                    const f32x4 x0 = (f32x4){bflo(old.x), bfhi(old.x), bflo(old.y), bfhi(old.y)} + acc[ai][bj][m][0];
                    const f32x4 x1 = (f32x4){bflo(old.z), bfhi(old.z), bflo(old.w), bfhi(old.w)} + acc[ai][bj][m][1];
                    u32x4 w; w.x = pk2(x0[0], x0[1]); w.y = pk2(x0[2], x0[3]); w.z = pk2(x1[0], x1[1]); w.w = pk2(x1[2], x1[3]); *(u32x4*)(XB + off) = w;
                    ss += ((x0[0] * x0[0] + x0[1] * x0[1]) + (x0[2] * x0[2] + x0[3] * x0[3])) + ((x1[0] * x1[0] + x1[1] * x1[1]) + (x1[2] * x1[2] + x1[3] * x1[3]));
                }
                ss += __shfl_xor(ss, 16); ss += __shfl_xor(ss, 32);
                if (fq == 0) rowsq[(size_t)(u.pn * 4 + wc) * MTOK + r] = ss;
            }
    }
};
struct EpiSwiglu {
    bf16_t* HID; const float* rowsq; const LAS float* tab; int tab_pm;
    __device__ __forceinline__ float rs(int r, int fq) const { return (r >> 8) == tab_pm ? tab[r & 255] : row_rstd(rowsq, r, fq); }
    __device__ __forceinline__ void operator()(const f32x4 (&acc)[2][2][4][2], const pg8::Unit& u, int wr, int wc, int fr, int fq) const {
        const int row0 = u.pm * 256 + wr * 64 + fr;
#pragma unroll
        for (int ai = 0; ai < 2; ++ai)
#pragma unroll
            for (int m = 0; m < 4; ++m) {
                const int r = row0 + ai * 128 + m * 16;
                const float rstd = rs(r, fq);
                float o[2][4];
#pragma unroll
                for (int bj = 0; bj < 2; ++bj) {
                    const f32x4 gv = acc[ai][bj][m][0] * rstd, uv = acc[ai][bj][m][1] * rstd;
#pragma unroll
                    for (int i = 0; i < 4; ++i) o[bj][i] = gv[i] * sigmoidf_(gv[i]) * uv[i];
                }
                const int j0 = u.pn * 128 + wc * 32 + 8 * fq;
                u32x4 w; w.x = pk2(o[0][0], o[0][1]); w.y = pk2(o[0][2], o[0][3]); w.z = pk2(o[1][0], o[1][1]); w.w = pk2(o[1][2], o[1][3]);
                *(u32x4*)(HID + (size_t)r * DFF + j0) = w;
            }
    }
};

__device__ __forceinline__ void transpose_item(const float* W, int K, int N, bf16_t* WT, int mode, const float* gain, LAS float* scr, int item, int lane) {
    const int nblk = (N + 31) / 32, kb = item / nblk, nb = item % nblk, k0 = 64 * kb, n0 = 32 * nb;
    const int nn = n0 + (lane & 31);
    float cs = 1.f; if (mode == 4 && nn >= C_Q && nn < C_KC) cs = 0.125f;
#pragma unroll
    for (int i = 0; i < 32; ++i) { const int kk = 2 * i + (lane >> 5);
        float v = (nn < N) ? __builtin_nontemporal_load(&W[(size_t)(k0 + kk) * N + nn]) : 0.f;
        if (gain) v *= gain[k0 + kk];
        scr[kk * 33 + (lane & 31)] = v * cs; }
    wave_lds_fence();
    const int c = lane & 7;
#pragma unroll
    for (int j = 0; j < 4; ++j) { const int n = (lane >> 3) + 8 * j; const LAS float* s = scr + (8 * c) * 33 + n;
        u32x4 o; o.x = pk2(s[0 * 33], s[1 * 33]); o.y = pk2(s[2 * 33], s[3 * 33]); o.z = pk2(s[4 * 33], s[5 * 33]); o.w = pk2(s[6 * 33], s[7 * 33]);
        const int ng = n0 + n; int dest = ng;
        if (mode == 1) { const int hf = ng >= DSSM, jj = ng - DSSM * hf; dest = (jj >> 4) * 32 + 16 * hf + (jj & 15); }
        else if (mode == 5) { const int c32 = ng & 31; dest = (ng & ~31) + 16 * ((c32 >> 2) & 1) + 4 * (c32 >> 3) + (c32 & 3); }
        else if (mode == 2 || mode == 3) { const int jl = ng & 127; dest = (ng >> 7) * 256 + 128 * ((jl >> 2) & 1) + 32 * (jl >> 5) + 16 * (mode - 2) + 4 * ((jl >> 3) & 3) + (jl & 3); }
        *(u32x4*)(WT + (size_t)dest * K + k0 + 8 * c) = o; }
    wave_lds_fence();
}

struct Args {
    const float* in[26];
    float* out; unsigned char* ws;
};
typedef const Args __attribute__((address_space(4))) CArgs;
__device__ __forceinline__ CArgs* get_args() { CArgs* p = (CArgs*)__builtin_amdgcn_kernarg_segment_ptr(); asm volatile("" : "+s"(p)); return p; }

constexpr int IT_WIN = 32 * 114, IT_GLU = 16 * 64, IT_OUT = 32 * 64, IT_G = 32 * 176, IT_U = 32 * 176, IT_D = 88 * 64, IT_C1 = 32 * 4, IT_C2 = 2 * 2;
constexpr int IT_LAYER = IT_WIN + IT_GLU + IT_OUT + IT_G + IT_U + IT_D + 2 * IT_C1 + 2 * IT_C2;

__device__ __forceinline__ void prologue(LAS unsigned char* lds, int wave, int lane, int gw, int NGW) {
    CArgs* Ap = get_args();
    unsigned char* ws = Ap->ws;
    LAS float* scr = (LAS float*)(lds + wave * 16384);
    for (int it = gw; it < DEPTH * IT_LAYER; it += NGW) {
        const int l = it / IT_LAYER; int r = it % IT_LAYER;
        if (r < IT_WIN) { transpose_item(Ap->in[5] + (size_t)l * DM * NIN, DM, NIN, (bf16_t*)(ws + WS_WIN) + (size_t)l * NINP * DM, 4, Ap->in[2] + l * DM, scr, r, lane); continue; } r -= IT_WIN;
        if (r < IT_GLU) { transpose_item(Ap->in[14] + (size_t)l * DSSM * 2 * DSSM, DSSM, 2 * DSSM, (bf16_t*)(ws + WS_WGLU) + (size_t)l * 2 * DSSM * DSSM, 1, nullptr, scr, r, lane); continue; } r -= IT_GLU;
        if (r < IT_OUT) { transpose_item(Ap->in[22] + (size_t)l * DM * DM, DM, DM, (bf16_t*)(ws + WS_WOUT) + (size_t)l * DM * DM, 5, nullptr, scr, r, lane); continue; } r -= IT_OUT;
        if (r < IT_G) { transpose_item(Ap->in[23] + (size_t)l * DM * DFF, DM, DFF, (bf16_t*)(ws + WS_WGU) + (size_t)l * 2 * DFF * DM, 2, Ap->in[3] + l * DM, scr, r, lane); continue; } r -= IT_G;
        if (r < IT_U) { transpose_item(Ap->in[24] + (size_t)l * DM * DFF, DM, DFF, (bf16_t*)(ws + WS_WGU) + (size_t)l * 2 * DFF * DM, 3, Ap->in[3] + l * DM, scr, r, lane); continue; } r -= IT_U;
        if (r < IT_D) { transpose_item(Ap->in[25] + (size_t)l * DFF * DM, DFF, DM, (bf16_t*)(ws + WS_WDN) + (size_t)l * DM * DFF, 5, nullptr, scr, r, lane); continue; } r -= IT_D;
        if (r < IT_C1) { transpose_item(Ap->in[17] + (size_t)l * 2048 * 128, 2048, 128, (bf16_t*)(ws + WS_CW1) + (size_t)(l * 2 + 0) * 128 * 2048, 0, nullptr, scr, r, lane); continue; } r -= IT_C1;
        if (r < IT_C1) { transpose_item(Ap->in[20] + (size_t)l * 2048 * 128, 2048, 128, (bf16_t*)(ws + WS_CW1) + (size_t)(l * 2 + 1) * 128 * 2048, 0, nullptr, scr, r, lane); continue; } r -= IT_C1;
        if (r < IT_C2) { transpose_item(Ap->in[18] + (size_t)l * 128 * 64, 128, 64, (bf16_t*)(ws + WS_CW2) + (size_t)(l * 2 + 0) * 64 * 128, 0, nullptr, scr, r, lane); continue; } r -= IT_C2;
        transpose_item(Ap->in[21] + (size_t)l * 128 * 64, 128, 64, (bf16_t*)(ws + WS_CW2) + (size_t)(l * 2 + 1) * 64 * 128, 0, nullptr, scr, r, lane);
    }
    const float* x = Ap->in[0]; bf16_t* XB = (bf16_t*)(ws + WS_XB); float* rowsq = (float*)(ws + WS_RSQ);
    for (int m = gw; m < MTOK; m += NGW) {
        const f32x4* xr = (const f32x4*)(x + (size_t)m * DM) + lane; u32x2* xb = (u32x2*)(XB + (size_t)m * DM) + lane;
        float s = 0.f;
#pragma unroll
        for (int j = 0; j < 8; ++j) { const f32x4 v = __builtin_nontemporal_load(&xr[64 * j]); u32x2 w; w.x = pk2(v[0], v[1]); w.y = pk2(v[2], v[3]); xb[64 * j] = w; s += (v[0] * v[0] + v[1] * v[1]) + (v[2] * v[2] + v[3] * v[3]); }
        s = wave_sum(s);
        if (lane < 32) rowsq[(size_t)lane * MTOK + m] = (lane == 0) ? s : 0.f;
    }
}

__device__ __forceinline__ void sincos_small(float ang, float& sn, float& cs) {
    const float k = rintf(ang * 0.636619772f);
    float r = fmaf(-k, 1.5707963705f, ang); r = fmaf(-k, -4.37113883e-8f, r);
    const float r2 = r * r;
    const float s = r * (1.f + r2 * (-1.f / 6.f + r2 * (1.f / 120.f + r2 * (-1.f / 5040.f + r2 * (1.f / 362880.f)))));
    const float c = 1.f + r2 * (-0.5f + r2 * (1.f / 24.f + r2 * (-1.f / 720.f + r2 * (1.f / 40320.f))));
    const int q = ((int)k) & 3;
    sn = (q == 0) ? s : (q == 1) ? c : (q == 2) ? -s : -c;
    cs = (q == 0) ? c : (q == 1) ? -s : (q == 2) ? -c : s;
}

template <int PASS>
__device__ __forceinline__ void s5_task(CArgs* Ap, int l, int b, int g, int c, LAS unsigned char* wl, int lane) {
    if (PASS == 1 && c == NCHUNK - 1) return;
    unsigned char* ws = Ap->ws;
    const bf16_t* P = (const bf16_t*)(ws + p_off(l));
    f32x2* SST = (f32x2*)(ws + WS_SST + (size_t)l * MiB);
    LAS float* us = (LAS float*)wl;
    LAS bf16_t* Xs = (LAS bf16_t*)(wl + 1024);
    const int p = lane;
    const float a_re = fminf(Ap->in[6][(l * NGRP + g) * NST + p], -1e-4f), a_im = Ap->in[7][(l * NGRP + g) * NST + p];
    const float dt = expf(Ap->in[8][l * NGRP + g]);
    const float mag = expf(a_re * dt); float sn, cs; sincos_small(a_im * dt, sn, cs);
    const float ab_re = mag * cs, ab_im = mag * sn;
    const float nr = ab_re - 1.f, ni = ab_im, den = a_re * a_re + a_im * a_im;
    const float f_re = (nr * a_re + ni * a_im) / den, f_im = (ni * a_re - nr * a_im) / den;
    float bbr[16], bbi[16]; f32x2 bb2[16];
    {
        const f32x4* br = (const f32x4*)(Ap->in[9] + ((size_t)(l * NGRP + g) * NST + p) * 16); const f32x4* bi = (const f32x4*)(Ap->in[10] + ((size_t)(l * NGRP + g) * NST + p) * 16);
#pragma unroll
        for (int q = 0; q < 4; ++q) { const f32x4 vr = br[q], vi = bi[q];
#pragma unroll
            for (int i = 0; i < 4; ++i) { bbr[4 * q + i] = f_re * vr[i] - f_im * vi[i]; bbi[4 * q + i] = f_re * vi[i] + f_im * vr[i]; bb2[4 * q + i] = (f32x2){bbr[4 * q + i], bbi[4 * q + i]}; } }
    }
    float xr = 0.f, xi = 0.f;
    const int n16 = lane & 15, g4 = lane >> 4;
    bf16x8 cB[4]; float dval = 0.f;
    if (PASS == 2) {
        float pr = ab_re, pi = ab_im;
#pragma unroll
        for (int i = 0; i < 9; ++i) { const float t_ = pr * pr - pi * pi; pi = 2.f * pr * pi; pr = t_; }
        const f32x2* S = SST + (size_t)((b * NGRP + g) * NCHUNK) * NST + p;
        for (int cc = 0; cc < c; ++cc) { const f32x2 s = S[(size_t)cc * NST]; const float t_ = pr * xr - pi * xi + s.x; xi = pr * xi + pi * xr + s.y; xr = t_; }
        const float* cre = Ap->in[11] + ((size_t)(l * NGRP + g) * 16 + n16) * NST; const float* cim = Ap->in[12] + ((size_t)(l * NGRP + g) * 16 + n16) * NST;
#pragma unroll
        for (int kk = 0; kk < 4; ++kk) { const f32x4 r4 = *(const f32x4*)(cre + 16 * kk + 4 * g4), i4 = *(const f32x4*)(cim + 16 * kk + 4 * g4);
            u32x4 w; w.x = pk2(r4[0], -i4[0]); w.y = pk2(r4[1], -i4[1]); w.z = pk2(r4[2], -i4[2]); w.w = pk2(r4[3], -i4[3]);
            cB[kk] = __builtin_bit_cast(bf16x8, w); }
        dval = Ap->in[13][l * DSSM + g * 16 + n16];
    }
    const size_t row0 = (size_t)b * SEQ + (size_t)c * CHUNK;
    const bf16_t* up = P + (row0 + (lane >> 2)) * NINP + g * 16 + 4 * (lane & 3);
    u32x2 unext = *(const u32x2*)up;
    bf16_t* Y1 = (bf16_t*)(ws + WS_Y1);
    for (int tb = 0; tb < CHUNK; tb += 16) {
        const u32x2 ucur = unext;
        if (tb + 16 < CHUNK) unext = *(const u32x2*)(up + (size_t)(tb + 16) * NINP);
        *(LAS f32x4*)(us + (lane >> 2) * 16 + 4 * (lane & 3)) = (f32x4){bflo(ucur.x), bfhi(ucur.x), bflo(ucur.y), bfhi(ucur.y)};
        wave_lds_fence();
#pragma unroll 4
        for (int s = 0; s < 16; ++s) {
            const f32x4 u0 = *(const LAS f32x4*)(us + s * 16), u1 = *(const LAS f32x4*)(us + s * 16 + 4), u2 = *(const LAS f32x4*)(us + s * 16 + 8), u3 = *(const LAS f32x4*)(us + s * 16 + 12);
            f32x2 bu = (f32x2){0.f, 0.f};
#pragma unroll
            for (int i = 0; i < 4; ++i) bu = bb2[i] * (f32x2){u0[i], u0[i]} + bu;
#pragma unroll
            for (int i = 0; i < 4; ++i) bu = bb2[4 + i] * (f32x2){u1[i], u1[i]} + bu;
#pragma unroll
            for (int i = 0; i < 4; ++i) bu = bb2[8 + i] * (f32x2){u2[i], u2[i]} + bu;
#pragma unroll
            for (int i = 0; i < 4; ++i) bu = bb2[12 + i] * (f32x2){u3[i], u3[i]} + bu;
            const float br_ = bu.x, bi_ = bu.y;
            const float nxr = fmaf(ab_re, xr, fmaf(-ab_im, xi, br_)); const float nxi = fmaf(ab_re, xi, fmaf(ab_im, xr, bi_));
            xr = nxr; xi = nxi;
            if (PASS == 2) *(LAS unsigned*)(Xs + s * 136 + 2 * p) = pk2(xr, xi);
        }
        if (PASS == 2) {
            wave_lds_fence();
            f32x4 y = (f32x4){0.f, 0.f, 0.f, 0.f};
#pragma unroll
            for (int kk = 0; kk < 4; ++kk) { const bf16x8 xa = *(const LAS bf16x8*)(Xs + n16 * 136 + 32 * kk + 8 * g4); y = __builtin_amdgcn_mfma_f32_16x16x32_bf16(xa, cB[kk], y, 0, 0, 0); }
#pragma unroll
            for (int i = 0; i < 4; ++i) { const int tl = 4 * g4 + i; const float uv = us[tl * 16 + n16]; const float v = gelu_tanh(y[i] + dval * uv);
                Y1[(row0 + tb + tl) * DSSM + g * 16 + n16] = f2bf(v); }
        }
        wave_lds_fence();
    }
    if (PASS == 1) SST[(size_t)((b * NGRP + g) * NCHUNK + c) * NST + p] = (f32x2){xr, xi};
}

__device__ __forceinline__ void compress_task(CArgs* Ap, int l, int task, int lane) {
    unsigned char* ws = Ap->ws;
    const int kv = task & 1, nb = (task >> 1) & 31, g = (task >> 6) & 3, b = task >> 8;
    const int n16 = lane & 15, g4 = lane >> 4;
    const bf16_t* P = (const bf16_t*)(ws + p_off(l));
    const bf16_t* W1t = (const bf16_t*)(ws + WS_CW1) + (size_t)(l * 2 + kv) * 128 * 2048;
    const bf16_t* W2t = (const bf16_t*)(ws + WS_CW2) + (size_t)(l * 2 + kv) * 64 * 128;
    const float* pos = Ap->in[kv ? 19 : 16] + (size_t)l * 32 * 64;
    const int n = nb * 16 + n16;
    const int colb = (kv ? C_VC : C_KC) + g * 64;
    f32x4 acc[8];
#pragma unroll
    for (int h = 0; h < 8; ++h) acc[h] = (f32x4){0.f, 0.f, 0.f, 0.f};
#pragma unroll 2
    for (int ks = 0; ks < 64; ++ks) {
        const int itok = ks >> 1, d0 = 32 * (ks & 1) + 8 * g4;
        int tok = 16 * n + itok; tok = tok > SEQ - 1 ? SEQ - 1 : tok;
        const u32x4 raw = *(const u32x4*)(P + ((size_t)b * SEQ + tok) * NINP + colb + d0);
        const f32x4 p0 = *(const f32x4*)(pos + itok * 64 + d0), p1 = *(const f32x4*)(pos + itok * 64 + d0 + 4);
        u32x4 w;
        w.x = pk2(bflo(raw.x) + p0[0], bfhi(raw.x) + p0[1]); w.y = pk2(bflo(raw.y) + p0[2], bfhi(raw.y) + p0[3]);
        w.z = pk2(bflo(raw.z) + p1[0], bfhi(raw.z) + p1[1]); w.w = pk2(bflo(raw.w) + p1[2], bfhi(raw.w) + p1[3]);
        const bf16x8 fb = __builtin_bit_cast(bf16x8, w);
#pragma unroll
        for (int h = 0; h < 8; ++h) { const bf16x8 wa = *(const bf16x8*)(W1t + (size_t)(16 * h + n16) * 2048 + 32 * ks + 8 * g4); acc[h] = __builtin_amdgcn_mfma_f32_16x16x32_bf16(wa, fb, acc[h], 0, 0, 0); }
    }
    bf16x8 hB[4];
#pragma unroll
    for (int pp = 0; pp < 4; ++pp) { float v[8];
#pragma unroll
        for (int i = 0; i < 4; ++i) { v[i] = gelu_tanh(acc[2 * pp][i]); v[4 + i] = gelu_tanh(acc[2 * pp + 1][i]); }
        u32x4 w; w.x = pk2(v[0], v[1]); w.y = pk2(v[2], v[3]); w.z = pk2(v[4], v[5]); w.w = pk2(v[6], v[7]); hB[pp] = __builtin_bit_cast(bf16x8, w); }
    bf16_t* KC = (bf16_t*)(ws + WS_KC + (size_t)l * MiB); bf16_t* VCT = (bf16_t*)(ws + WS_VCT + (size_t)l * MiB);
#pragma unroll
    for (int dt = 0; dt < 4; ++dt) {
        f32x4 o = (f32x4){0.f, 0.f, 0.f, 0.f};
#pragma unroll
        for (int pp = 0; pp < 4; ++pp) { const bf16_t* wrow = W2t + (size_t)(16 * dt + n16) * 128 + 32 * pp + 4 * g4;
            const u32x2 lo = *(const u32x2*)wrow, hi = *(const u32x2*)(wrow + 16);
            u32x4 w; w.x = lo.x; w.y = lo.y; w.z = hi.x; w.w = hi.y;
            o = __builtin_amdgcn_mfma_f32_16x16x32_bf16(__builtin_bit_cast(bf16x8, w), hB[pp], o, 0, 0, 0); }
        if (kv == 0) { u32x2 w; w.x = pk2(o[0], o[1]); w.y = pk2(o[2], o[3]); *(u32x2*)(KC + (size_t)((b * 4 + g) * 8 + (n >> 6)) * 4096 + kswz(n & 63, 16 * dt + 4 * g4)) = w; }
        else {
#pragma unroll
            for (int i = 0; i < 4; ++i) VCT[(size_t)((b * 4 + g) * 8 + (n >> 6)) * 4096 + vswz(16 * dt + 4 * g4 + i, n & 63)] = f2bf(o[i]); }
    }
}

__device__ __forceinline__ void compress_simple(CArgs* Ap, int l, int task, LAS float* hs, int lane) {
    unsigned char* ws = Ap->ws;
    const int kv = task & 1, n0 = ((task >> 1) & 127) * 4, g = (task >> 8) & 3, b = task >> 10;
    const bf16_t* P = (const bf16_t*)(ws + p_off(l));
    const float* w1 = Ap->in[kv ? 20 : 17] + (size_t)l * 2048 * 128; const float* w2 = Ap->in[kv ? 21 : 18] + (size_t)l * 128 * 64;
    const float* pos = Ap->in[kv ? 19 : 16] + (size_t)l * 32 * 64;
    const int colb = (kv ? C_VC : C_KC) + g * 64;
    float h0[4] = {0.f, 0.f, 0.f, 0.f}, h1[4] = {0.f, 0.f, 0.f, 0.f};
    for (int i = 0; i < 32; ++i) {
        const bf16_t* pr[4];
#pragma unroll
        for (int r = 0; r < 4; ++r) { int tok = 16 * (n0 + r) + i; tok = tok > SEQ - 1 ? SEQ - 1 : tok; pr[r] = P + ((size_t)b * SEQ + tok) * NINP + colb; }
        for (int d8 = 0; d8 < 8; ++d8) {
            const f32x4 p0 = *(const f32x4*)(pos + i * 64 + d8 * 8), p1 = *(const f32x4*)(pos + i * 64 + d8 * 8 + 4);
            const float pv[8] = {p0[0], p0[1], p0[2], p0[3], p1[0], p1[1], p1[2], p1[3]};
            float f[4][8];
#pragma unroll
            for (int r = 0; r < 4; ++r) { const u32x4 raw = *(const u32x4*)(pr[r] + d8 * 8);
                f[r][0] = bflo(raw.x) + pv[0]; f[r][1] = bfhi(raw.x) + pv[1]; f[r][2] = bflo(raw.y) + pv[2]; f[r][3] = bfhi(raw.y) + pv[3];
                f[r][4] = bflo(raw.z) + pv[4]; f[r][5] = bfhi(raw.z) + pv[5]; f[r][6] = bflo(raw.w) + pv[6]; f[r][7] = bfhi(raw.w) + pv[7]; }
            const float* wr = w1 + (size_t)(i * 64 + d8 * 8) * 128 + lane;
#pragma unroll
            for (int e = 0; e < 8; ++e) { const float wa = wr[e * 128], wb = wr[e * 128 + 64];
#pragma unroll
                for (int r = 0; r < 4; ++r) { h0[r] = fmaf(f[r][e], wa, h0[r]); h1[r] = fmaf(f[r][e], wb, h1[r]); } }
        }
    }
#pragma unroll
    for (int r = 0; r < 4; ++r) { hs[r * 128 + lane] = gelu_tanh(h0[r]); hs[r * 128 + lane + 64] = gelu_tanh(h1[r]); }
    wave_lds_fence();
    float o[4] = {0.f, 0.f, 0.f, 0.f};
    for (int k = 0; k < 128; ++k) { const float w = w2[k * 64 + lane];
#pragma unroll
        for (int r = 0; r < 4; ++r) o[r] = fmaf(hs[r * 128 + k], w, o[r]); }
    wave_lds_fence();
    bf16_t* KC = (bf16_t*)(ws + WS_KC + (size_t)l * MiB); bf16_t* VCT = (bf16_t*)(ws + WS_VCT + (size_t)l * MiB);
#pragma unroll
    for (int r = 0; r < 4; ++r) { const int n = n0 + r;
        if (kv == 0) KC[(size_t)((b * 4 + g) * 8 + (n >> 6)) * 4096 + kswz(n & 63, lane)] = f2bf(o[r]);
        else VCT[(size_t)((b * 4 + g) * 8 + (n >> 6)) * 4096 + vswz(lane, n & 63)] = f2bf(o[r]); }
}

__device__ __forceinline__ int rel_bucket_i(int n) {
    if (n < 16) return n;
    int c = 0;
    c += n >= 16; c += n >= 21; c += n >= 27; c += n >= 35; c += n >= 46; c += n >= 59; c += n >= 77; c += n >= 99;
    c += n >= 128; c += n >= 166; c += n >= 216; c += n >= 280; c += n >= 363; c += n >= 470; c += n >= 609; c += n >= 790;
    return 15 + c;
}

struct SmState { float m, l; };

template <int MODE>
__device__ __forceinline__ void softmax_block(f32x4 (&acc)[4], int base, bool ok, int t, int g4, const LAS float* lutg, SmState& st, f32x4 (&O)[4], bf16x8 (&pB)[2]) {
    float mx = -1e30f; unsigned vm = 0u;
#pragma unroll
    for (int nt = 0; nt < 4; ++nt)
#pragma unroll
        for (int i = 0; i < 4; ++i) {
            const int key = base + 16 * nt + 4 * g4 + i;
            const int dist = (MODE == 0) ? t - (16 * key + 31) : t - key;
            bool valid = dist >= 0;
            if (MODE == 1) valid = valid && ok;
            if (MODE == 2) valid = valid && dist < 512;
            int dc = dist < 0 ? 0 : dist; dc = dc > 1023 ? 1023 : dc;
            const float lg = acc[nt][i] + lutg[dc * 4];
            acc[nt][i] = lg;
            if (valid) { mx = fmaxf(mx, lg); vm |= 1u << (nt * 4 + i); }
        }
    mx = fmaxf(mx, __shfl_xor(mx, 16)); mx = fmaxf(mx, __shfl_xor(mx, 32));
    const float mn = fmaxf(st.m, mx);
    const float sc = fexp(st.m - mn);
    float ls = 0.f;
#pragma unroll
    for (int nt = 0; nt < 4; ++nt)
#pragma unroll
        for (int i = 0; i < 4; ++i) { const float p = ((vm >> (nt * 4 + i)) & 1u) ? fexp(acc[nt][i] - mn) : 0.f; acc[nt][i] = p; ls += p; }
    st.l = st.l * sc + ls; st.m = mn;
#pragma unroll
    for (int dt = 0; dt < 4; ++dt) O[dt] = O[dt] * sc;
#pragma unroll
    for (int hh = 0; hh < 2; ++hh) { u32x4 w; w.x = pk2(acc[2 * hh][0], acc[2 * hh][1]); w.y = pk2(acc[2 * hh][2], acc[2 * hh][3]); w.z = pk2(acc[2 * hh + 1][0], acc[2 * hh + 1][1]); w.w = pk2(acc[2 * hh + 1][2], acc[2 * hh + 1][3]);
        pB[hh] = __builtin_bit_cast(bf16x8, w); }
}

__device__ __forceinline__ void load_k(bf16x8 (&kf)[4][2], const bf16_t* Kb, int lane) {
#pragma unroll
    for (int nt = 0; nt < 4; ++nt)
#pragma unroll
        for (int kk = 0; kk < 2; ++kk) kf[nt][kk] = *(const bf16x8*)(Kb + ((nt * 2 + kk) * 64 + lane) * 8);
}
__device__ __forceinline__ void load_v(bf16x8 (&vf)[4][2], const bf16_t* Vb, int lane) {
#pragma unroll
    for (int dt = 0; dt < 4; ++dt)
#pragma unroll
        for (int hh = 0; hh < 2; ++hh) vf[dt][hh] = *(const bf16x8*)(Vb + ((dt * 2 + hh) * 64 + lane) * 8);
}
__device__ __forceinline__ void qk_acc(f32x4 (&acc)[4], const bf16x8 (&kf)[4][2], const bf16x8 (&q)[2]) {
#pragma unroll
    for (int nt = 0; nt < 4; ++nt) { acc[nt] = __builtin_amdgcn_mfma_f32_16x16x32_bf16(kf[nt][0], q[0], acc[nt], 0, 0, 0); acc[nt] = __builtin_amdgcn_mfma_f32_16x16x32_bf16(kf[nt][1], q[1], acc[nt], 0, 0, 0); }
}
__device__ __forceinline__ void pv_acc(f32x4 (&O)[4], const bf16x8 (&vf)[4][2], const bf16x8 (&pB)[2]) {
#pragma unroll
    for (int dt = 0; dt < 4; ++dt) { O[dt] = __builtin_amdgcn_mfma_f32_16x16x32_bf16(vf[dt][0], pB[0], O[dt], 0, 0, 0); O[dt] = __builtin_amdgcn_mfma_f32_16x16x32_bf16(vf[dt][1], pB[1], O[dt], 0, 0, 0); }
}


__device__ __forceinline__ void load_kh(bf16x8 (&kf)[2][2], const bf16_t* Kb, int hh, int lane) {
#pragma unroll
    for (int nt = 0; nt < 2; ++nt)
#pragma unroll
        for (int kk = 0; kk < 2; ++kk) kf[nt][kk] = *(const bf16x8*)(Kb + (((2 * hh + nt) * 2 + kk) * 64 + lane) * 8);
}
__device__ __forceinline__ void load_vh(bf16x8 (&vf)[4], const bf16_t* Vb, int hh, int lane) {
#pragma unroll
    for (int dt = 0; dt < 4; ++dt) vf[dt] = *(const bf16x8*)(Vb + ((dt * 2 + hh) * 64 + lane) * 8);
}
__device__ __forceinline__ void qk_acch(f32x4 (&acc)[2], const bf16x8 (&kf)[2][2], const bf16x8 (&q)[2]) {
#pragma unroll
    for (int nt = 0; nt < 2; ++nt) { acc[nt] = __builtin_amdgcn_mfma_f32_16x16x32_bf16(kf[nt][0], q[0], acc[nt], 0, 0, 0); acc[nt] = __builtin_amdgcn_mfma_f32_16x16x32_bf16(kf[nt][1], q[1], acc[nt], 0, 0, 0); }
}
__device__ __forceinline__ void pv_acch(f32x4 (&O)[4], const bf16x8 (&vf)[4], const bf16x8 pB) {
#pragma unroll
    for (int dt = 0; dt < 4; ++dt) O[dt] = __builtin_amdgcn_mfma_f32_16x16x32_bf16(vf[dt], pB, O[dt], 0, 0, 0);
}
__device__ __forceinline__ void softmax_half_far(f32x4 (&acc)[2], const LAS float* lutg, SmState& st, f32x4 (&O)[4]) {
    const float bias = lutg[1023 * 4];
    float mx = -1e30f;
#pragma unroll
    for (int nt = 0; nt < 2; ++nt)
#pragma unroll
        for (int i = 0; i < 4; ++i) { const float lg = acc[nt][i] + bias; acc[nt][i] = lg; mx = fmaxf(mx, lg); }
    mx = fmaxf(mx, __shfl_xor(mx, 16)); mx = fmaxf(mx, __shfl_xor(mx, 32));
    const float mn = fmaxf(st.m, mx);
    const float sc = fexp(st.m - mn);
    float ls = 0.f;
#pragma unroll
    for (int nt = 0; nt < 2; ++nt)
#pragma unroll
        for (int i = 0; i < 4; ++i) { const float p = fexp(acc[nt][i] - mn); acc[nt][i] = p; ls += p; }
    st.l = st.l * sc + ls; st.m = mn;
#pragma unroll
    for (int dt = 0; dt < 4; ++dt) O[dt] = O[dt] * sc;
}
template <int MODE>
__device__ __forceinline__ void softmax_half(f32x4 (&acc)[2], int base, bool ok, int t, int g4, const LAS float* lutg, SmState& st, f32x4 (&O)[4], bf16x8& pB) {
    float mx = -1e30f; unsigned vm = 0u;
#pragma unroll
    for (int nt = 0; nt < 2; ++nt)
#pragma unroll
        for (int i = 0; i < 4; ++i) {
            const int key = base + 16 * nt + 4 * g4 + i;
            const int dist = t - key;
            bool valid = dist >= 0;
            if (MODE == 1) valid = valid && ok;
            if (MODE == 2) valid = valid && dist < 512;
            int dc = dist < 0 ? 0 : dist; dc = dc > 1023 ? 1023 : dc;
            const float lg = acc[nt][i] + lutg[dc * 4];
            acc[nt][i] = lg;
            if (valid) { mx = fmaxf(mx, lg); vm |= 1u << (nt * 4 + i); }
        }
    mx = fmaxf(mx, __shfl_xor(mx, 16)); mx = fmaxf(mx, __shfl_xor(mx, 32));
    const float mn = fmaxf(st.m, mx);
    const float sc = fexp(st.m - mn);
    float ls = 0.f;
#pragma unroll
    for (int nt = 0; nt < 2; ++nt)
#pragma unroll
        for (int i = 0; i < 4; ++i) { const float p = ((vm >> (nt * 4 + i)) & 1u) ? fexp(acc[nt][i] - mn) : 0.f; acc[nt][i] = p; ls += p; }
    st.l = st.l * sc + ls; st.m = mn;
#pragma unroll
    for (int dt = 0; dt < 4; ++dt) O[dt] = O[dt] * sc;
    u32x4 w; w.x = pk2(acc[0][0], acc[0][1]); w.y = pk2(acc[0][2], acc[0][3]); w.z = pk2(acc[1][0], acc[1][1]); w.w = pk2(acc[1][2], acc[1][3]);
    pB = __builtin_bit_cast(bf16x8, w);
}


__device__ __forceinline__ void load_kh8(long (&kf)[2][2], const unsigned char* Kb, int hh, int lane) {
#pragma unroll
    for (int nt = 0; nt < 2; ++nt)
#pragma unroll
        for (int kk = 0; kk < 2; ++kk) kf[nt][kk] = *(const long*)(Kb + (((2 * hh + nt) * 2 + kk) * 64 + lane) * 8);
}
__device__ __forceinline__ void load_vh8(long (&vf)[4], const unsigned char* Vb, int hh, int lane) {
#pragma unroll
    for (int dt = 0; dt < 4; ++dt) vf[dt] = *(const long*)(Vb + ((dt * 2 + hh) * 64 + lane) * 8);
}
__device__ __forceinline__ void qk_acch8(f32x4 (&acc)[2], const long (&kf)[2][2], const long (&q)[2]) {
#pragma unroll
    for (int nt = 0; nt < 2; ++nt) { acc[nt] = __builtin_amdgcn_mfma_f32_16x16x32_fp8_fp8(kf[nt][0], q[0], acc[nt], 0, 0, 0); acc[nt] = __builtin_amdgcn_mfma_f32_16x16x32_fp8_fp8(kf[nt][1], q[1], acc[nt], 0, 0, 0); }
}
__device__ __forceinline__ void pv_acch8(f32x4 (&O)[4], const long (&vf)[4], const long p8) {
#pragma unroll
    for (int dt = 0; dt < 4; ++dt) O[dt] = __builtin_amdgcn_mfma_f32_16x16x32_fp8_fp8(vf[dt], p8, O[dt], 0, 0, 0);
}
constexpr float P8_SCALE = 256.f;
__device__ __forceinline__ long p_to_fp8(const f32x4 (&acc)[2]) {
    return pack8_fp8(acc[0][0] * P8_SCALE, acc[0][1] * P8_SCALE, acc[0][2] * P8_SCALE, acc[0][3] * P8_SCALE, acc[1][0] * P8_SCALE, acc[1][1] * P8_SCALE, acc[1][2] * P8_SCALE, acc[1][3] * P8_SCALE);
}

__device__ __forceinline__ void nsa_wave(CArgs* Ap, int l, int b, int g, int tq0, const LAS float* lut, LAS float* imp, int lane) {
    unsigned char* ws = Ap->ws;
    const bf16_t* P = (const bf16_t*)(ws + p_off(l));
    const bf16_t* KC = (const bf16_t*)(ws + WS_KC + (size_t)l * MiB) + (size_t)(b * 4 + g) * 8 * 4096;
    const bf16_t* VCT = (const bf16_t*)(ws + WS_VCT + (size_t)l * MiB) + (size_t)(b * 4 + g) * 8 * 4096;
    const bf16_t* VST = (const bf16_t*)(ws + vt_off(l)) + (size_t)(b * 4 + g) * 128 * 4096;
    const bf16_t* VWT = (const bf16_t*)(ws + vt_off(l) + 8 * MiB) + (size_t)(b * 4 + g) * 128 * 4096;
    bf16_t* MIX = (bf16_t*)(ws + WS_MIX);
    const int n16 = lane & 15, g4 = lane >> 4, qi = n16 >> 2, r = n16 & 3;
    const int t = tq0 + qi;
    const bf16_t* prow = P + ((size_t)b * SEQ + t) * NINP;
    bf16x8 qB[2];
    qB[0] = *(const bf16x8*)(prow + C_Q + (4 * g + r) * 64 + 8 * g4); qB[1] = *(const bf16x8*)(prow + C_Q + (4 * g + r) * 64 + 8 * g4 + 32);
    float gt[3];
#pragma unroll
    for (int br = 0; br < 3; ++br) gt[br] = sigmoidf_(bf2f(prow[C_GATE + (4 * g + r) * 3 + br]));
    const LAS float* lutg = lut + g * 4096 + r;
    f32x4 outacc[4];
#pragma unroll
    for (int dt = 0; dt < 4; ++dt) outacc[dt] = (f32x4){0.f, 0.f, 0.f, 0.f};
#pragma unroll
    for (int i = 0; i < 8; ++i) *(LAS f32x4*)(imp + (i * 64 + lane) * 4) = (f32x4){0.f, 0.f, 0.f, 0.f};

    const int tmax = tq0 + 3;
    const int ncb = (tmax >= 31) ? ((((tmax - 31) >> 4) >> 6) + 1) : 0;
    {
        SmState st{-1e30f, 0.f};
        f32x4 Od[4];
#pragma unroll
        for (int dt = 0; dt < 4; ++dt) Od[dt] = (f32x4){0.f, 0.f, 0.f, 0.f};
        bf16x8 pB[2];
        for (int cb = 0; cb < ncb; ++cb) {
            bf16x8 kf[4][2]; load_k(kf, KC + (size_t)cb * 4096, lane);
            f32x4 acc[4];
#pragma unroll
            for (int nt = 0; nt < 4; ++nt) acc[nt] = (f32x4){0.f, 0.f, 0.f, 0.f};
            qk_acc(acc, kf, qB);
            softmax_block<0>(acc, cb * 64, true, t, g4, lutg, st, Od, pB);
        }
        float lt = st.l; lt += __shfl_xor(lt, 16); lt += __shfl_xor(lt, 32);
        const float inv = 1.f / fmaxf(lt, 1e-30f), mfin = st.m;
        for (int cb = 0; cb < ncb; ++cb) {
            bf16x8 kf[4][2]; load_k(kf, KC + (size_t)cb * 4096, lane);
            bf16x8 vf[4][2]; load_v(vf, VCT + (size_t)cb * 4096, lane);
            f32x4 acc[4];
#pragma unroll
            for (int nt = 0; nt < 4; ++nt) acc[nt] = (f32x4){0.f, 0.f, 0.f, 0.f};
            qk_acc(acc, kf, qB);
#pragma unroll
            for (int nt = 0; nt < 4; ++nt) {
                f32x4 pi4;
#pragma unroll
                for (int i = 0; i < 4; ++i) {
                    const int key = cb * 64 + 16 * nt + 4 * g4 + i; const int dist = t - (16 * key + 31);
                    int dc = dist < 0 ? 0 : dist; dc = dc > 1023 ? 1023 : dc;
                    const float lg = acc[nt][i] + lutg[dc * 4];
                    float p = (dist >= 0) ? fexp(lg - mfin) * inv : 0.f;
                    acc[nt][i] = p;
                    p += __shfl_xor(p, 1); p += __shfl_xor(p, 2);
                    pi4[i] = p;
                }
                if (r == 0) *(LAS f32x4*)(imp + qi * 512 + cb * 64 + 16 * nt + 4 * g4) = pi4;
            }
#pragma unroll
            for (int hh = 0; hh < 2; ++hh) { u32x4 w; w.x = pk2(acc[2 * hh][0], acc[2 * hh][1]); w.y = pk2(acc[2 * hh][2], acc[2 * hh][3]); w.z = pk2(acc[2 * hh + 1][0], acc[2 * hh + 1][1]); w.w = pk2(acc[2 * hh + 1][2], acc[2 * hh + 1][3]);
                pB[hh] = __builtin_bit_cast(bf16x8, w); }
            pv_acc(outacc, vf, pB);
        }
#pragma unroll
        for (int dt = 0; dt < 4; ++dt) outacc[dt] = outacc[dt] * gt[0];
    }
    wave_lds_fence();

    const int cur = tq0 >> 6;
    int selreg = -1;
    if (cur < 16) selreg = (n16 <= cur) ? n16 : -1;
    else {
        const int sq = lane >> 4, tsel = tq0 + sq; (void)tsel;
        float sc[8];
#pragma unroll
        for (int jj = 0; jj < 8; ++jj) { const int j = n16 + 16 * jj;
            float v;
            if (j > cur) v = -1.f;
            else if (j == 0 || j == cur || j == cur - 1) v = 1e4f;
            else { const LAS float* ip = imp + sq * 512 + 4 * j; v = ip[0] + 2.f * (ip[-1] + ip[-2] + ip[-3]) + ip[-4]; }
            sc[jj] = v; }
        for (int s = 0; s < 16; ++s) {
            float bv = sc[0]; int bj = n16;
#pragma unroll
            for (int jj = 1; jj < 8; ++jj) if (sc[jj] > bv) { bv = sc[jj]; bj = n16 + 16 * jj; }
#pragma unroll
            for (int off = 1; off < 16; off <<= 1) { const float ov = __shfl_xor(bv, off); const int oj = __shfl_xor(bj, off); if (ov > bv || (ov == bv && oj < bj)) { bv = ov; bj = oj; } }
            if (n16 == s) selreg = (bv >= 0.f) ? bj : -1;
#pragma unroll
            for (int jj = 0; jj < 8; ++jj) if (bj == n16 + 16 * jj) sc[jj] = -2.f;
        }
    }
    if (cur >= 16) {
        const int fj = selreg;
        const int key = (fj < 0) ? ((1 << 20) + n16) : ((fj == 0 || fj == cur || fj == cur - 1) ? fj : (1 << 10) + fj);
        int rank = 0;
#pragma unroll
        for (int o = 1; o < 16; ++o) { const int other = __shfl(key, (lane & 48) | ((n16 + o) & 15)); rank += (other < key) ? 1 : 0; }
        selreg = __builtin_amdgcn_ds_permute(((lane & 48) | rank) << 2, fj);
    }
    const int nvalid = (cur + 1) < 16 ? (cur + 1) : 16;
    wave_lds_fence();
#pragma unroll
    for (int dt = 0; dt < 4; ++dt) *(LAS f32x4*)(imp + (dt * 64 + lane) * 4) = outacc[dt];

    {
        SmState st{-1e30f, 0.f};
        f32x4 Od[4];
#pragma unroll
        for (int dt = 0; dt < 4; ++dt) Od[dt] = (f32x4){0.f, 0.f, 0.f, 0.f};
        const unsigned char* Ks8 = (const unsigned char*)(ws + WS_KST) + (size_t)(b * 4 + g) * 128 * 4096;
        const unsigned char* Vs8 = (const unsigned char*)(ws + WS_VST) + (size_t)(b * 4 + g) * 128 * 4096;
        long q8[2];
#pragma unroll
        for (int kk = 0; kk < 2; ++kk) { const u32x4 w = __builtin_bit_cast(u32x4, qB[kk]);
            q8[kk] = pack8_fp8(bflo(w.x), bfhi(w.x), bflo(w.y), bfhi(w.y), bflo(w.z), bfhi(w.z), bflo(w.w), bfhi(w.w)); }
        int ns = 0;
        for (; ns < nvalid; ++ns) { const int j0 = __builtin_amdgcn_readlane(selreg, ns), j1 = __builtin_amdgcn_readlane(selreg, 16 + ns), j2 = __builtin_amdgcn_readlane(selreg, 32 + ns), j3 = __builtin_amdgcn_readlane(selreg, 48 + ns);
            if (!(j0 >= 0 && j0 == j1 && j0 == j2 && j0 == j3)) break; }
        {
            long kh[2][2], vh[4];
            if (ns > 0) { const int j0_ = __builtin_amdgcn_readlane(selreg, 0); load_kh8(kh, Ks8 + (size_t)j0_ * 4096, 0, lane); load_vh8(vh, Vs8 + (size_t)j0_ * 4096, 0, lane); }
            for (int hs = 0; hs < 2 * ns; ++hs) {
                const int s = hs >> 1, hh = hs & 1;
                const int j = __builtin_amdgcn_readlane(selreg, s);
                const bool more = hs + 1 < 2 * ns; const int s1 = (hs + 1) >> 1, h1 = (hs + 1) & 1;
                const int jn = more ? __builtin_amdgcn_readlane(selreg, s1) : 0;
                f32x4 acc[2];
                acc[0] = (f32x4){0.f, 0.f, 0.f, 0.f}; acc[1] = (f32x4){0.f, 0.f, 0.f, 0.f};
                qk_acch8(acc, kh, q8);
                if (more) load_kh8(kh, Ks8 + (size_t)jn * 4096, h1, lane);
                if (__all(t - (j * 64 + 32 * hh + 31) >= 1023)) softmax_half_far(acc, lutg, st, Od);
                else { bf16x8 pB; softmax_half<1>(acc, j * 64 + 32 * hh, true, t, g4, lutg, st, Od, pB); }
                pv_acch8(Od, vh, p_to_fp8(acc));
                if (more) load_vh8(vh, Vs8 + (size_t)jn * 4096, h1, lane);
            }
        }
        const int nh = 2 * nvalid, h0 = 2 * ns;
        long kq[4][2][2], vq[4][4];
        if (h0 < nh) {
#pragma unroll
            for (int q2 = 0; q2 < 4; ++q2) { int j = __builtin_amdgcn_readlane(selreg, 16 * q2 + ns); j = j < 0 ? 0 : j; load_kh8(kq[q2], Ks8 + (size_t)j * 4096, 0, lane); load_vh8(vq[q2], Vs8 + (size_t)j * 4096, 0, lane); } }
        for (int hs = h0; hs < nh; ++hs) {
            const int s = hs >> 1, hh = hs & 1;
            const int jm = __shfl(selreg, 16 * qi + s);
            f32x4 acc[2];
            acc[0] = (f32x4){0.f, 0.f, 0.f, 0.f}; acc[1] = (f32x4){0.f, 0.f, 0.f, 0.f};
#pragma unroll
            for (int q2 = 0; q2 < 4; ++q2) { long qm[2]; qm[0] = (qi == q2) ? q8[0] : 0l; qm[1] = (qi == q2) ? q8[1] : 0l; qk_acch8(acc, kq[q2], qm); }
            const bool more = hs + 1 < nh; const int s1 = (hs + 1) >> 1, h1 = (hs + 1) & 1;
            int jn[4];
#pragma unroll
            for (int q2 = 0; q2 < 4; ++q2) { int j = more ? __builtin_amdgcn_readlane(selreg, 16 * q2 + s1) : 0; jn[q2] = j < 0 ? 0 : j; }
            if (more) {
#pragma unroll
                for (int q2 = 0; q2 < 4; ++q2) load_kh8(kq[q2], Ks8 + (size_t)jn[q2] * 4096, h1, lane); }
            if (__all(jm >= 0 && t - (jm * 64 + 32 * hh + 31) >= 1023)) softmax_half_far(acc, lutg, st, Od);
            else { bf16x8 pB; softmax_half<1>(acc, (jm < 0 ? 0 : jm) * 64 + 32 * hh, jm >= 0, t, g4, lutg, st, Od, pB); }
            const long p8 = p_to_fp8(acc);
#pragma unroll
            for (int q2 = 0; q2 < 4; ++q2) { const long pm = (qi == q2) ? p8 : 0l; pv_acch8(Od, vq[q2], pm); }
            if (more) {
#pragma unroll
                for (int q2 = 0; q2 < 4; ++q2) load_vh8(vq[q2], Vs8 + (size_t)jn[q2] * 4096, h1, lane); }
        }
        float lt = st.l; lt += __shfl_xor(lt, 16); lt += __shfl_xor(lt, 32);
        const float sc = gt[1] / (P8_SCALE * fmaxf(lt, 1e-30f));
#pragma unroll
        for (int dt = 0; dt < 4; ++dt) outacc[dt] = Od[dt] * sc;
    }

    {
        SmState st{-1e30f, 0.f};
        f32x4 Od[4];
#pragma unroll
        for (int dt = 0; dt < 4; ++dt) Od[dt] = (f32x4){0.f, 0.f, 0.f, 0.f};
        const bf16_t* Kw = (const bf16_t*)(ws + WS_KWT) + (size_t)(b * 4 + g) * 128 * 4096;
        const int lo = tq0 - 511, jb0 = (lo > 0 ? lo : 0) >> 6, jb1 = (tq0 + 3) >> 6;
        for (int jb = jb0; jb <= jb1; ++jb) {
            bf16x8 kf[4][2]; load_k(kf, Kw + (size_t)jb * 4096, lane);
            bf16x8 vf[4][2]; load_v(vf, VWT + (size_t)jb * 4096, lane);
            f32x4 acc[4];
#pragma unroll
            for (int nt = 0; nt < 4; ++nt) acc[nt] = (f32x4){0.f, 0.f, 0.f, 0.f};
            qk_acc(acc, kf, qB);
            bf16x8 pB[2];
            softmax_block<2>(acc, jb * 64, true, t, g4, lutg, st, Od, pB);
            pv_acc(Od, vf, pB);
        }
        float lt = st.l; lt += __shfl_xor(lt, 16); lt += __shfl_xor(lt, 32);
        const float sc = gt[2] / fmaxf(lt, 1e-30f);
#pragma unroll
        for (int dt = 0; dt < 4; ++dt) outacc[dt] = outacc[dt] + Od[dt] * sc;
    }
    wave_lds_fence();
#pragma unroll
    for (int dt = 0; dt < 4; ++dt) outacc[dt] = outacc[dt] + *(const LAS f32x4*)(imp + (dt * 64 + lane) * 4);
    bf16_t* orow = MIX + ((size_t)b * SEQ + t) * DM + DSSM + (4 * g + r) * 64 + 4 * g4;
#pragma unroll
    for (int dt = 0; dt < 4; ++dt) { u32x2 w; w.x = pk2(outacc[dt][0], outacc[dt][1]); w.y = pk2(outacc[dt][2], outacc[dt][3]); *(u32x2*)(orow + 16 * dt) = w; }
    wave_lds_fence();
}

__global__ void __launch_bounds__(512, 2) hymba_fwd(Args A_unused) {
    extern __shared__ __attribute__((aligned(16))) unsigned char lds_raw[];
    LAS unsigned char* lds = (LAS unsigned char*)lds_raw;
    cg::grid_group grid = cg::this_grid();
#define GRID_SYNC() do { asm volatile("s_waitcnt vmcnt(0) lgkmcnt(0)" ::: "memory"); grid.sync(); \
    asm volatile("buffer_inv sc1\n\ts_waitcnt vmcnt(0) lgkmcnt(0)" ::: "memory"); } while (0)
    const int wave0 = __builtin_amdgcn_readfirstlane(threadIdx.x >> 6);
#define PHASE_IDS() int wv_ = wave0; asm volatile("" : "+s"(wv_)); int tid; asm volatile("v_mbcnt_lo_u32_b32 %0, -1, 0\n\tv_mbcnt_hi_u32_b32 %0, -1, %0" : "=v"(tid)); tid += wv_ * 64; asm volatile("" : "+v"(tid)); const int lane = tid & 63, wave = __builtin_amdgcn_readfirstlane(tid >> 6); \
    int G = gridDim.x, blk = blockIdx.x; asm volatile("" : "+s"(G), "+s"(blk)); const int gw = blk * 8 + wave, NGW = G * 8; (void)lane; (void)gw; (void)NGW;

    unsigned nsync = 0;
#define FAST_SYNC() do { asm volatile("s_waitcnt vmcnt(0) lgkmcnt(0)" ::: "memory"); __syncthreads(); ++nsync; \
    { int l0_; asm volatile("v_mbcnt_lo_u32_b32 %0, -1, 0\n\tv_mbcnt_hi_u32_b32 %0, -1, %0" : "=v"(l0_)); \
      if (wave0 == 0 && l0_ == 0) { unsigned* bar_ = (unsigned*)(get_args()->ws + WS_CTL); const unsigned tgt_ = nsync * gridDim.x; \
        __builtin_amdgcn_fence(__ATOMIC_RELEASE, "agent"); asm volatile("s_waitcnt vmcnt(0)" ::: "memory"); \
        __hip_atomic_fetch_add(bar_, 1u, __ATOMIC_RELAXED, __HIP_MEMORY_SCOPE_AGENT); \
        for (unsigned sp_ = 0; sp_ < (1u << 22); ++sp_) { if (__hip_atomic_load(bar_, __ATOMIC_RELAXED, __HIP_MEMORY_SCOPE_AGENT) >= tgt_) break; __builtin_amdgcn_s_sleep(2); } } } \
    __syncthreads(); asm volatile("buffer_inv sc1\n\ts_waitcnt vmcnt(0) lgkmcnt(0)" ::: "memory"); } while (0)

    { PHASE_IDS(); if (blk == 0 && tid == 0) __hip_atomic_store((unsigned*)(get_args()->ws + WS_CTL), 0u, __ATOMIC_RELAXED, __HIP_MEMORY_SCOPE_AGENT);
      prologue(lds, wave, lane, gw, NGW); }
    GRID_SYNC();

#pragma nounroll
    for (int l = 0; l < DEPTH; ++l) {
        {
            PHASE_IDS(); CArgs* Ap = get_args(); unsigned char* ws = Ap->ws;
            pg8::Gemm g{(const bf16_t*)(ws + WS_XB), (const bf16_t*)(ws + WS_WIN) + (size_t)l * NINP * DM, MTOK, NINP, DM}; pg8::StaticOrder S; S.init(MTOK, NINP, G, blk);
            const float* rq = (const float*)(ws + WS_RSQ) + (size_t)(2 * l) * RSQ_BUF; LAS float* tab = (LAS float*)(lds + 131072);
            pg8::Unit u0; const int pm0 = S.next(0, u0) ? u0.pm : -1; if (pm0 >= 0) rstd_table(rq, pm0, tab, tid); else __syncthreads();
            EpiInProj E{ws, rq, tab, pm0};
            pg8::gemm_phase<EpiInProj, pg8::StaticOrder, true, true>(lds, g, S, E, tid);
        }
        FAST_SYNC();
        {
            PHASE_IDS(); CArgs* Ap = get_args();
            for (int wt = blk; wt < 256; wt += G) { const int b_ = wt >> 7, cp_ = (wt >> 4) & 7, gq_ = wt & 15;
                s5_task<1>(Ap, l, b_, 4 * gq_ + (wave & 3), 2 * cp_ + (wave >> 2), lds + wave * 8192, lane); }
            if (wave < 2) for (int task = blk * 2 + wave; task < 512; task += G * 2) compress_task(Ap, l, task, lane);
        }
        FAST_SYNC();
        {
            PHASE_IDS(); CArgs* Ap = get_args();
            for (int wt = blk; wt < 256; wt += G) { const int b_ = wt >> 7, cp_ = (wt >> 4) & 7, gq_ = wt & 15;
                s5_task<2>(Ap, l, b_, 4 * gq_ + (wave & 3), 2 * cp_ + (wave >> 2), lds + wave * 8192, lane); }
            __syncthreads();
            LAS float* lut = (LAS float*)lds;
            { const float* tab = Ap->in[1];
              for (int e = tid; e < 4 * 1024 * 4; e += 512) { const int r = e & 3, dist = (e >> 2) & 1023, gg = e >> 12; lut[e] = tab[rel_bucket_i(dist) * 16 + gg * 4 + r]; } }
            __syncthreads();
            LAS float* imp = (LAS float*)(lds + 65536 + wave * 8192);
            for (int i = 0; ; ++i) {
                const int unit = i * G + blk; if (unit >= 2048) break;
                const int bg = unit >> 8; int qt = unit & 255; qt = ((qt & 7) << 5) | (qt >> 3);
                if (i & 1) qt = 255 - qt;
                nsa_wave(Ap, l, bg >> 2, bg & 3, qt * 32 + wave * 4, lut, imp, lane);
            }
            __syncthreads();
        }
        FAST_SYNC();
        {
            PHASE_IDS(); CArgs* Ap = get_args(); unsigned char* ws = Ap->ws;
            pg8::Gemm g{(const bf16_t*)(ws + WS_Y1), (const bf16_t*)(ws + WS_WGLU) + (size_t)l * 2 * DSSM * DSSM, MTOK, 2 * DSSM, DSSM}; pg8::StaticOrder S; S.init(MTOK, 2 * DSSM, G, blk);
            EpiGlu E{(bf16_t*)(ws + WS_MIX), Ap->in[15] + (size_t)l * 2 * DSSM};
            pg8::gemm_phase<EpiGlu, pg8::StaticOrder, true, true>(lds, g, S, E, tid);
        }
        FAST_SYNC();
        {
            PHASE_IDS(); CArgs* Ap = get_args(); unsigned char* ws = Ap->ws;
            pg8::Gemm g{(const bf16_t*)(ws + WS_MIX), (const bf16_t*)(ws + WS_WOUT) + (size_t)l * DM * DM, MTOK, DM, DM}; pg8::StaticOrder S; S.init(MTOK, DM, G, blk);
            EpiResid E{(bf16_t*)(ws + WS_XB), (float*)(ws + WS_RSQ) + (size_t)(2 * l + 1) * RSQ_BUF};
            pg8::gemm_phase<EpiResid, pg8::StaticOrder, true, true>(lds, g, S, E, tid);
        }
        FAST_SYNC();
        {
            PHASE_IDS(); CArgs* Ap = get_args(); unsigned char* ws = Ap->ws;
            pg8::Gemm g{(const bf16_t*)(ws + WS_XB), (const bf16_t*)(ws + WS_WGU) + (size_t)l * 2 * DFF * DM, MTOK, 2 * DFF, DM}; pg8::StaticOrder S; S.init(MTOK, 2 * DFF, G, blk);
            const float* rq = (const float*)(ws + WS_RSQ) + (size_t)(2 * l + 1) * RSQ_BUF; LAS float* tab = (LAS float*)(lds + 131072);
            pg8::Unit u0; const int pm0 = S.next(0, u0) ? u0.pm : -1; if (pm0 >= 0) rstd_table(rq, pm0, tab, tid); else __syncthreads();
            EpiSwiglu E{(bf16_t*)(ws + WS_HID), rq, tab, pm0};
            pg8::gemm_phase<EpiSwiglu, pg8::StaticOrder, true, true>(lds, g, S, E, tid);
        }
        FAST_SYNC();
        {
            PHASE_IDS(); CArgs* Ap = get_args(); unsigned char* ws = Ap->ws;
            pg8::Gemm g{(const bf16_t*)(ws + WS_HID), (const bf16_t*)(ws + WS_WDN) + (size_t)l * DM * DFF, MTOK, DM, DFF}; pg8::StaticOrder S; S.init(MTOK, DM, G, blk);
            EpiResid E{(bf16_t*)(ws + WS_XB), (float*)(ws + WS_RSQ) + (size_t)(2 * l + 2) * RSQ_BUF};
            pg8::gemm_phase<EpiResid, pg8::StaticOrder, true, true>(lds, g, S, E, tid);
        }
        FAST_SYNC();
    }
    {
        PHASE_IDS(); CArgs* Ap = get_args();
        const float* fr = (const float*)(Ap->ws + WS_RSQ) + (size_t)(2 * DEPTH) * RSQ_BUF; const float* gn = Ap->in[4]; float* out = Ap->out;
        for (int m = gw; m < MTOK; m += NGW) {
            const float sq = wave_sum(lane < 32 ? fr[(size_t)lane * MTOK + m] : 0.f);
            const float rstd = rsqrtf(sq * (1.f / DM) + EPS);
            f32x4* xo = (f32x4*)(out + (size_t)m * DM) + lane; const f32x4* gp = (const f32x4*)gn + lane; const u32x2* xb = (const u32x2*)((const bf16_t*)(Ap->ws + WS_XB) + (size_t)m * DM) + lane;
#pragma unroll
            for (int j = 0; j < 8; ++j) { const u32x2 q = xb[64 * j]; f32x4 v = (f32x4){bflo(q.x), bfhi(q.x), bflo(q.y), bfhi(q.y)}; const f32x4 gg = gp[64 * j]; v = v * rstd * gg; __builtin_nontemporal_store(v, &xo[64 * j]); }
        }
    }
}

extern "C" void kernel_launch(void* const* d_in, const int* in_sizes, int n_in, void* d_out, int out_size, void* d_ws, size_t ws_size, hipStream_t stream) {
    static int grid = 0;
    if (grid == 0) {
        if (n_in != 26 || ws_size < WS_END) { fprintf(stderr, "kernel_launch: unexpected inputs (n_in %d, ws %zu, need %zu)\n", n_in, ws_size, (size_t)WS_END); grid = -1; return; }
        int dev = 0, cus = 0, per_cu = 0;
        hipGetDevice(&dev); hipDeviceGetAttribute(&cus, hipDeviceAttributeMultiprocessorCount, dev);
        hipFuncSetAttribute((const void*)hymba_fwd, hipFuncAttributeMaxDynamicSharedMemorySize, LDS_BYTES);
        hipOccupancyMaxActiveBlocksPerMultiprocessor(&per_cu, (const void*)hymba_fwd, 512, LDS_BYTES);
        if (per_cu < 1) { fprintf(stderr, "kernel_launch: occupancy query says %d blocks per CU\n", per_cu); per_cu = 1; }
        grid = cus * 1;
        (void)hipGetLastError();
    }
    if (grid < 0) return;
    Args a{};
    for (int i = 0; i < 26; ++i) a.in[i] = (const float*)d_in[i];
    a.out = (float*)d_out; a.ws = (unsigned char*)d_ws;
    void* args[] = {&a};
    hipError_t e = hipLaunchCooperativeKernel((const void*)hymba_fwd, dim3(grid), dim3(512), args, LDS_BYTES, stream);
    if (e != hipSuccess) fprintf(stderr, "cooperative launch failed: %s (grid %d)\n", hipGetErrorString(e), grid);
}
```

```cpp
#include <hip/hip_runtime.h>
#include <hip/hip_cooperative_groups.h>
#include <cstdio>
#include <cstdint>
namespace cg = cooperative_groups;

#define LAS __attribute__((address_space(3)))
typedef unsigned short bf16_t;
typedef short bf16x8 __attribute__((ext_vector_type(8)));
typedef short s16x4 __attribute__((ext_vector_type(4)));
typedef float f32x4 __attribute__((ext_vector_type(4)));
typedef float f32x2 __attribute__((ext_vector_type(2)));
typedef unsigned u32x4 __attribute__((ext_vector_type(4)));
typedef unsigned u32x2 __attribute__((ext_vector_type(2)));

constexpr int NB = 2, SEQ = 8192, MTOK = NB * SEQ, DM = 2048, DEPTH = 4;
constexpr int NIN = 3632, NINP = 3840;
constexpr int DSSM = 1024, NGRP = 64, NST = 64;
constexpr int NKV = 4, HD = 64;
constexpr int DFF = 5632;
constexpr int NCHUNK = 16, CHUNK = SEQ / NCHUNK;
constexpr float EPS = 1e-6f;
constexpr int C_Q = 1024, C_KC = 2048, C_VC = 2304, C_KS = 2560, C_KW = 3072, C_GATE = 3584;

constexpr size_t MiB = 1u << 20;
constexpr size_t WS_CTL = 0;
constexpr size_t WS_WIN = 1 * MiB;
constexpr size_t WS_WGLU = WS_WIN + 60 * MiB;
constexpr size_t WS_WOUT = WS_WGLU + 16 * MiB;
constexpr size_t WS_WGU = WS_WOUT + 32 * MiB;
constexpr size_t WS_WDN = WS_WGU + 176 * MiB;
constexpr size_t WS_CW1 = WS_WDN + 88 * MiB;
constexpr size_t WS_CW2 = WS_CW1 + 4 * MiB;
constexpr size_t WS_XB = WS_CW2 + 1 * MiB;
constexpr size_t WS_P = WS_XB + 64 * MiB;
constexpr size_t WS_Y1 = WS_P + 120 * MiB;
constexpr size_t WS_MIX = WS_Y1 + 32 * MiB;
constexpr size_t WS_HID = WS_P;
constexpr size_t WS_VST = WS_MIX + 64 * MiB;
constexpr size_t WS_VWT = WS_VST + 8 * MiB;
constexpr size_t WS_KC = WS_VWT + 8 * MiB;
constexpr size_t WS_VCT = WS_KC + 4 * MiB;
constexpr size_t WS_SST = WS_VCT + 4 * MiB;
constexpr size_t WS_RSQ = WS_SST + 4 * MiB;
constexpr size_t WS_P1 = WS_RSQ + 18 * MiB;
constexpr size_t WS_VT1 = WS_P1 + 120 * MiB;
constexpr size_t WS_END = WS_P1 + 16 * MiB;
__host__ __device__ __forceinline__ size_t p_off(int) { return WS_P; }
__host__ __device__ __forceinline__ size_t vt_off(int) { return WS_VST; }
constexpr size_t WS_KST = WS_P1;
constexpr size_t WS_KWT = WS_P1 + 8 * MiB;
constexpr size_t RSQ_BUF = (size_t)32 * MTOK;

constexpr int LDS_BYTES = 135168;

namespace pg8 {
constexpr int BM = 256, BK = 64, HALF = 128, HTB = HALF * BK * 2, STAGE_BYTES = 8 * HTB, NXCD = 8, WGM = 8;
__host__ __device__ __forceinline__ int lds_byte(int r, int c) { const int st = (r >> 4) * 2 + (c >> 5), rr = r & 15, cc = c & 31, ob = rr * 64 + cc * 2; return st * 1024 + (ob ^ (((ob >> 9) & 1) << 5)); }
__host__ __device__ __forceinline__ void stage_rc(int b, int& R, int& C) { const int st = b / 1024, sb = b % 1024, swz = sb ^ (((sb >> 9) & 1) << 5); R = (st >> 1) * 16 + swz / 64; C = (st & 1) * 32 + (swz % 64) / 2; }
struct Unit { int pm, pn; };
struct Gemm { const bf16_t* A; const bf16_t* Bt; int M, N, K; };
struct StaticOrder {
    int nM, nN, nwg, G, c;
    __host__ __device__ void init(int M, int N, int G_, int c_) { nM = M / BM; nN = N / BM; nwg = nM * nN; G = G_; c = c_; }
    __host__ __device__ bool next(int i, Unit& u) const {
        const long L = (long)i * G + c; if (L >= nwg) return false;
        int wgid = (int)L; { const int q = nwg / NXCD, r = nwg % NXCD, xcd = wgid % NXCD, off = wgid / NXCD; wgid = (xcd < r ? xcd * (q + 1) : r * (q + 1) + (xcd - r) * q) + off; }
        const int nig = WGM * nN, gid = wgid / nig, fm = gid * WGM, gsz = (nM - fm) < WGM ? (nM - fm) : WGM;
        u.pm = fm + ((wgid % nig) % gsz); u.pn = (wgid % nig) / gsz; return true;
    }
};
typedef float f32x2_cv __attribute__((ext_vector_type(2))); typedef __bf16 bf16x2_cv __attribute__((ext_vector_type(2)));
__device__ __forceinline__ unsigned cvt_pk_bf16(float lo, float hi) { const f32x2_cv v = {lo, hi}; const bf16x2_cv b = __builtin_convertvector(v, bf16x2_cv); return __builtin_bit_cast(unsigned, b); }

template <class Epi, class Sched, bool ALIGN_EPI = false, bool SP2 = false>
__device__ __forceinline__ void gemm_phase(LAS unsigned char* lds, const Gemm g, const Sched& S, const Epi& E, const int tid) {
    const int wid = __builtin_amdgcn_readfirstlane(tid >> 6), lane = tid & 63, wr = wid >> 2, wc = wid & 3, fr = lane & 15, fq = lane >> 4;
    const int K = g.K, nt = K / BK;
    unsigned voffA[2], voffB[2];
#pragma unroll
    for (int i = 0; i < 2; ++i) { int R, C; stage_rc(tid * 16 + i * 8192, R, C); voffA[i] = (unsigned)(R * K + C) * 2u; voffB[i] = voffA[i]; }
    const size_t kstep = (size_t)(BK * 2);
    const size_t hstep = (size_t)HALF * K * 2;
    const size_t tstep = 2 * hstep;
    const unsigned ldsw = (unsigned)wid * 1024u;
    const int aoff = lds_byte(wr * 64 + fr, fq * 8), boff = lds_byte(wc * 32 + fr, fq * 8);
#define PG8_SA(b, h) (((b) * 2 + (h)) * HTB)
#define PG8_SB(b, h) ((4 + (b) * 2 + (h)) * HTB)
#define PG8_STAGE(bufoff, gbase, voff) do { _Pragma("unroll") for (int _i = 0; _i < 2; ++_i) \
        __builtin_amdgcn_global_load_lds((const unsigned*)((const char*)(gbase) + (voff)[_i]), (LAS unsigned*)(lds + (bufoff) + ldsw + _i * 8192), 16, 0, 0); } while (0)
#define PG8_LDA(dst, b, h) do { _Pragma("unroll") for (int m = 0; m < 4; ++m) _Pragma("unroll") for (int k = 0; k < 2; ++k) dst[m][k] = *(const LAS bf16x8*)(lds + PG8_SA(b, h) + aoff + m * 2048 + k * 1024); } while (0)
#define PG8_LDB(dst, b, h) do { _Pragma("unroll") for (int n = 0; n < 2; ++n) _Pragma("unroll") for (int k = 0; k < 2; ++k) dst[n][k] = *(const LAS bf16x8*)(lds + PG8_SB(b, h) + boff + n * 2048 + k * 1024); } while (0)
#define PG8_MMA(ai, bj, At, Bt) do { __builtin_amdgcn_s_setprio(1); _Pragma("unroll") for (int m = 0; m < 4; ++m) _Pragma("unroll") for (int n = 0; n < 2; ++n) _Pragma("unroll") for (int k = 0; k < 2; ++k) \
        acc[ai][bj][m][n] = __builtin_amdgcn_mfma_f32_16x16x32_bf16(Bt[n][k], At[m][k], acc[ai][bj][m][n], 0, 0, 0); __builtin_amdgcn_s_setprio(0); } while (0)
#define PG8_WAIT_V(n) asm volatile("s_waitcnt vmcnt(" #n ")" ::: "memory")
#define PG8_WAIT_L(n) asm volatile("s_waitcnt lgkmcnt(" #n ")" ::: "memory")
#define PG8_BAR __builtin_amdgcn_s_barrier()
#define PG8_SCHED __builtin_amdgcn_sched_barrier(0)
    Unit cur, nxt; int ui = 0;
    if (!S.next(0, cur)) return;
    f32x4 acc[2][2][4][2];
#pragma unroll
    for (int a = 0; a < 2; ++a)
#pragma unroll
        for (int b = 0; b < 2; ++b)
#pragma unroll
            for (int m = 0; m < 4; ++m)
#pragma unroll
                for (int n = 0; n < 2; ++n) acc[a][b][m][n] = (f32x4){0.f, 0.f, 0.f, 0.f};
    bf16x8 At[4][2], B0[2][2], B1[2][2];
    const char* cA = (const char*)g.A + (size_t)cur.pm * tstep; const char* cB = (const char*)g.Bt + (size_t)cur.pn * tstep;
    if constexpr (SP2) {
        PG8_STAGE(PG8_SB(0, 0), cB, voffB); PG8_STAGE(PG8_SB(0, 1), cB + hstep, voffB); PG8_STAGE(PG8_SA(0, 0), cA, voffA); PG8_STAGE(PG8_SA(0, 1), cA + hstep, voffA);
        if (wr == 1) PG8_BAR;
        PG8_WAIT_V(2); PG8_BAR;
        PG8_STAGE(PG8_SB(1, 0), cB + kstep, voffB); PG8_STAGE(PG8_SA(1, 0), cA + kstep, voffA); PG8_STAGE(PG8_SB(1, 1), cB + hstep + kstep, voffB);
        PG8_WAIT_V(6); PG8_BAR;
    } else {
        PG8_STAGE(PG8_SB(0, 0), cB, voffB); PG8_STAGE(PG8_SA(0, 0), cA, voffA); PG8_STAGE(PG8_SB(0, 1), cB + hstep, voffB); PG8_STAGE(PG8_SA(0, 1), cA + hstep, voffA);
        if (wr == 1) PG8_BAR;
        PG8_WAIT_V(4); PG8_BAR;
        PG8_STAGE(PG8_SB(1, 0), cB + kstep, voffB); PG8_STAGE(PG8_SA(1, 0), cA + kstep, voffA); PG8_STAGE(PG8_SB(1, 1), cB + hstep + kstep, voffB);
        PG8_WAIT_V(6); PG8_BAR;
    }
    for (;;) {
        const bool has_next = S.next(ui + 1, nxt);
        const char* nA = has_next ? (const char*)g.A + (size_t)nxt.pm * tstep : cA; const char* nB = has_next ? (const char*)g.Bt + (size_t)nxt.pn * tstep : cB;
        for (int t = 0; t < nt; t += 2) {
            const bool last = (t == nt - 2);
            const char* a1 = cA + (size_t)(t + 1) * kstep;
            const char* a2 = last ? nA : cA + (size_t)(t + 2) * kstep; const char* b2 = last ? nB : cB + (size_t)(t + 2) * kstep;
            const char* a3 = a2 + kstep; const char* b3 = b2 + kstep;
            if constexpr (SP2) {
            PG8_LDB(B0, 0, 0); PG8_LDB(B1, 0, 1); PG8_SCHED; PG8_LDA(At, 0, 0); PG8_STAGE(PG8_SA(1, 1), a1 + hstep, voffA);
            PG8_WAIT_V(8); PG8_WAIT_L(0); PG8_BAR; PG8_MMA(0, 0, At, B0); PG8_MMA(0, 1, At, B1); PG8_BAR; PG8_SCHED;
            PG8_LDA(At, 0, 1); PG8_STAGE(PG8_SB(0, 0), b2, voffB); PG8_STAGE(PG8_SB(0, 1), b2 + hstep, voffB); PG8_STAGE(PG8_SA(0, 0), a2, voffA);
            PG8_WAIT_V(8); PG8_WAIT_L(0); PG8_BAR; PG8_MMA(1, 0, At, B0); PG8_MMA(1, 1, At, B1); PG8_BAR; PG8_SCHED;
            PG8_LDB(B0, 1, 0); PG8_LDB(B1, 1, 1); PG8_SCHED; PG8_LDA(At, 1, 0); PG8_STAGE(PG8_SA(0, 1), a2 + hstep, voffA);
            PG8_WAIT_V(8); PG8_WAIT_L(0); PG8_BAR; PG8_MMA(0, 0, At, B0); PG8_MMA(0, 1, At, B1); PG8_BAR; PG8_SCHED;
            PG8_LDA(At, 1, 1); PG8_STAGE(PG8_SB(1, 0), b3, voffB); PG8_STAGE(PG8_SB(1, 1), b3 + hstep, voffB); PG8_STAGE(PG8_SA(1, 0), a3, voffA);
            PG8_WAIT_V(8); PG8_WAIT_L(0); PG8_BAR; PG8_MMA(1, 0, At, B0); PG8_MMA(1, 1, At, B1); PG8_BAR; PG8_SCHED;
            } else {
            PG8_LDB(B0, 0, 0); PG8_SCHED; PG8_LDA(At, 0, 0); PG8_STAGE(PG8_SA(1, 1), a1 + hstep, voffA);
            PG8_WAIT_L(8); PG8_BAR; PG8_WAIT_L(0); PG8_MMA(0, 0, At, B0); PG8_BAR; PG8_SCHED;
            PG8_LDB(B1, 0, 1); PG8_STAGE(PG8_SB(0, 0), b2, voffB);
            PG8_BAR; PG8_WAIT_L(0); PG8_MMA(0, 1, At, B1); PG8_BAR;
            PG8_LDA(At, 0, 1); PG8_STAGE(PG8_SA(0, 0), a2, voffA);
            PG8_BAR; PG8_WAIT_L(0); PG8_MMA(1, 0, At, B0); PG8_BAR; PG8_SCHED;
            PG8_STAGE(PG8_SB(0, 1), b2 + hstep, voffB);
            PG8_WAIT_V(6); PG8_BAR; PG8_MMA(1, 1, At, B1); PG8_BAR;
            PG8_LDB(B0, 1, 0); PG8_SCHED; PG8_LDA(At, 1, 0); PG8_STAGE(PG8_SA(0, 1), a2 + hstep, voffA);
            PG8_WAIT_L(8); PG8_BAR; PG8_WAIT_L(0); PG8_MMA(0, 0, At, B0); PG8_BAR; PG8_SCHED;
            PG8_LDB(B1, 1, 1); PG8_STAGE(PG8_SB(1, 0), b3, voffB);
            PG8_BAR; PG8_WAIT_L(0); PG8_MMA(0, 1, At, B1); PG8_BAR;
            PG8_LDA(At, 1, 1); PG8_STAGE(PG8_SA(1, 0), a3, voffA);
            PG8_BAR; PG8_WAIT_L(0); PG8_MMA(1, 0, At, B0); PG8_BAR; PG8_SCHED;
            PG8_STAGE(PG8_SB(1, 1), b3 + hstep, voffB);
            PG8_WAIT_V(6); PG8_BAR; PG8_MMA(1, 1, At, B1); PG8_BAR;
            }
        }
        if constexpr (ALIGN_EPI) { if (wr == 0) PG8_BAR; }
        E(acc, cur, wr, wc, fr, fq);
        if (!has_next) break;
#pragma unroll
        for (int a = 0; a < 2; ++a)
#pragma unroll
            for (int b = 0; b < 2; ++b)
#pragma unroll
                for (int m = 0; m < 4; ++m)
#pragma unroll
                    for (int n = 0; n < 2; ++n) acc[a][b][m][n] = (f32x4){0.f, 0.f, 0.f, 0.f};
        cur = nxt; cA = nA; cB = nB; ++ui;
        if constexpr (ALIGN_EPI) { if (wr == 1) PG8_BAR; }
    }
    PG8_WAIT_V(0);
    if constexpr (!ALIGN_EPI) { if (wr == 0) PG8_BAR; }
    PG8_BAR;
#undef PG8_SA
#undef PG8_SB
#undef PG8_STAGE
#undef PG8_LDA
#undef PG8_LDB
#undef PG8_MMA
#undef PG8_WAIT_V
#undef PG8_WAIT_L
#undef PG8_BAR
#undef PG8_SCHED
}
}

__device__ __forceinline__ unsigned pk2(float lo, float hi) { return pg8::cvt_pk_bf16(lo, hi); }
__device__ __forceinline__ bf16_t f2bf(float f) { return (bf16_t)(pk2(f, f) & 0xffffu); }
__device__ __forceinline__ float bf2f(bf16_t h) { return __uint_as_float(((unsigned)h) << 16); }
__device__ __forceinline__ float bflo(unsigned w) { return __uint_as_float(w << 16); }
__device__ __forceinline__ float bfhi(unsigned w) { return __uint_as_float(w & 0xffff0000u); }
__device__ __forceinline__ float fexp(float x) { return __expf(x); }
__device__ __forceinline__ float sigmoidf_(float x) { return __builtin_amdgcn_rcpf(1.f + fexp(-x)); }
__device__ __forceinline__ float gelu_tanh(float x) { const float z = 0.7978845608f * (x + 0.044715f * x * x * x); const float e = fexp(2.f * z); const float th = 1.f - 2.f * __builtin_amdgcn_rcpf(e + 1.f); return 0.5f * x * (1.f + th); }
__device__ __forceinline__ int vperm(int k) { return (k & 32) | (((k & 15) >> 2) << 3) | (k & 3) | (((k >> 4) & 1) << 2); }
__device__ __forceinline__ int kswz(int key, int d) { return ((((key >> 4) * 2 + (d >> 5)) * 64) + ((d >> 3) & 3) * 16 + (key & 15)) * 8 + (d & 7); }
__device__ __forceinline__ int vswz(int d, int key) { const int k = key & 31; return ((((d >> 4) * 2 + (key >> 5)) * 64) + ((k & 15) >> 2) * 16 + (d & 15)) * 8 + (k & 3) + 4 * (k >> 4); }
__device__ __forceinline__ void wave_lds_fence() { asm volatile("s_waitcnt lgkmcnt(0)" ::: "memory"); }
__device__ __forceinline__ float wave_sum(float v) {
#pragma unroll
    for (int o = 1; o < 64; o <<= 1) v += __shfl_xor(v, o);
    return v;
}
__device__ __forceinline__ bf16x8 zero8() { return (bf16x8){0, 0, 0, 0, 0, 0, 0, 0}; }

__device__ __forceinline__ long pack8_fp8(float a0, float a1, float a2, float a3, float a4, float a5, float a6, float a7) {
    int lo = 0, hi = 0;
    lo = __builtin_amdgcn_cvt_pk_fp8_f32(a0, a1, lo, false); lo = __builtin_amdgcn_cvt_pk_fp8_f32(a2, a3, lo, true);
    hi = __builtin_amdgcn_cvt_pk_fp8_f32(a4, a5, hi, false); hi = __builtin_amdgcn_cvt_pk_fp8_f32(a6, a7, hi, true);
    return (long)(((unsigned long long)(unsigned)hi << 32) | (unsigned long long)(unsigned)lo);
}
__device__ __forceinline__ unsigned pack4_fp8(float a0, float a1, float a2, float a3) {
    int lo = 0; lo = __builtin_amdgcn_cvt_pk_fp8_f32(a0, a1, lo, false); lo = __builtin_amdgcn_cvt_pk_fp8_f32(a2, a3, lo, true); return (unsigned)lo;
}
__device__ __forceinline__ void rstd_table(const float* part, int pm, LAS float* tab, int tid) {
    const int row = tid >> 1, hf = tid & 1; float s = 0.f;
#pragma unroll
    for (int k = 0; k < 16; ++k) s += part[(size_t)(hf * 16 + k) * MTOK + pm * 256 + row];
    s += __shfl_xor(s, 1);
    if (hf == 0) tab[row] = rsqrtf(s * (1.f / DM) + EPS);
    __syncthreads();
}
__device__ __forceinline__ float row_rstd(const float* part, int r, int fq) {
    float s = 0.f;
#pragma unroll
    for (int k = 0; k < 8; ++k) s += part[(size_t)(fq * 8 + k) * MTOK + r];
    s += __shfl_xor(s, 16); s += __shfl_xor(s, 32);
    return rsqrtf(s * (1.f / DM) + EPS);
}
struct EpiInProj {
    unsigned char* wsb; const float* rowsq; const LAS float* tab; int tab_pm;
    __device__ __forceinline__ float rs(int r, int fq) const { return (r >> 8) == tab_pm ? tab[r & 255] : row_rstd(rowsq, r, fq); }
    __device__ __forceinline__ void operator()(const f32x4 (&acc)[2][2][4][2], const pg8::Unit& u, int wr, int wc, int fr, int fq) const {
        const int row0 = u.pm * 256 + wr * 64 + fr;
        const bool tr = (u.pn >= 10 && u.pn <= 13);
        if (!tr) {
            bf16_t* P = (bf16_t*)(wsb + WS_P);
#pragma unroll
            for (int ai = 0; ai < 2; ++ai)
#pragma unroll
                for (int m = 0; m < 4; ++m) {
                    const int r = row0 + ai * 128 + m * 16;
                    const float rstd = rs(r, fq);
                    bf16_t* rowp = P + (size_t)r * NINP + u.pn * 256 + wc * 32 + 8 * fq;
#pragma unroll
                    for (int bj = 0; bj < 2; ++bj) { const f32x4 v0 = acc[ai][bj][m][0] * rstd, v1 = acc[ai][bj][m][1] * rstd;
                        u32x4 w; w.x = pk2(v0[0], v0[1]); w.y = pk2(v0[2], v0[3]); w.z = pk2(v1[0], v1[1]); w.w = pk2(v1[2], v1[3]); *(u32x4*)(rowp + bj * 128) = w; }
                }
        } else {
            const bool isv = (u.pn & 1); const bool sel8 = (u.pn < 12);
            bf16_t* BT = (bf16_t*)(wsb + ((u.pn == 10) ? WS_KST : (u.pn == 11) ? WS_VST : (u.pn == 12) ? WS_KWT : WS_VWT));
            const int b = u.pm >> 5, blk0 = (u.pm & 31) * 4 + wr;
            const int lk = (((fq >> 1) * 16 + fr) * 8) + 4 * (fq & 1);
            const int lv = (((fr >> 2) * 16 + 4 * fq) * 8) + (fr & 3);
#pragma unroll
            for (int ai = 0; ai < 2; ++ai)
#pragma unroll
                for (int m = 0; m < 4; ++m) {
                    const int r = row0 + ai * 128 + m * 16;
                    const float rstd = rs(r, fq);
#pragma unroll
                    for (int bj = 0; bj < 2; ++bj) {
                        bf16_t* blkp = BT + (size_t)((b * 4 + 2 * bj + (wc >> 1)) * 128 + blk0 + 2 * ai) * 4096;
#pragma unroll
                        for (int n = 0; n < 2; ++n) { const f32x4 v = acc[ai][bj][m][n] * rstd;
                            if (sel8) {
                                unsigned char* blk8 = (unsigned char*)BT + (size_t)((b * 4 + 2 * bj + (wc >> 1)) * 128 + blk0 + 2 * ai) * 4096;
                                if (!isv) *(unsigned*)(blk8 + ((m * 2 + (wc & 1)) * 64 + 2 * n * 16) * 8 + lk) = pack4_fp8(v[0], v[1], v[2], v[3]);
                                else { unsigned char* vp = blk8 + ((((wc & 1) * 2 + n) * 2 + (m >> 1)) * 64) * 8 + 4 * (m & 1) + lv; const unsigned w4 = pack4_fp8(v[0], v[1], v[2], v[3]);
#pragma unroll
                                    for (int i = 0; i < 4; ++i) vp[8 * i] = (unsigned char)(w4 >> (8 * i)); }
                            } else
                            if (!isv) { u32x2 w; w.x = pk2(v[0], v[1]); w.y = pk2(v[2], v[3]); *(u32x2*)(blkp + ((m * 2 + (wc & 1)) * 64 + 2 * n * 16) * 8 + lk) = w; }
                            else { bf16_t* vp = blkp + ((((wc & 1) * 2 + n) * 2 + (m >> 1)) * 64) * 8 + 4 * (m & 1) + lv;
#pragma unroll
                                for (int i = 0; i < 4; ++i) vp[8 * i] = f2bf(v[i]); } }
                    }
                }
        }
    }
};
struct EpiGlu {
    bf16_t* MIX; const float* bias;
    __device__ __forceinline__ void operator()(const f32x4 (&acc)[2][2][4][2], const pg8::Unit& u, int wr, int wc, int fr, int fq) const {
        const int row0 = u.pm * 256 + wr * 64 + fr;
#pragma unroll
        for (int bj = 0; bj < 2; ++bj) {
            const int j0 = u.pn * 128 + bj * 64 + wc * 16 + 4 * fq;
            const f32x4 ba = *(const f32x4*)(bias + j0), bb = *(const f32x4*)(bias + DSSM + j0);
#pragma unroll
            for (int ai = 0; ai < 2; ++ai)
#pragma unroll
                for (int m = 0; m < 4; ++m) {
                    const int r = row0 + ai * 128 + m * 16;
                    const f32x4 a = acc[ai][bj][m][0] + ba, b = acc[ai][bj][m][1] + bb;
                    float o[4];
#pragma unroll
                    for (int i = 0; i < 4; ++i) o[i] = a[i] * sigmoidf_(b[i]);
                    u32x2 w; w.x = pk2(o[0], o[1]); w.y = pk2(o[2], o[3]);
                    *(u32x2*)(MIX + (size_t)r * DM + j0) = w;
                }
        }
    }
};
struct EpiResid {
    bf16_t* XB; float* rowsq;
    __device__ __forceinline__ void operator()(const f32x4 (&acc)[2][2][4][2], const pg8::Unit& u, int wr, int wc, int fr, int fq) const {
        const int row0 = u.pm * 256 + wr * 64 + fr; const int col0 = u.pn * 256 + wc * 32 + 8 * fq;
#pragma unroll
        for (int ai = 0; ai < 2; ++ai)
#pragma unroll
            for (int m = 0; m < 4; ++m) {
                const int r = row0 + ai * 128 + m * 16; float ss = 0.f;
#pragma unroll
                for (int bj = 0; bj < 2; ++bj) {
                    const size_t off = (size_t)r * DM + col0 + bj * 128;
                    const u32x4 old = *(const u32x4*)(XB + off);
                    const f32x4 x0 = (f32x4){bflo(old.x), bfhi(old.x), bflo(old.y), bfhi(old.y)} + acc[ai][bj][m][0];
                    const f32x4 x1 = (f32x4){bflo(old.z), bfhi(old.z), bflo(old.w), bfhi(old.w)} + acc[ai][bj][m][1];
                    u32x4 w; w.x = pk2(x0[0], x0[1]); w.y = pk2(x0[2], x0[3]); w.z = pk2(x1[0], x1[1]); w.w = pk2(x1[2], x1[3]); *(u32x4*)(XB + off) = w;
                    ss += ((x0[0] * x0[0] + x0[1] * x0[1]) + (x0[2] * x0[2] + x0[3] * x0[3])) + ((x1[0] * x1[0] + x1[1] * x1[1]) + (x1[2] * x1[2] + x1[3] * x1[3]));
                }
                ss += __shfl_xor(ss, 16); ss += __shfl_xor(ss, 32);
                if (fq == 0) rowsq[(size_t)(u.pn * 4 + wc) * MTOK + r] = ss;
            }
    }
};
struct EpiSwiglu {
    bf16_t* HID; const float* rowsq; const LAS float* tab; int tab_pm;
    __device__ __forceinline__ float rs(int r, int fq) const { return (r >> 8) == tab_pm ? tab[r & 255] : row_rstd(rowsq, r, fq); }
    __device__ __forceinline__ void operator()(const f32x4 (&acc)[2][2][4][2], const pg8::Unit& u, int wr, int wc, int fr, int fq) const {
        const int row0 = u.pm * 256 + wr * 64 + fr;
#pragma unroll
        for (int ai = 0; ai < 2; ++ai)
#pragma unroll
            for (int m = 0; m < 4; ++m) {
                const int r = row0 + ai * 128 + m * 16;
                const float rstd = rs(r, fq);
                float o[2][4];
#pragma unroll
                for (int bj = 0; bj < 2; ++bj) {
                    const f32x4 gv = acc[ai][bj][m][0] * rstd, uv = acc[ai][bj][m][1] * rstd;
#pragma unroll
                    for (int i = 0; i < 4; ++i) o[bj][i] = gv[i] * sigmoidf_(gv[i]) * uv[i];
                }
                const int j0 = u.pn * 128 + wc * 32 + 8 * fq;
                u32x4 w; w.x = pk2(o[0][0], o[0][1]); w.y = pk2(o[0][2], o[0][3]); w.z = pk2(o[1][0], o[1][1]); w.w = pk2(o[1][2], o[1][3]);
                *(u32x4*)(HID + (size_t)r * DFF + j0) = w;
            }
    }
};

__device__ __forceinline__ void transpose_item(const float* W, int K, int N, bf16_t* WT, int mode, const float* gain, LAS float* scr, int item, int lane) {
    const int nblk = (N + 31) / 32, kb = item / nblk, nb = item % nblk, k0 = 64 * kb, n0 = 32 * nb;
    const int nn = n0 + (lane & 31);
    float cs = 1.f; if (mode == 4 && nn >= C_Q && nn < C_KC) cs = 0.125f;
#pragma unroll
    for (int i = 0; i < 32; ++i) { const int kk = 2 * i + (lane >> 5);
        float v = (nn < N) ? __builtin_nontemporal_load(&W[(size_t)(k0 + kk) * N + nn]) : 0.f;
        if (gain) v *= gain[k0 + kk];
        scr[kk * 33 + (lane & 31)] = v * cs; }
    wave_lds_fence();
    const int c = lane & 7;
#pragma unroll
    for (int j = 0; j < 4; ++j) { const int n = (lane >> 3) + 8 * j; const LAS float* s = scr + (8 * c) * 33 + n;
        u32x4 o; o.x = pk2(s[0 * 33], s[1 * 33]); o.y = pk2(s[2 * 33], s[3 * 33]); o.z = pk2(s[4 * 33], s[5 * 33]); o.w = pk2(s[6 * 33], s[7 * 33]);
        const int ng = n0 + n; int dest = ng;
        if (mode == 1) { const int hf = ng >= DSSM, jj = ng - DSSM * hf; dest = (jj >> 4) * 32 + 16 * hf + (jj & 15); }
        else if (mode == 5 || (mode == 4 && ((ng >> 8) < 10 || (ng >> 8) > 13))) { const int c32 = ng & 31; dest = (ng & ~31) + 16 * ((c32 >> 2) & 1) + 4 * (c32 >> 3) + (c32 & 3); }
        else if (mode == 2 || mode == 3) { const int jl = ng & 127; dest = (ng >> 7) * 256 + 128 * ((jl >> 2) & 1) + 32 * (jl >> 5) + 16 * (mode - 2) + 4 * ((jl >> 3) & 3) + (jl & 3); }
        *(u32x4*)(WT + (size_t)dest * K + k0 + 8 * c) = o; }
    wave_lds_fence();
}

struct Args {
    const float* in[26];
    float* out; unsigned char* ws;
};
typedef const Args __attribute__((address_space(4))) CArgs;
__device__ __forceinline__ CArgs* get_args() { CArgs* p = (CArgs*)__builtin_amdgcn_kernarg_segment_ptr(); asm volatile("" : "+s"(p)); return p; }

constexpr int IT_WIN = 32 * 114, IT_GLU = 16 * 64, IT_OUT = 32 * 64, IT_G = 32 * 176, IT_U = 32 * 176, IT_D = 88 * 64, IT_C1 = 32 * 4, IT_C2 = 2 * 2;
constexpr int IT_LAYER = IT_WIN + IT_GLU + IT_OUT + IT_G + IT_U + IT_D + 2 * IT_C1 + 2 * IT_C2;

__device__ __forceinline__ void prologue(LAS unsigned char* lds, int wave, int lane, int gw, int NGW) {
    CArgs* Ap = get_args();
    unsigned char* ws = Ap->ws;
    LAS float* scr = (LAS float*)(lds + wave * 16384);
    for (int it = gw; it < DEPTH * IT_LAYER; it += NGW) {
        const int l = it / IT_LAYER; int r = it % IT_LAYER;
        if (r < IT_WIN) { transpose_item(Ap->in[5] + (size_t)l * DM * NIN, DM, NIN, (bf16_t*)(ws + WS_WIN) + (size_t)l * NINP * DM, 4, Ap->in[2] + l * DM, scr, r, lane); continue; } r -= IT_WIN;
        if (r < IT_GLU) { transpose_item(Ap->in[14] + (size_t)l * DSSM * 2 * DSSM, DSSM, 2 * DSSM, (bf16_t*)(ws + WS_WGLU) + (size_t)l * 2 * DSSM * DSSM, 1, nullptr, scr, r, lane); continue; } r -= IT_GLU;
        if (r < IT_OUT) { transpose_item(Ap->in[22] + (size_t)l * DM * DM, DM, DM, (bf16_t*)(ws + WS_WOUT) + (size_t)l * DM * DM, 5, nullptr, scr, r, lane); continue; } r -= IT_OUT;
        if (r < IT_G) { transpose_item(Ap->in[23] + (size_t)l * DM * DFF, DM, DFF, (bf16_t*)(ws + WS_WGU) + (size_t)l * 2 * DFF * DM, 2, Ap->in[3] + l * DM, scr, r, lane); continue; } r -= IT_G;
        if (r < IT_U) { transpose_item(Ap->in[24] + (size_t)l * DM * DFF, DM, DFF, (bf16_t*)(ws + WS_WGU) + (size_t)l * 2 * DFF * DM, 3, Ap->in[3] + l * DM, scr, r, lane); continue; } r -= IT_U;
        if (r < IT_D) { transpose_item(Ap->in[25] + (size_t)l * DFF * DM, DFF, DM, (bf16_t*)(ws + WS_WDN) + (size_t)l * DM * DFF, 5, nullptr, scr, r, lane); continue; } r -= IT_D;
        if (r < IT_C1) { transpose_item(Ap->in[17] + (size_t)l * 2048 * 128, 2048, 128, (bf16_t*)(ws + WS_CW1) + (size_t)(l * 2 + 0) * 128 * 2048, 0, nullptr, scr, r, lane); continue; } r -= IT_C1;
        if (r < IT_C1) { transpose_item(Ap->in[20] + (size_t)l * 2048 * 128, 2048, 128, (bf16_t*)(ws + WS_CW1) + (size_t)(l * 2 + 1) * 128 * 2048, 0, nullptr, scr, r, lane); continue; } r -= IT_C1;
        if (r < IT_C2) { transpose_item(Ap->in[18] + (size_t)l * 128 * 64, 128, 64, (bf16_t*)(ws + WS_CW2) + (size_t)(l * 2 + 0) * 64 * 128, 0, nullptr, scr, r, lane); continue; } r -= IT_C2;
        transpose_item(Ap->in[21] + (size_t)l * 128 * 64, 128, 64, (bf16_t*)(ws + WS_CW2) + (size_t)(l * 2 + 1) * 64 * 128, 0, nullptr, scr, r, lane);
    }
    const float* x = Ap->in[0]; bf16_t* XB = (bf16_t*)(ws + WS_XB); float* rowsq = (float*)(ws + WS_RSQ);
    for (int m = gw; m < MTOK; m += NGW) {
        const f32x4* xr = (const f32x4*)(x + (size_t)m * DM) + lane; u32x2* xb = (u32x2*)(XB + (size_t)m * DM) + lane;
        float s = 0.f;
#pragma unroll
        for (int j = 0; j < 8; ++j) { const f32x4 v = __builtin_nontemporal_load(&xr[64 * j]); u32x2 w; w.x = pk2(v[0], v[1]); w.y = pk2(v[2], v[3]); xb[64 * j] = w; s += (v[0] * v[0] + v[1] * v[1]) + (v[2] * v[2] + v[3] * v[3]); }
        s = wave_sum(s);
        if (lane < 32) rowsq[(size_t)lane * MTOK + m] = (lane == 0) ? s : 0.f;
    }
}

__device__ __forceinline__ void sincos_small(float ang, float& sn, float& cs) {
    const float k = rintf(ang * 0.636619772f);
    float r = fmaf(-k, 1.5707963705f, ang); r = fmaf(-k, -4.37113883e-8f, r);
    const float r2 = r * r;
    const float s = r * (1.f + r2 * (-1.f / 6.f + r2 * (1.f / 120.f + r2 * (-1.f / 5040.f + r2 * (1.f / 362880.f)))));
    const float c = 1.f + r2 * (-0.5f + r2 * (1.f / 24.f + r2 * (-1.f / 720.f + r2 * (1.f / 40320.f))));
    const int q = ((int)k) & 3;
    sn = (q == 0) ? s : (q == 1) ? c : (q == 2) ? -s : -c;
    cs = (q == 0) ? c : (q == 1) ? -s : (q == 2) ? -c : s;
}

template <int PASS>
__device__ __forceinline__ void s5_task(CArgs* Ap, int l, int b, int g, int c, LAS unsigned char* wl, int lane) {
    if (PASS == 1 && c == NCHUNK - 1) return;
    unsigned char* ws = Ap->ws;
    const bf16_t* P = (const bf16_t*)(ws + p_off(l));
    f32x2* SST = (f32x2*)(ws + WS_SST + (size_t)l * MiB);
    LAS float* us = (LAS float*)wl;
    LAS bf16_t* Xs = (LAS bf16_t*)(wl + 1024);
    const int p = lane;
    const float a_re = fminf(Ap->in[6][(l * NGRP + g) * NST + p], -1e-4f), a_im = Ap->in[7][(l * NGRP + g) * NST + p];
    const float dt = expf(Ap->in[8][l * NGRP + g]);
    const float mag = expf(a_re * dt); float sn, cs; sincos_small(a_im * dt, sn, cs);
    const float ab_re = mag * cs, ab_im = mag * sn;
    const float nr = ab_re - 1.f, ni = ab_im, den = a_re * a_re + a_im * a_im;
    const float f_re = (nr * a_re + ni * a_im) / den, f_im = (ni * a_re - nr * a_im) / den;
    float bbr[16], bbi[16]; f32x2 bb2[16];
    {
        const f32x4* br = (const f32x4*)(Ap->in[9] + ((size_t)(l * NGRP + g) * NST + p) * 16); const f32x4* bi = (const f32x4*)(Ap->in[10] + ((size_t)(l * NGRP + g) * NST + p) * 16);
#pragma unroll
        for (int q = 0; q < 4; ++q) { const f32x4 vr = br[q], vi = bi[q];
#pragma unroll
            for (int i = 0; i < 4; ++i) { bbr[4 * q + i] = f_re * vr[i] - f_im * vi[i]; bbi[4 * q + i] = f_re * vi[i] + f_im * vr[i]; bb2[4 * q + i] = (f32x2){bbr[4 * q + i], bbi[4 * q + i]}; } }
    }
    float xr = 0.f, xi = 0.f;
    const int n16 = lane & 15, g4 = lane >> 4;
    bf16x8 cB[4]; float dval = 0.f;
    if (PASS == 2) {
        float pr = ab_re, pi = ab_im;
#pragma unroll
        for (int i = 0; i < 9; ++i) { const float t_ = pr * pr - pi * pi; pi = 2.f * pr * pi; pr = t_; }
        const f32x2* S = SST + (size_t)((b * NGRP + g) * NCHUNK) * NST + p;
        for (int cc = 0; cc < c; ++cc) { const f32x2 s = S[(size_t)cc * NST]; const float t_ = pr * xr - pi * xi + s.x; xi = pr * xi + pi * xr + s.y; xr = t_; }
        const float* cre = Ap->in[11] + ((size_t)(l * NGRP + g) * 16 + n16) * NST; const float* cim = Ap->in[12] + ((size_t)(l * NGRP + g) * 16 + n16) * NST;
#pragma unroll
        for (int kk = 0; kk < 4; ++kk) { const f32x4 r4 = *(const f32x4*)(cre + 16 * kk + 4 * g4), i4 = *(const f32x4*)(cim + 16 * kk + 4 * g4);
            u32x4 w; w.x = pk2(r4[0], -i4[0]); w.y = pk2(r4[1], -i4[1]); w.z = pk2(r4[2], -i4[2]); w.w = pk2(r4[3], -i4[3]);
            cB[kk] = __builtin_bit_cast(bf16x8, w); }
        dval = Ap->in[13][l * DSSM + g * 16 + n16];
    }
    const size_t row0 = (size_t)b * SEQ + (size_t)c * CHUNK;
    const bf16_t* up = P + (row0 + (lane >> 2)) * NINP + g * 16 + 4 * (lane & 3);
    u32x2 unext = *(const u32x2*)up;
    bf16_t* Y1 = (bf16_t*)(ws + WS_Y1);
    for (int tb = 0; tb < CHUNK; tb += 16) {
        const u32x2 ucur = unext;
        if (tb + 16 < CHUNK) unext = *(const u32x2*)(up + (size_t)(tb + 16) * NINP);
        *(LAS f32x4*)(us + (lane >> 2) * 16 + 4 * (lane & 3)) = (f32x4){bflo(ucur.x), bfhi(ucur.x), bflo(ucur.y), bfhi(ucur.y)};
        wave_lds_fence();
#pragma unroll 4
        for (int s = 0; s < 16; ++s) {
            const f32x4 u0 = *(const LAS f32x4*)(us + s * 16), u1 = *(const LAS f32x4*)(us + s * 16 + 4), u2 = *(const LAS f32x4*)(us + s * 16 + 8), u3 = *(const LAS f32x4*)(us + s * 16 + 12);
            f32x2 bu = (f32x2){0.f, 0.f};
#pragma unroll
            for (int i = 0; i < 4; ++i) bu = bb2[i] * (f32x2){u0[i], u0[i]} + bu;
#pragma unroll
            for (int i = 0; i < 4; ++i) bu = bb2[4 + i] * (f32x2){u1[i], u1[i]} + bu;
#pragma unroll
            for (int i = 0; i < 4; ++i) bu = bb2[8 + i] * (f32x2){u2[i], u2[i]} + bu;
#pragma unroll
            for (int i = 0; i < 4; ++i) bu = bb2[12 + i] * (f32x2){u3[i], u3[i]} + bu;
            const float br_ = bu.x, bi_ = bu.y;
            const float nxr = fmaf(ab_re, xr, fmaf(-ab_im, xi, br_)); const float nxi = fmaf(ab_re, xi, fmaf(ab_im, xr, bi_));
            xr = nxr; xi = nxi;
            if (PASS == 2) *(LAS unsigned*)(Xs + s * 136 + 2 * p) = pk2(xr, xi);
        }
        if (PASS == 2) {
            wave_lds_fence();
            f32x4 y = (f32x4){0.f, 0.f, 0.f, 0.f};
#pragma unroll
            for (int kk = 0; kk < 4; ++kk) { const bf16x8 xa = *(const LAS bf16x8*)(Xs + n16 * 136 + 32 * kk + 8 * g4); y = __builtin_amdgcn_mfma_f32_16x16x32_bf16(xa, cB[kk], y, 0, 0, 0); }
#pragma unroll
            for (int i = 0; i < 4; ++i) { const int tl = 4 * g4 + i; const float uv = us[tl * 16 + n16]; const float v = gelu_tanh(y[i] + dval * uv);
                Y1[(row0 + tb + tl) * DSSM + g * 16 + n16] = f2bf(v); }
        }
        wave_lds_fence();
    }
    if (PASS == 1) SST[(size_t)((b * NGRP + g) * NCHUNK + c) * NST + p] = (f32x2){xr, xi};
}

__device__ __forceinline__ void compress_task(CArgs* Ap, int l, int task, int lane) {
    unsigned char* ws = Ap->ws;
    const int kv = task & 1, nb = (task >> 1) & 31, g = (task >> 6) & 3, b = task >> 8;
    const int n16 = lane & 15, g4 = lane >> 4;
    const bf16_t* P = (const bf16_t*)(ws + p_off(l));
    const bf16_t* W1t = (const bf16_t*)(ws + WS_CW1) + (size_t)(l * 2 + kv) * 128 * 2048;
    const bf16_t* W2t = (const bf16_t*)(ws + WS_CW2) + (size_t)(l * 2 + kv) * 64 * 128;
    const float* pos = Ap->in[kv ? 19 : 16] + (size_t)l * 32 * 64;
    const int n = nb * 16 + n16;
    const int colb = (kv ? C_VC : C_KC) + g * 64;
    f32x4 acc[8];
#pragma unroll
    for (int h = 0; h < 8; ++h) acc[h] = (f32x4){0.f, 0.f, 0.f, 0.f};
#pragma unroll 2
    for (int ks = 0; ks < 64; ++ks) {
        const int itok = ks >> 1, d0 = 32 * (ks & 1) + 8 * g4;
        int tok = 16 * n + itok; tok = tok > SEQ - 1 ? SEQ - 1 : tok;
        const u32x4 raw = *(const u32x4*)(P + ((size_t)b * SEQ + tok) * NINP + colb + d0);
        const f32x4 p0 = *(const f32x4*)(pos + itok * 64 + d0), p1 = *(const f32x4*)(pos + itok * 64 + d0 + 4);
        u32x4 w;
        w.x = pk2(bflo(raw.x) + p0[0], bfhi(raw.x) + p0[1]); w.y = pk2(bflo(raw.y) + p0[2], bfhi(raw.y) + p0[3]);
        w.z = pk2(bflo(raw.z) + p1[0], bfhi(raw.z) + p1[1]); w.w = pk2(bflo(raw.w) + p1[2], bfhi(raw.w) + p1[3]);
        const bf16x8 fb = __builtin_bit_cast(bf16x8, w);
#pragma unroll
        for (int h = 0; h < 8; ++h) { const bf16x8 wa = *(const bf16x8*)(W1t + (size_t)(16 * h + n16) * 2048 + 32 * ks + 8 * g4); acc[h] = __builtin_amdgcn_mfma_f32_16x16x32_bf16(wa, fb, acc[h], 0, 0, 0); }
    }
    bf16x8 hB[4];
#pragma unroll
    for (int pp = 0; pp < 4; ++pp) { float v[8];
#pragma unroll
        for (int i = 0; i < 4; ++i) { v[i] = gelu_tanh(acc[2 * pp][i]); v[4 + i] = gelu_tanh(acc[2 * pp + 1][i]); }
        u32x4 w; w.x = pk2(v[0], v[1]); w.y = pk2(v[2], v[3]); w.z = pk2(v[4], v[5]); w.w = pk2(v[6], v[7]); hB[pp] = __builtin_bit_cast(bf16x8, w); }
    bf16_t* KC = (bf16_t*)(ws + WS_KC + (size_t)l * MiB); bf16_t* VCT = (bf16_t*)(ws + WS_VCT + (size_t)l * MiB);
#pragma unroll
    for (int dt = 0; dt < 4; ++dt) {
        f32x4 o = (f32x4){0.f, 0.f, 0.f, 0.f};
#pragma unroll
        for (int pp = 0; pp < 4; ++pp) { const bf16_t* wrow = W2t + (size_t)(16 * dt + n16) * 128 + 32 * pp + 4 * g4;
            const u32x2 lo = *(const u32x2*)wrow, hi = *(const u32x2*)(wrow + 16);
            u32x4 w; w.x = lo.x; w.y = lo.y; w.z = hi.x; w.w = hi.y;
            o = __builtin_amdgcn_mfma_f32_16x16x32_bf16(__builtin_bit_cast(bf16x8, w), hB[pp], o, 0, 0, 0); }
        if (kv == 0) { u32x2 w; w.x = pk2(o[0], o[1]); w.y = pk2(o[2], o[3]); *(u32x2*)(KC + (size_t)((b * 4 + g) * 8 + (n >> 6)) * 4096 + kswz(n & 63, 16 * dt + 4 * g4)) = w; }
        else {
#pragma unroll
            for (int i = 0; i < 4; ++i) VCT[(size_t)((b * 4 + g) * 8 + (n >> 6)) * 4096 + vswz(16 * dt + 4 * g4 + i, n & 63)] = f2bf(o[i]); }
    }
}

__device__ __forceinline__ void compress_simple(CArgs* Ap, int l, int task, LAS float* hs, int lane) {
    unsigned char* ws = Ap->ws;
    const int kv = task & 1, n0 = ((task >> 1) & 127) * 4, g = (task >> 8) & 3, b = task >> 10;
    const bf16_t* P = (const bf16_t*)(ws + p_off(l));
    const float* w1 = Ap->in[kv ? 20 : 17] + (size_t)l * 2048 * 128; const float* w2 = Ap->in[kv ? 21 : 18] + (size_t)l * 128 * 64;
    const float* pos = Ap->in[kv ? 19 : 16] + (size_t)l * 32 * 64;
    const int colb = (kv ? C_VC : C_KC) + g * 64;
    float h0[4] = {0.f, 0.f, 0.f, 0.f}, h1[4] = {0.f, 0.f, 0.f, 0.f};
    for (int i = 0; i < 32; ++i) {
        const bf16_t* pr[4];
#pragma unroll
        for (int r = 0; r < 4; ++r) { int tok = 16 * (n0 + r) + i; tok = tok > SEQ - 1 ? SEQ - 1 : tok; pr[r] = P + ((size_t)b * SEQ + tok) * NINP + colb; }
        for (int d8 = 0; d8 < 8; ++d8) {
            const f32x4 p0 = *(const f32x4*)(pos + i * 64 + d8 * 8), p1 = *(const f32x4*)(pos + i * 64 + d8 * 8 + 4);
            const float pv[8] = {p0[0], p0[1], p0[2], p0[3], p1[0], p1[1], p1[2], p1[3]};
            float f[4][8];
#pragma unroll
            for (int r = 0; r < 4; ++r) { const u32x4 raw = *(const u32x4*)(pr[r] + d8 * 8);
                f[r][0] = bflo(raw.x) + pv[0]; f[r][1] = bfhi(raw.x) + pv[1]; f[r][2] = bflo(raw.y) + pv[2]; f[r][3] = bfhi(raw.y) + pv[3];
                f[r][4] = bflo(raw.z) + pv[4]; f[r][5] = bfhi(raw.z) + pv[5]; f[r][6] = bflo(raw.w) + pv[6]; f[r][7] = bfhi(raw.w) + pv[7]; }
            const float* wr = w1 + (size_t)(i * 64 + d8 * 8) * 128 + lane;
#pragma unroll
            for (int e = 0; e < 8; ++e) { const float wa = wr[e * 128], wb = wr[e * 128 + 64];
#pragma unroll
                for (int r = 0; r < 4; ++r) { h0[r] = fmaf(f[r][e], wa, h0[r]); h1[r] = fmaf(f[r][e], wb, h1[r]); } }
        }
    }
#pragma unroll
    for (int r = 0; r < 4; ++r) { hs[r * 128 + lane] = gelu_tanh(h0[r]); hs[r * 128 + lane + 64] = gelu_tanh(h1[r]); }
    wave_lds_fence();
    float o[4] = {0.f, 0.f, 0.f, 0.f};
    for (int k = 0; k < 128; ++k) { const float w = w2[k * 64 + lane];
#pragma unroll
        for (int r = 0; r < 4; ++r) o[r] = fmaf(hs[r * 128 + k], w, o[r]); }
    wave_lds_fence();
    bf16_t* KC = (bf16_t*)(ws + WS_KC + (size_t)l * MiB); bf16_t* VCT = (bf16_t*)(ws + WS_VCT + (size_t)l * MiB);
#pragma unroll
    for (int r = 0; r < 4; ++r) { const int n = n0 + r;
        if (kv == 0) KC[(size_t)((b * 4 + g) * 8 + (n >> 6)) * 4096 + kswz(n & 63, lane)] = f2bf(o[r]);
        else VCT[(size_t)((b * 4 + g) * 8 + (n >> 6)) * 4096 + vswz(lane, n & 63)] = f2bf(o[r]); }
}

__device__ __forceinline__ int rel_bucket_i(int n) {
    if (n < 16) return n;
    int c = 0;
    c += n >= 16; c += n >= 21; c += n >= 27; c += n >= 35; c += n >= 46; c += n >= 59; c += n >= 77; c += n >= 99;
    c += n >= 128; c += n >= 166; c += n >= 216; c += n >= 280; c += n >= 363; c += n >= 470; c += n >= 609; c += n >= 790;
    return 15 + c;
}

struct SmState { float m, l; };

template <int MODE>
__device__ __forceinline__ void softmax_block(f32x4 (&acc)[4], int base, bool ok, int t, int g4, const LAS float* lutg, SmState& st, f32x4 (&O)[4], bf16x8 (&pB)[2]) {
    float mx = -1e30f; unsigned vm = 0u;
#pragma unroll
    for (int nt = 0; nt < 4; ++nt)
#pragma unroll
        for (int i = 0; i < 4; ++i) {
            const int key = base + 16 * nt + 4 * g4 + i;
            const int dist = (MODE == 0) ? t - (16 * key + 31) : t - key;
            bool valid = dist >= 0;
            if (MODE == 1) valid = valid && ok;
            if (MODE == 2) valid = valid && dist < 512;
            int dc = dist < 0 ? 0 : dist; dc = dc > 1023 ? 1023 : dc;
            const float lg = acc[nt][i] + lutg[dc * 4];
            acc[nt][i] = lg;
            if (valid) { mx = fmaxf(mx, lg); vm |= 1u << (nt * 4 + i); }
        }
    mx = fmaxf(mx, __shfl_xor(mx, 16)); mx = fmaxf(mx, __shfl_xor(mx, 32));
    const float mn = fmaxf(st.m, mx);
    const float sc = fexp(st.m - mn);
    float ls = 0.f;
#pragma unroll
    for (int nt = 0; nt < 4; ++nt)
#pragma unroll
        for (int i = 0; i < 4; ++i) { const float p = ((vm >> (nt * 4 + i)) & 1u) ? fexp(acc[nt][i] - mn) : 0.f; acc[nt][i] = p; ls += p; }
    st.l = st.l * sc + ls; st.m = mn;
#pragma unroll
    for (int dt = 0; dt < 4; ++dt) O[dt] = O[dt] * sc;
#pragma unroll
    for (int hh = 0; hh < 2; ++hh) { u32x4 w; w.x = pk2(acc[2 * hh][0], acc[2 * hh][1]); w.y = pk2(acc[2 * hh][2], acc[2 * hh][3]); w.z = pk2(acc[2 * hh + 1][0], acc[2 * hh + 1][1]); w.w = pk2(acc[2 * hh + 1][2], acc[2 * hh + 1][3]);
        pB[hh] = __builtin_bit_cast(bf16x8, w); }
}

__device__ __forceinline__ void load_k(bf16x8 (&kf)[4][2], const bf16_t* Kb, int lane) {
#pragma unroll
    for (int nt = 0; nt < 4; ++nt)
#pragma unroll
        for (int kk = 0; kk < 2; ++kk) kf[nt][kk] = *(const bf16x8*)(Kb + ((nt * 2 + kk) * 64 + lane) * 8);
}
__device__ __forceinline__ void load_v(bf16x8 (&vf)[4][2], const bf16_t* Vb, int lane) {
#pragma unroll
    for (int dt = 0; dt < 4; ++dt)
#pragma unroll
        for (int hh = 0; hh < 2; ++hh) vf[dt][hh] = *(const bf16x8*)(Vb + ((dt * 2 + hh) * 64 + lane) * 8);
}
__device__ __forceinline__ void qk_acc(f32x4 (&acc)[4], const bf16x8 (&kf)[4][2], const bf16x8 (&q)[2]) {
#pragma unroll
    for (int nt = 0; nt < 4; ++nt) { acc[nt] = __builtin_amdgcn_mfma_f32_16x16x32_bf16(kf[nt][0], q[0], acc[nt], 0, 0, 0); acc[nt] = __builtin_amdgcn_mfma_f32_16x16x32_bf16(kf[nt][1], q[1], acc[nt], 0, 0, 0); }
}
__device__ __forceinline__ void pv_acc(f32x4 (&O)[4], const bf16x8 (&vf)[4][2], const bf16x8 (&pB)[2]) {
#pragma unroll
    for (int dt = 0; dt < 4; ++dt) { O[dt] = __builtin_amdgcn_mfma_f32_16x16x32_bf16(vf[dt][0], pB[0], O[dt], 0, 0, 0); O[dt] = __builtin_amdgcn_mfma_f32_16x16x32_bf16(vf[dt][1], pB[1], O[dt], 0, 0, 0); }
}


__device__ __forceinline__ void load_kh(bf16x8 (&kf)[2][2], const bf16_t* Kb, int hh, int lane) {
#pragma unroll
    for (int nt = 0; nt < 2; ++nt)
#pragma unroll
        for (int kk = 0; kk < 2; ++kk) kf[nt][kk] = *(const bf16x8*)(Kb + (((2 * hh + nt) * 2 + kk) * 64 + lane) * 8);
}
__device__ __forceinline__ void load_vh(bf16x8 (&vf)[4], const bf16_t* Vb, int hh, int lane) {
#pragma unroll
    for (int dt = 0; dt < 4; ++dt) vf[dt] = *(const bf16x8*)(Vb + ((dt * 2 + hh) * 64 + lane) * 8);
}
__device__ __forceinline__ void qk_acch(f32x4 (&acc)[2], const bf16x8 (&kf)[2][2], const bf16x8 (&q)[2]) {
#pragma unroll
    for (int nt = 0; nt < 2; ++nt) { acc[nt] = __builtin_amdgcn_mfma_f32_16x16x32_bf16(kf[nt][0], q[0], acc[nt], 0, 0, 0); acc[nt] = __builtin_amdgcn_mfma_f32_16x16x32_bf16(kf[nt][1], q[1], acc[nt], 0, 0, 0); }
}
__device__ __forceinline__ void pv_acch(f32x4 (&O)[4], const bf16x8 (&vf)[4], const bf16x8 pB) {
#pragma unroll
    for (int dt = 0; dt < 4; ++dt) O[dt] = __builtin_amdgcn_mfma_f32_16x16x32_bf16(vf[dt], pB, O[dt], 0, 0, 0);
}
__device__ __forceinline__ void softmax_half_far(f32x4 (&acc)[2], const LAS float* lutg, SmState& st, f32x4 (&O)[4]) {
    const float bias = lutg[1023 * 4];
    float mx = -1e30f;
#pragma unroll
    for (int nt = 0; nt < 2; ++nt)
#pragma unroll
        for (int i = 0; i < 4; ++i) { const float lg = acc[nt][i] + bias; acc[nt][i] = lg; mx = fmaxf(mx, lg); }
    mx = fmaxf(mx, __shfl_xor(mx, 16)); mx = fmaxf(mx, __shfl_xor(mx, 32));
    const float mn = fmaxf(st.m, mx);
    const float sc = fexp(st.m - mn);
    float ls = 0.f;
#pragma unroll
    for (int nt = 0; nt < 2; ++nt)
#pragma unroll
        for (int i = 0; i < 4; ++i) { const float p = fexp(acc[nt][i] - mn); acc[nt][i] = p; ls += p; }
    st.l = st.l * sc + ls; st.m = mn;
#pragma unroll
    for (int dt = 0; dt < 4; ++dt) O[dt] = O[dt] * sc;
}
template <int MODE>
__device__ __forceinline__ void softmax_half(f32x4 (&acc)[2], int base, bool ok, int t, int g4, const LAS float* lutg, SmState& st, f32x4 (&O)[4], bf16x8& pB) {
    float mx = -1e30f; unsigned vm = 0u;
#pragma unroll
    for (int nt = 0; nt < 2; ++nt)
#pragma unroll
        for (int i = 0; i < 4; ++i) {
            const int key = base + 16 * nt + 4 * g4 + i;
            const int dist = t - key;
            bool valid = dist >= 0;
            if (MODE == 1) valid = valid && ok;
            if (MODE == 2) valid = valid && dist < 512;
            int dc = dist < 0 ? 0 : dist; dc = dc > 1023 ? 1023 : dc;
            const float lg = acc[nt][i] + lutg[dc * 4];
            acc[nt][i] = lg;
            if (valid) { mx = fmaxf(mx, lg); vm |= 1u << (nt * 4 + i); }
        }
    mx = fmaxf(mx, __shfl_xor(mx, 16)); mx = fmaxf(mx, __shfl_xor(mx, 32));
    const float mn = fmaxf(st.m, mx);
    const float sc = fexp(st.m - mn);
    float ls = 0.f;
#pragma unroll
    for (int nt = 0; nt < 2; ++nt)
#pragma unroll
        for (int i = 0; i < 4; ++i) { const float p = ((vm >> (nt * 4 + i)) & 1u) ? fexp(acc[nt][i] - mn) : 0.f; acc[nt][i] = p; ls += p; }
    st.l = st.l * sc + ls; st.m = mn;
#pragma unroll
    for (int dt = 0; dt < 4; ++dt) O[dt] = O[dt] * sc;
    u32x4 w; w.x = pk2(acc[0][0], acc[0][1]); w.y = pk2(acc[0][2], acc[0][3]); w.z = pk2(acc[1][0], acc[1][1]); w.w = pk2(acc[1][2], acc[1][3]);
    pB = __builtin_bit_cast(bf16x8, w);
}


__device__ __forceinline__ void load_kh8(long (&kf)[2][2], const unsigned char* Kb, int hh, int lane) {
#pragma unroll
    for (int nt = 0; nt < 2; ++nt)
#pragma unroll
        for (int kk = 0; kk < 2; ++kk) kf[nt][kk] = *(const long*)(Kb + (((2 * hh + nt) * 2 + kk) * 64 + lane) * 8);
}
__device__ __forceinline__ void load_vh8(long (&vf)[4], const unsigned char* Vb, int hh, int lane) {
#pragma unroll
    for (int dt = 0; dt < 4; ++dt) vf[dt] = *(const long*)(Vb + ((dt * 2 + hh) * 64 + lane) * 8);
}
__device__ __forceinline__ void qk_acch8(f32x4 (&acc)[2], const long (&kf)[2][2], const long (&q)[2]) {
#pragma unroll
    for (int nt = 0; nt < 2; ++nt) { acc[nt] = __builtin_amdgcn_mfma_f32_16x16x32_fp8_fp8(kf[nt][0], q[0], acc[nt], 0, 0, 0); acc[nt] = __builtin_amdgcn_mfma_f32_16x16x32_fp8_fp8(kf[nt][1], q[1], acc[nt], 0, 0, 0); }
}
__device__ __forceinline__ void pv_acch8(f32x4 (&O)[4], const long (&vf)[4], const long p8) {
#pragma unroll
    for (int dt = 0; dt < 4; ++dt) O[dt] = __builtin_amdgcn_mfma_f32_16x16x32_fp8_fp8(vf[dt], p8, O[dt], 0, 0, 0);
}
constexpr float P8_SCALE = 256.f;
__device__ __forceinline__ long p_to_fp8(const f32x4 (&acc)[2]) {
    return pack8_fp8(acc[0][0] * P8_SCALE, acc[0][1] * P8_SCALE, acc[0][2] * P8_SCALE, acc[0][3] * P8_SCALE, acc[1][0] * P8_SCALE, acc[1][1] * P8_SCALE, acc[1][2] * P8_SCALE, acc[1][3] * P8_SCALE);
}

__device__ __forceinline__ void nsa_wave(CArgs* Ap, int l, int b, int g, int tq0, const LAS float* lut, LAS float* imp, int lane) {
    unsigned char* ws = Ap->ws;
    const bf16_t* P = (const bf16_t*)(ws + p_off(l));
    const bf16_t* KC = (const bf16_t*)(ws + WS_KC + (size_t)l * MiB) + (size_t)(b * 4 + g) * 8 * 4096;
    const bf16_t* VCT = (const bf16_t*)(ws + WS_VCT + (size_t)l * MiB) + (size_t)(b * 4 + g) * 8 * 4096;
    const bf16_t* VST = (const bf16_t*)(ws + vt_off(l)) + (size_t)(b * 4 + g) * 128 * 4096;
    const bf16_t* VWT = (const bf16_t*)(ws + vt_off(l) + 8 * MiB) + (size_t)(b * 4 + g) * 128 * 4096;
    bf16_t* MIX = (bf16_t*)(ws + WS_MIX);
    const int n16 = lane & 15, g4 = lane >> 4, qi = n16 >> 2, r = n16 & 3;
    const int t = tq0 + qi;
    const bf16_t* prow = P + ((size_t)b * SEQ + t) * NINP;
    bf16x8 qB[2];
    qB[0] = *(const bf16x8*)(prow + C_Q + (4 * g + r) * 64 + 8 * g4); qB[1] = *(const bf16x8*)(prow + C_Q + (4 * g + r) * 64 + 8 * g4 + 32);
    float gt[3];
#pragma unroll
    for (int br = 0; br < 3; ++br) gt[br] = sigmoidf_(bf2f(prow[C_GATE + (4 * g + r) * 3 + br]));
    const LAS float* lutg = lut + g * 4096 + r;
    f32x4 outacc[4];
#pragma unroll
    for (int dt = 0; dt < 4; ++dt) outacc[dt] = (f32x4){0.f, 0.f, 0.f, 0.f};
#pragma unroll
    for (int i = 0; i < 8; ++i) *(LAS f32x4*)(imp + (i * 64 + lane) * 4) = (f32x4){0.f, 0.f, 0.f, 0.f};

    const int tmax = tq0 + 3;
    const int ncb = (tmax >= 31) ? ((((tmax - 31) >> 4) >> 6) + 1) : 0;
    {
        SmState st{-1e30f, 0.f};
        f32x4 Od[4];
#pragma unroll
        for (int dt = 0; dt < 4; ++dt) Od[dt] = (f32x4){0.f, 0.f, 0.f, 0.f};
        bf16x8 pB[2];
        for (int cb = 0; cb < ncb; ++cb) {
            bf16x8 kf[4][2]; load_k(kf, KC + (size_t)cb * 4096, lane);
            f32x4 acc[4];
#pragma unroll
            for (int nt = 0; nt < 4; ++nt) acc[nt] = (f32x4){0.f, 0.f, 0.f, 0.f};
            qk_acc(acc, kf, qB);
            softmax_block<0>(acc, cb * 64, true, t, g4, lutg, st, Od, pB);
        }
        float lt = st.l; lt += __shfl_xor(lt, 16); lt += __shfl_xor(lt, 32);
        const float inv = 1.f / fmaxf(lt, 1e-30f), mfin = st.m;
        for (int cb = 0; cb < ncb; ++cb) {
            bf16x8 kf[4][2]; load_k(kf, KC + (size_t)cb * 4096, lane);
            bf16x8 vf[4][2]; load_v(vf, VCT + (size_t)cb * 4096, lane);
            f32x4 acc[4];
#pragma unroll
            for (int nt = 0; nt < 4; ++nt) acc[nt] = (f32x4){0.f, 0.f, 0.f, 0.f};
            qk_acc(acc, kf, qB);
#pragma unroll
            for (int nt = 0; nt < 4; ++nt) {
                f32x4 pi4;
#pragma unroll
                for (int i = 0; i < 4; ++i) {
                    const int key = cb * 64 + 16 * nt + 4 * g4 + i; const int dist = t - (16 * key + 31);
                    int dc = dist < 0 ? 0 : dist; dc = dc > 1023 ? 1023 : dc;
                    const float lg = acc[nt][i] + lutg[dc * 4];
                    float p = (dist >= 0) ? fexp(lg - mfin) * inv : 0.f;
                    acc[nt][i] = p;
                    p += __shfl_xor(p, 1); p += __shfl_xor(p, 2);
                    pi4[i] = p;
                }
                if (r == 0) *(LAS f32x4*)(imp + qi * 512 + cb * 64 + 16 * nt + 4 * g4) = pi4;
            }
#pragma unroll
            for (int hh = 0; hh < 2; ++hh) { u32x4 w; w.x = pk2(acc[2 * hh][0], acc[2 * hh][1]); w.y = pk2(acc[2 * hh][2], acc[2 * hh][3]); w.z = pk2(acc[2 * hh + 1][0], acc[2 * hh + 1][1]); w.w = pk2(acc[2 * hh + 1][2], acc[2 * hh + 1][3]);
                pB[hh] = __builtin_bit_cast(bf16x8, w); }
            pv_acc(outacc, vf, pB);
        }
#pragma unroll
        for (int dt = 0; dt < 4; ++dt) outacc[dt] = outacc[dt] * gt[0];
    }
    wave_lds_fence();

    const int cur = tq0 >> 6;
    int selreg = -1;
    if (cur < 16) selreg = (n16 <= cur) ? n16 : -1;
    else {
        const int sq = lane >> 4, tsel = tq0 + sq; (void)tsel;
        float sc[8];
#pragma unroll
        for (int jj = 0; jj < 8; ++jj) { const int j = n16 + 16 * jj;
            float v;
            if (j > cur) v = -1.f;
            else if (j == 0 || j == cur || j == cur - 1) v = 1e4f;
            else { const LAS float* ip = imp + sq * 512 + 4 * j; v = ip[0] + 2.f * (ip[-1] + ip[-2] + ip[-3]) + ip[-4]; }
            sc[jj] = v; }
        for (int s = 0; s < 16; ++s) {
            float bv = sc[0]; int bj = n16;
#pragma unroll
            for (int jj = 1; jj < 8; ++jj) if (sc[jj] > bv) { bv = sc[jj]; bj = n16 + 16 * jj; }
#pragma unroll
            for (int off = 1; off < 16; off <<= 1) { const float ov = __shfl_xor(bv, off); const int oj = __shfl_xor(bj, off); if (ov > bv || (ov == bv && oj < bj)) { bv = ov; bj = oj; } }
            if (n16 == s) selreg = (bv >= 0.f) ? bj : -1;
#pragma unroll
            for (int jj = 0; jj < 8; ++jj) if (bj == n16 + 16 * jj) sc[jj] = -2.f;
        }
    }
    if (cur >= 16) {
        const int fj = selreg;
        const int key = (fj < 0) ? ((1 << 20) + n16) : ((fj == 0 || fj == cur || fj == cur - 1) ? fj : (1 << 10) + fj);
        int rank = 0;
#pragma unroll
        for (int o = 1; o < 16; ++o) { const int other = __shfl(key, (lane & 48) | ((n16 + o) & 15)); rank += (other < key) ? 1 : 0; }
        selreg = __builtin_amdgcn_ds_permute(((lane & 48) | rank) << 2, fj);
    }
    const int nvalid = (cur + 1) < 16 ? (cur + 1) : 16;
    wave_lds_fence();
#pragma unroll
    for (int dt = 0; dt < 4; ++dt) *(LAS f32x4*)(imp + (dt * 64 + lane) * 4) = outacc[dt];

    {
        SmState st{-1e30f, 0.f};
        f32x4 Od[4];
#pragma unroll
        for (int dt = 0; dt < 4; ++dt) Od[dt] = (f32x4){0.f, 0.f, 0.f, 0.f};
        const unsigned char* Ks8 = (const unsigned char*)(ws + WS_KST) + (size_t)(b * 4 + g) * 128 * 4096;
        const unsigned char* Vs8 = (const unsigned char*)(ws + WS_VST) + (size_t)(b * 4 + g) * 128 * 4096;
        long q8[2];
#pragma unroll
        for (int kk = 0; kk < 2; ++kk) { const u32x4 w = __builtin_bit_cast(u32x4, qB[kk]);
            q8[kk] = pack8_fp8(bflo(w.x), bfhi(w.x), bflo(w.y), bfhi(w.y), bflo(w.z), bfhi(w.z), bflo(w.w), bfhi(w.w)); }
        int ns = 0;
        for (; ns < nvalid; ++ns) { const int j0 = __builtin_amdgcn_readlane(selreg, ns), j1 = __builtin_amdgcn_readlane(selreg, 16 + ns), j2 = __builtin_amdgcn_readlane(selreg, 32 + ns), j3 = __builtin_amdgcn_readlane(selreg, 48 + ns);
            if (!(j0 >= 0 && j0 == j1 && j0 == j2 && j0 == j3)) break; }
        {
            long kh[2][2], vh[4];
            if (ns > 0) { const int j0_ = __builtin_amdgcn_readlane(selreg, 0); load_kh8(kh, Ks8 + (size_t)j0_ * 4096, 0, lane); load_vh8(vh, Vs8 + (size_t)j0_ * 4096, 0, lane); }
            for (int hs = 0; hs < 2 * ns; ++hs) {
                const int s = hs >> 1, hh = hs & 1;
                const int j = __builtin_amdgcn_readlane(selreg, s);
                const bool more = hs + 1 < 2 * ns; const int s1 = (hs + 1) >> 1, h1 = (hs + 1) & 1;
                const int jn = more ? __builtin_amdgcn_readlane(selreg, s1) : 0;
                f32x4 acc[2];
                acc[0] = (f32x4){0.f, 0.f, 0.f, 0.f}; acc[1] = (f32x4){0.f, 0.f, 0.f, 0.f};
                qk_acch8(acc, kh, q8);
                if (more) load_kh8(kh, Ks8 + (size_t)jn * 4096, h1, lane);
                if (__all(t - (j * 64 + 32 * hh + 31) >= 1023)) softmax_half_far(acc, lutg, st, Od);
                else { bf16x8 pB; softmax_half<1>(acc, j * 64 + 32 * hh, true, t, g4, lutg, st, Od, pB); }
                pv_acch8(Od, vh, p_to_fp8(acc));
                if (more) load_vh8(vh, Vs8 + (size_t)jn * 4096, h1, lane);
            }
        }
        const int nh = 2 * nvalid, h0 = 2 * ns;
        long kq[4][2][2], vq[4][4];
        if (h0 < nh) {
#pragma unroll
            for (int q2 = 0; q2 < 4; ++q2) { int j = __builtin_amdgcn_readlane(selreg, 16 * q2 + ns); j = j < 0 ? 0 : j; load_kh8(kq[q2], Ks8 + (size_t)j * 4096, 0, lane); load_vh8(vq[q2], Vs8 + (size_t)j * 4096, 0, lane); } }
        for (int hs = h0; hs < nh; ++hs) {
            const int s = hs >> 1, hh = hs & 1;
            const int jm = __shfl(selreg, 16 * qi + s);
            f32x4 acc[2];
            acc[0] = (f32x4){0.f, 0.f, 0.f, 0.f}; acc[1] = (f32x4){0.f, 0.f, 0.f, 0.f};
#pragma unroll
            for (int q2 = 0; q2 < 4; ++q2) { long qm[2]; qm[0] = (qi == q2) ? q8[0] : 0l; qm[1] = (qi == q2) ? q8[1] : 0l; qk_acch8(acc, kq[q2], qm); }
            const bool more = hs + 1 < nh; const int s1 = (hs + 1) >> 1, h1 = (hs + 1) & 1;
            int jn[4];
#pragma unroll
            for (int q2 = 0; q2 < 4; ++q2) { int j = more ? __builtin_amdgcn_readlane(selreg, 16 * q2 + s1) : 0; jn[q2] = j < 0 ? 0 : j; }
            if (more) {
#pragma unroll
                for (int q2 = 0; q2 < 4; ++q2) load_kh8(kq[q2], Ks8 + (size_t)jn[q2] * 4096, h1, lane); }
            if (__all(jm >= 0 && t - (jm * 64 + 32 * hh + 31) >= 1023)) softmax_half_far(acc, lutg, st, Od);
            else { bf16x8 pB; softmax_half<1>(acc, (jm < 0 ? 0 : jm) * 64 + 32 * hh, jm >= 0, t, g4, lutg, st, Od, pB); }
            const long p8 = p_to_fp8(acc);
#pragma unroll
            for (int q2 = 0; q2 < 4; ++q2) { const long pm = (qi == q2) ? p8 : 0l; pv_acch8(Od, vq[q2], pm); }
            if (more) {
#pragma unroll
                for (int q2 = 0; q2 < 4; ++q2) load_vh8(vq[q2], Vs8 + (size_t)jn[q2] * 4096, h1, lane); }
        }
        float lt = st.l; lt += __shfl_xor(lt, 16); lt += __shfl_xor(lt, 32);
        const float sc = gt[1] / (P8_SCALE * fmaxf(lt, 1e-30f));
#pragma unroll
        for (int dt = 0; dt < 4; ++dt) outacc[dt] = Od[dt] * sc;
    }

    {
        SmState st{-1e30f, 0.f};
        f32x4 Od[4];
#pragma unroll
        for (int dt = 0; dt < 4; ++dt) Od[dt] = (f32x4){0.f, 0.f, 0.f, 0.f};
        const bf16_t* Kw = (const bf16_t*)(ws + WS_KWT) + (size_t)(b * 4 + g) * 128 * 4096;
        const int lo = tq0 - 511, jb0 = (lo > 0 ? lo : 0) >> 6, jb1 = (tq0 + 3) >> 6;
        for (int jb = jb0; jb <= jb1; ++jb) {
            bf16x8 kf[4][2]; load_k(kf, Kw + (size_t)jb * 4096, lane);
            bf16x8 vf[4][2]; load_v(vf, VWT + (size_t)jb * 4096, lane);
            f32x4 acc[4];
#pragma unroll
            for (int nt = 0; nt < 4; ++nt) acc[nt] = (f32x4){0.f, 0.f, 0.f, 0.f};
            qk_acc(acc, kf, qB);
            bf16x8 pB[2];
            softmax_block<2>(acc, jb * 64, true, t, g4, lutg, st, Od, pB);
            pv_acc(Od, vf, pB);
        }
        float lt = st.l; lt += __shfl_xor(lt, 16); lt += __shfl_xor(lt, 32);
        const float sc = gt[2] / fmaxf(lt, 1e-30f);
#pragma unroll
        for (int dt = 0; dt < 4; ++dt) outacc[dt] = outacc[dt] + Od[dt] * sc;
    }
    wave_lds_fence();
#pragma unroll
    for (int dt = 0; dt < 4; ++dt) outacc[dt] = outacc[dt] + *(const LAS f32x4*)(imp + (dt * 64 + lane) * 4);
    bf16_t* orow = MIX + ((size_t)b * SEQ + t) * DM + DSSM + (4 * g + r) * 64 + 4 * g4;
#pragma unroll
    for (int dt = 0; dt < 4; ++dt) { u32x2 w; w.x = pk2(outacc[dt][0], outacc[dt][1]); w.y = pk2(outacc[dt][2], outacc[dt][3]); *(u32x2*)(orow + 16 * dt) = w; }
    wave_lds_fence();
}

__global__ void __launch_bounds__(512, 2) hymba_fwd(Args A_unused) {
    extern __shared__ __attribute__((aligned(16))) unsigned char lds_raw[];
    LAS unsigned char* lds = (LAS unsigned char*)lds_raw;
    cg::grid_group grid = cg::this_grid();
#define GRID_SYNC() do { asm volatile("s_waitcnt vmcnt(0) lgkmcnt(0)" ::: "memory"); grid.sync(); \
    asm volatile("buffer_inv sc1\n\ts_waitcnt vmcnt(0) lgkmcnt(0)" ::: "memory"); } while (0)
    const int wave0 = __builtin_amdgcn_readfirstlane(threadIdx.x >> 6);
#define PHASE_IDS() int wv_ = wave0; asm volatile("" : "+s"(wv_)); int tid; asm volatile("v_mbcnt_lo_u32_b32 %0, -1, 0\n\tv_mbcnt_hi_u32_b32 %0, -1, %0" : "=v"(tid)); tid += wv_ * 64; asm volatile("" : "+v"(tid)); const int lane = tid & 63, wave = __builtin_amdgcn_readfirstlane(tid >> 6); \
    int G = gridDim.x, blk = blockIdx.x; asm volatile("" : "+s"(G), "+s"(blk)); const int gw = blk * 8 + wave, NGW = G * 8; (void)lane; (void)gw; (void)NGW;

    unsigned nsync = 0;
#define FAST_SYNC() do { asm volatile("s_waitcnt vmcnt(0) lgkmcnt(0)" ::: "memory"); __syncthreads(); ++nsync; \
    { int l0_; asm volatile("v_mbcnt_lo_u32_b32 %0, -1, 0\n\tv_mbcnt_hi_u32_b32 %0, -1, %0" : "=v"(l0_)); \
      if (wave0 == 0 && l0_ == 0) { unsigned* bar_ = (unsigned*)(get_args()->ws + WS_CTL); const unsigned tgt_ = nsync * gridDim.x; \
        __builtin_amdgcn_fence(__ATOMIC_RELEASE, "agent"); asm volatile("s_waitcnt vmcnt(0)" ::: "memory"); \
        __hip_atomic_fetch_add(bar_, 1u, __ATOMIC_RELAXED, __HIP_MEMORY_SCOPE_AGENT); \
        for (unsigned sp_ = 0; sp_ < (1u << 22); ++sp_) { if (__hip_atomic_load(bar_, __ATOMIC_RELAXED, __HIP_MEMORY_SCOPE_AGENT) >= tgt_) break; __builtin_amdgcn_s_sleep(2); } } } \
    __syncthreads(); asm volatile("buffer_inv sc1\n\ts_waitcnt vmcnt(0) lgkmcnt(0)" ::: "memory"); } while (0)

    { PHASE_IDS(); if (blk == 0 && tid == 0) __hip_atomic_store((unsigned*)(get_args()->ws + WS_CTL), 0u, __ATOMIC_RELAXED, __HIP_MEMORY_SCOPE_AGENT);
      prologue(lds, wave, lane, gw, NGW); }
    GRID_SYNC();

#pragma nounroll
    for (int l = 0; l < DEPTH; ++l) {
        {
            PHASE_IDS(); CArgs* Ap = get_args(); unsigned char* ws = Ap->ws;
            pg8::Gemm g{(const bf16_t*)(ws + WS_XB), (const bf16_t*)(ws + WS_WIN) + (size_t)l * NINP * DM, MTOK, NINP, DM}; pg8::StaticOrder S; S.init(MTOK, NINP, G, blk);
            const float* rq = (const float*)(ws + WS_RSQ) + (size_t)(2 * l) * RSQ_BUF; LAS float* tab = (LAS float*)(lds + 131072);
            pg8::Unit u0; const int pm0 = S.next(0, u0) ? u0.pm : -1; if (pm0 >= 0) rstd_table(rq, pm0, tab, tid); else __syncthreads();
            EpiInProj E{ws, rq, tab, pm0};
            pg8::gemm_phase<EpiInProj, pg8::StaticOrder, true, true>(lds, g, S, E, tid);
        }
        FAST_SYNC();
        {
            PHASE_IDS(); CArgs* Ap = get_args();
            for (int wt = blk; wt < 256; wt += G) { const int b_ = wt >> 7, cp_ = (wt >> 4) & 7, gq_ = wt & 15;
                s5_task<1>(Ap, l, b_, 4 * gq_ + (wave & 3), 2 * cp_ + (wave >> 2), lds + wave * 8192, lane); }
            if (wave < 2) for (int task = blk * 2 + wave; task < 512; task += G * 2) compress_task(Ap, l, task, lane);
        }
        FAST_SYNC();
        {
            PHASE_IDS(); CArgs* Ap = get_args();
            for (int wt = blk; wt < 256; wt += G) { const int b_ = wt >> 7, cp_ = (wt >> 4) & 7, gq_ = wt & 15;
                s5_task<2>(Ap, l, b_, 4 * gq_ + (wave & 3), 2 * cp_ + (wave >> 2), lds + wave * 8192, lane); }
            __syncthreads();
            LAS float* lut = (LAS float*)lds;
            { const float* tab = Ap->in[1];
              for (int e = tid; e < 4 * 1024 * 4; e += 512) { const int r = e & 3, dist = (e >> 2) & 1023, gg = e >> 12; lut[e] = tab[rel_bucket_i(dist) * 16 + gg * 4 + r]; } }
            __syncthreads();
            LAS float* imp = (LAS float*)(lds + 65536 + wave * 8192);
            for (int i = 0; ; ++i) {
                const int unit = i * G + blk; if (unit >= 2048) break;
                const int bg = unit >> 8; int qt = unit & 255; qt = ((qt & 7) << 5) | (qt >> 3);
                if (i & 1) qt = 255 - qt;
                nsa_wave(Ap, l, bg >> 2, bg & 3, qt * 32 + wave * 4, lut, imp, lane);
            }
            __syncthreads();
        }
        FAST_SYNC();
        {
            PHASE_IDS(); CArgs* Ap = get_args(); unsigned char* ws = Ap->ws;
            pg8::Gemm g{(const bf16_t*)(ws + WS_Y1), (const bf16_t*)(ws + WS_WGLU) + (size_t)l * 2 * DSSM * DSSM, MTOK, 2 * DSSM, DSSM}; pg8::StaticOrder S; S.init(MTOK, 2 * DSSM, G, blk);
            EpiGlu E{(bf16_t*)(ws + WS_MIX), Ap->in[15] + (size_t)l * 2 * DSSM};
            pg8::gemm_phase<EpiGlu, pg8::StaticOrder, true, true>(lds, g, S, E, tid);
        }
        FAST_SYNC();
        {
            PHASE_IDS(); CArgs* Ap = get_args(); unsigned char* ws = Ap->ws;
            pg8::Gemm g{(const bf16_t*)(ws + WS_MIX), (const bf16_t*)(ws + WS_WOUT) + (size_t)l * DM * DM, MTOK, DM, DM}; pg8::StaticOrder S; S.init(MTOK, DM, G, blk);
            EpiResid E{(bf16_t*)(ws + WS_XB), (float*)(ws + WS_RSQ) + (size_t)(2 * l + 1) * RSQ_BUF};
            pg8::gemm_phase<EpiResid, pg8::StaticOrder, true, true>(lds, g, S, E, tid);
        }
        FAST_SYNC();
        {
            PHASE_IDS(); CArgs* Ap = get_args(); unsigned char* ws = Ap->ws;
            pg8::Gemm g{(const bf16_t*)(ws + WS_XB), (const bf16_t*)(ws + WS_WGU) + (size_t)l * 2 * DFF * DM, MTOK, 2 * DFF, DM}; pg8::StaticOrder S; S.init(MTOK, 2 * DFF, G, blk);
            const float* rq = (const float*)(ws + WS_RSQ) + (size_t)(2 * l + 1) * RSQ_BUF; LAS float* tab = (LAS float*)(lds + 131072);
            pg8::Unit u0; const int pm0 = S.next(0, u0) ? u0.pm : -1; if (pm0 >= 0) rstd_table(rq, pm0, tab, tid); else __syncthreads();
            EpiSwiglu E{(bf16_t*)(ws + WS_HID), rq, tab, pm0};
            pg8::gemm_phase<EpiSwiglu, pg8::StaticOrder, true, true>(lds, g, S, E, tid);
        }
        FAST_SYNC();
        {
            PHASE_IDS(); CArgs* Ap = get_args(); unsigned char* ws = Ap->ws;
            pg8::Gemm g{(const bf16_t*)(ws + WS_HID), (const bf16_t*)(ws + WS_WDN) + (size_t)l * DM * DFF, MTOK, DM, DFF}; pg8::StaticOrder S; S.init(MTOK, DM, G, blk);
            EpiResid E{(bf16_t*)(ws + WS_XB), (float*)(ws + WS_RSQ) + (size_t)(2 * l + 2) * RSQ_BUF};
            pg8::gemm_phase<EpiResid, pg8::StaticOrder, true, true>(lds, g, S, E, tid);
        }
        FAST_SYNC();
    }
    {
        PHASE_IDS(); CArgs* Ap = get_args();
        const float* fr = (const float*)(Ap->ws + WS_RSQ) + (size_t)(2 * DEPTH) * RSQ_BUF; const float* gn = Ap->in[4]; float* out = Ap->out;
        for (int m = gw; m < MTOK; m += NGW) {
            const float sq = wave_sum(lane < 32 ? fr[(size_t)lane * MTOK + m] : 0.f);
            const float rstd = rsqrtf(sq * (1.f / DM) + EPS);
            f32x4* xo = (f32x4*)(out + (size_t)m * DM) + lane; const f32x4* gp = (const f32x4*)gn + lane; const u32x2* xb = (const u32x2*)((const bf16_t*)(Ap->ws + WS_XB) + (size_t)m * DM) + lane;
#pragma unroll
            for (int j = 0; j < 8; ++j) { const u32x2 q = xb[64 * j]; f32x4 v = (f32x4){bflo(q.x), bfhi(q.x), bflo(q.y), bfhi(q.y)}; const f32x4 gg = gp[64 * j]; v = v * rstd * gg; __builtin_nontemporal_store(v, &xo[64 * j]); }
        }
    }
}

extern "C" void kernel_launch(void* const* d_in, const int* in_sizes, int n_in, void* d_out, int out_size, void* d_ws, size_t ws_size, hipStream_t stream) {
    static int grid = 0;
    if (grid == 0) {
        if (n_in != 26 || ws_size < WS_END) { fprintf(stderr, "kernel_launch: unexpected inputs (n_in %d, ws %zu, need %zu)\n", n_in, ws_size, (size_t)WS_END); grid = -1; return; }
        int dev = 0, cus = 0, per_cu = 0;
        hipGetDevice(&dev); hipDeviceGetAttribute(&cus, hipDeviceAttributeMultiprocessorCount, dev);
        hipFuncSetAttribute((const void*)hymba_fwd, hipFuncAttributeMaxDynamicSharedMemorySize, LDS_BYTES);
        hipOccupancyMaxActiveBlocksPerMultiprocessor(&per_cu, (const void*)hymba_fwd, 512, LDS_BYTES);
        if (per_cu < 1) { fprintf(stderr, "kernel_launch: occupancy query says %d blocks per CU\n", per_cu); per_cu = 1; }
        grid = cus * 1;
        (void)hipGetLastError();
    }
    if (grid < 0) return;
    Args a{};
    for (int i = 0; i < 26; ++i) a.in[i] = (const float*)d_in[i];
    a.out = (float*)d_out; a.ws = (unsigned char*)d_ws;
    void* args[] = {&a};
    hipError_t e = hipLaunchCooperativeKernel((const void*)hymba_fwd, dim3(grid), dim3(512), args, LDS_BYTES, stream);
    if (e != hipSuccess) fprintf(stderr, "cooperative launch failed: %s (grid %d)\n", hipGetErrorString(e), grid);
}
```
